# Optimizing an MI355X kernel written in HIP

```python
import math
import jax, jax.numpy as jnp
from jax import lax
import numpy as np

D_MODEL = 2048
BATCH = 4
SEQ = 4096
DEPTH = 4

N_MEM = 256
N_MIXERS = 3
BRANCH_WIDTH = D_MODEL
MEM_HEADS = 4
MEM_HEAD_DIM = 128
MEM_WIDTH = MEM_HEADS * MEM_HEAD_DIM
MIX_WIDTH = BRANCH_WIDTH - MEM_WIDTH

SWA_HEAD_DIM = 64
SWA_Q_HEADS = MIX_WIDTH // SWA_HEAD_DIM
SWA_KV_HEADS = SWA_Q_HEADS // 8
SWA_WINDOW = 128

MOBA_HEAD_DIM = 128
MOBA_HEADS = MIX_WIDTH // MOBA_HEAD_DIM
MOBA_BLOCK = 256
MOBA_TOPK = 3
MOBA_Q_CHUNK = 32

RET_HEADS = 6
RET_V_DIM = MIX_WIDTH // RET_HEADS
RET_QK_DIM = RET_V_DIM // 2
RET_CHUNK = 128
RET_THETA = 10000.0

ROPE_THETA = 500000.0
ROPE_FRACTION = 4
EPS = 1e-6

IN_COLS = (
    SWA_Q_HEADS * SWA_HEAD_DIM + 2 * SWA_KV_HEADS * SWA_HEAD_DIM + MEM_WIDTH + BRANCH_WIDTH,
    3 * MIX_WIDTH + MEM_WIDTH + BRANCH_WIDTH,
    2 * RET_HEADS * RET_QK_DIM + RET_HEADS * RET_V_DIM + MEM_WIDTH + BRANCH_WIDTH,
)

kernel_name = "hybrid_swa_moba_retention_trunk"

F32 = jnp.float32


def rmsnorm(x, g):
    xf = x.astype(F32)
    y = xf * lax.rsqrt(jnp.mean(xf * xf, axis=-1, keepdims=True) + EPS)
    return (y * g.astype(F32)).astype(x.dtype)


def rope_angles(positions, rot_dim, theta):
    inv = theta ** (-jnp.arange(0, rot_dim, 2, dtype=F32) / rot_dim)
    ang = positions.astype(F32)[..., None] * inv
    return jnp.cos(ang)[:, :, None, :], jnp.sin(ang)[:, :, None, :]


def apply_rope(x, cos, sin):
    r = 2 * cos.shape[-1]
    xf = x[..., :r].astype(F32)
    x1, x2 = xf[..., : r // 2], xf[..., r // 2:]
    rot = jnp.concatenate([x1 * cos - x2 * sin, x2 * cos + x1 * sin], axis=-1).astype(x.dtype)
    return jnp.concatenate([rot, x[..., r:]], axis=-1)


def swa_sink_attention(q, k, v, sinks):
    B, S, Hq, dh = q.shape
    Hkv = k.shape[2]
    G = Hq // Hkv
    W = SWA_WINDOW
    nb = S // W
    qb = q.reshape(B, nb, W, Hkv, G, dh)

    def with_prev(t):
        tb = t.reshape(B, nb, W, Hkv, dh)
        prev = jnp.pad(tb, ((0, 0), (1, 0), (0, 0), (0, 0), (0, 0)))[:, :-1]
        return jnp.concatenate([prev, tb], axis=2)

    kb, vb = with_prev(k), with_prev(v)
    s = jnp.einsum('bnqhgd,bnkhd->bnhgqk', qb, kb, preferred_element_type=F32) * (dh ** -0.5)
    qi = jnp.arange(W)[:, None] + W
    ki = jnp.arange(2 * W)[None, :]
    blk = jnp.arange(nb)[:, None, None]
    valid = (ki <= qi) & (ki > qi - W) & ((blk > 0) | (ki >= W))
    s = jnp.where(valid[None, :, None, None], s, -jnp.inf)
    sink = sinks.astype(F32).reshape(1, 1, Hkv, G, 1, 1)
    m = jnp.maximum(jnp.max(s, axis=-1, keepdims=True), sink)
    p = jnp.exp(s - m)
    p = p / (jnp.sum(p, axis=-1, keepdims=True) + jnp.exp(sink - m))
    o = jnp.einsum('bnhgqk,bnkhd->bnqhgd', p.astype(v.dtype), vb)
    return o.reshape(B, S, Hq * dh)


def moba_attention(q, k, v):
    B, S, H, dh = q.shape
    L = MOBA_BLOCK
    C = MOBA_Q_CHUNK
    Sp = -(-S // L) * L
    nblk = Sp // L
    pad = ((0, 0), (0, Sp - S), (0, 0), (0, 0))
    qh = jnp.pad(q, pad).transpose(0, 2, 1, 3)
    kb = jnp.pad(k, pad).transpose(0, 2, 1, 3).reshape(B, H, nblk, L, dh)
    vb = jnp.pad(v, pad).transpose(0, 2, 1, 3).reshape(B, H, nblk, L, dh)
    scale = dh ** -0.5
    q_blk = jnp.arange(Sp) // L
    n_sel = min(MOBA_TOPK, nblk - 1)
    if n_sel > 0:
        kmean = jnp.mean(kb.astype(F32), axis=3)
        gate = jnp.einsum('bhsd,bhnd->bhsn', qh.astype(F32), kmean)
        past = jnp.arange(nblk)[None, :] < q_blk[:, None]
        gate = jnp.where(past, gate, -jnp.inf)
        _, sel = lax.top_k(gate, n_sel)
        sel_valid = sel < q_blk[:, None]
        bi = jnp.arange(B)[:, None, None, None]
        hi = jnp.arange(H)[None, :, None, None]

    def chunk_fn(c):
        start = c * C
        qc = lax.dynamic_slice_in_dim(qh, start, C, axis=2)
        own = start // L
        k_own = lax.dynamic_index_in_dim(kb, own, axis=2, keepdims=False)
        v_own = lax.dynamic_index_in_dim(vb, own, axis=2, keepdims=False)
        pos = start + jnp.arange(C)
        own_mask = (own * L + jnp.arange(L))[None, :] <= pos[:, None]
        s_own = jnp.einsum('bhqd,bhkd->bhqk', qc, k_own, preferred_element_type=F32) * scale
        s_own = jnp.where(own_mask, s_own, -jnp.inf)
        if n_sel > 0:
            sel_c = lax.dynamic_slice_in_dim(sel, start, C, axis=2)
            val_c = lax.dynamic_slice_in_dim(sel_valid, start, C, axis=2)
            k_sel = kb[bi, hi, sel_c]
            v_sel = vb[bi, hi, sel_c]
            s_sel = jnp.einsum('bhqd,bhqnkd->bhqnk', qc, k_sel, preferred_element_type=F32) * scale
            s_sel = jnp.where(val_c[..., None], s_sel, -jnp.inf).reshape(B, H, C, n_sel * L)
            p = jax.nn.softmax(jnp.concatenate([s_sel, s_own], axis=-1), axis=-1).astype(v.dtype)
            p_sel = p[..., : n_sel * L].reshape(B, H, C, n_sel, L)
            o = (jnp.einsum('bhqnk,bhqnkd->bhqd', p_sel, v_sel)
                 + jnp.einsum('bhqk,bhkd->bhqd', p[..., n_sel * L:], v_own))
        else:
            p = jax.nn.softmax(s_own, axis=-1).astype(v.dtype)
            o = jnp.einsum('bhqk,bhkd->bhqd', p, v_own)
        return o

    out = lax.map(chunk_fn, jnp.arange(Sp // C))
    out = out.transpose(1, 0, 3, 2, 4).reshape(B, Sp, H * dh)
    return out[:, :S]


def retention(q, k, v):
    B, S, H, dk = q.shape
    dv = v.shape[-1]
    T = RET_CHUNK
    nc = S // T
    log_g = jnp.log1p(-jnp.exp(jnp.linspace(math.log(1.0 / 32), math.log(1.0 / 512), H, dtype=F32)))
    k = k * (dk ** -0.5)
    qc = q.reshape(B, nc, T, H, dk)
    kc = k.reshape(B, nc, T, H, dk)
    vc = v.reshape(B, nc, T, H, dv)
    i = jnp.arange(T, dtype=F32)
    diff = i[:, None] - i[None, :]
    decay = jnp.where(diff >= 0, jnp.exp(jnp.maximum(diff, 0.0)[None] * log_g[:, None, None]), 0.0)
    s = jnp.einsum('bnqhd,bnkhd->bnhqk', qc, kc, preferred_element_type=F32) * decay[None, None]
    inner = jnp.einsum('bnhqk,bnkhe->bnqhe', s.astype(v.dtype), vc).astype(F32)
    zeta = jnp.exp((T - 1 - i)[:, None] * log_g[None, :])
    kv = jnp.einsum('bnkhd,bnkhe->bnhde', kc.astype(F32) * zeta[:, :, None], vc.astype(F32))
    g_chunk = jnp.exp(T * log_g)[None, :, None, None]

    def step(R, kv_n):
        return g_chunk * R + kv_n, R

    _, R_prev = lax.scan(step, jnp.zeros((B, H, dk, dv), F32), kv.transpose(1, 0, 2, 3, 4))
    xi = jnp.exp((i + 1)[:, None] * log_g[None, :])
    cross = jnp.einsum('bnqhd,nbhde->bnqhe', qc.astype(F32) * xi[:, :, None], R_prev)
    o = inner + cross
    o = o * lax.rsqrt(jnp.mean(o * o, axis=-1, keepdims=True) + EPS)
    return o.reshape(B, S, H * dv).astype(v.dtype)


def memory_attention(qm, mem_k, mem_v):
    B, S, Hm, dm = qm.shape
    s = jnp.einsum('bshd,bnhd->bhsn', qm, mem_k, preferred_element_type=F32) * (dm ** -0.5)
    p = jax.nn.softmax(s, axis=-1).astype(mem_v.dtype)
    return jnp.einsum('bhsn,bnhd->bshd', p, mem_v).reshape(B, S, Hm * dm)


def hybrid_layer(x, mixer_id, g, w_in, w_out, sinks, rope_a, rope_b, rope_c, mem_k, mem_v):
    B, S, _ = x.shape
    h = rmsnorm(x, g)
    proj = h @ w_in
    n_mix = w_in.shape[1] - MEM_WIDTH - BRANCH_WIDTH
    mix_in = proj[..., :n_mix]
    qm = proj[..., n_mix:n_mix + MEM_WIDTH].reshape(B, S, MEM_HEADS, MEM_HEAD_DIM)
    z = proj[..., n_mix + MEM_WIDTH:]
    if mixer_id == 0:
        nq = SWA_Q_HEADS * SWA_HEAD_DIM
        nkv = SWA_KV_HEADS * SWA_HEAD_DIM
        q = mix_in[..., :nq].reshape(B, S, SWA_Q_HEADS, SWA_HEAD_DIM)
        k = mix_in[..., nq:nq + nkv].reshape(B, S, SWA_KV_HEADS, SWA_HEAD_DIM)
        v = mix_in[..., nq + nkv:].reshape(B, S, SWA_KV_HEADS, SWA_HEAD_DIM)
        q, k = apply_rope(q, *rope_a), apply_rope(k, *rope_a)
        mix_out = swa_sink_attention(q, k, v, sinks)
    elif mixer_id == 1:
        q, k, v = [t.reshape(B, S, MOBA_HEADS, MOBA_HEAD_DIM) for t in jnp.split(mix_in, 3, axis=-1)]
        q, k = apply_rope(q, *rope_b), apply_rope(k, *rope_b)
        mix_out = moba_attention(q, k, v)
    else:
        nqk = RET_HEADS * RET_QK_DIM
        q = mix_in[..., :nqk].reshape(B, S, RET_HEADS, RET_QK_DIM)
        k = mix_in[..., nqk:2 * nqk].reshape(B, S, RET_HEADS, RET_QK_DIM)
        v = mix_in[..., 2 * nqk:].reshape(B, S, RET_HEADS, RET_V_DIM)
        q, k = apply_rope(q, *rope_c), apply_rope(k, *rope_c)
        mix_out = retention(q, k, v)
    mem_out = memory_attention(qm, mem_k, mem_v)
    y = jnp.concatenate([mix_out, mem_out], axis=-1) * jax.nn.silu(z)
    return x + y @ w_out


def setup_inputs(seed: int = 0) -> dict:
    key = jax.random.key(seed)
    keys = jax.random.split(key, 4 + 4 * DEPTH + 1)
    out = {}
    out['x'] = jax.random.normal(keys[0], (BATCH, SEQ, D_MODEL), F32)
    out['mem'] = jax.random.normal(keys[1], (BATCH, N_MEM, D_MODEL), F32)
    out['positions'] = jnp.broadcast_to(jnp.arange(SEQ, dtype=jnp.int32), (BATCH, SEQ))
    out['mem_norm'] = 1.0 + 0.02 * jax.random.normal(keys[2], (D_MODEL,), F32)
    out['w_mem_kv'] = jax.random.normal(keys[3], (D_MODEL, 2 * MEM_WIDTH), F32) * D_MODEL ** -0.5
    for i in range(DEPTH):
        kg, ki, ks, ko = keys[4 + 4 * i: 8 + 4 * i]
        mid = i % N_MIXERS
        out[f'norm_{i}'] = 1.0 + 0.02 * jax.random.normal(kg, (D_MODEL,), F32)
        out[f'w_in_{i}'] = jax.random.normal(ki, (D_MODEL, IN_COLS[mid]), F32) * D_MODEL ** -0.5
        if mid == 0:
            out[f'sinks_{i}'] = jax.random.normal(ks, (SWA_Q_HEADS,), F32)
        out[f'w_out_{i}'] = jax.random.normal(ko, (BRANCH_WIDTH, D_MODEL), F32) * (0.5 * BRANCH_WIDTH ** -0.5)
    out['final_norm'] = 1.0 + 0.02 * jax.random.normal(keys[-1], (D_MODEL,), F32)
    return out


def reference(x, mem, positions, mem_norm, w_mem_kv,
              norm_0, w_in_0, sinks_0, w_out_0,
              norm_1, w_in_1, w_out_1,
              norm_2, w_in_2, w_out_2,
              norm_3, w_in_3, sinks_3, w_out_3,
              final_norm):
    B = x.shape[0]
    layers = [(norm_0, w_in_0, w_out_0, sinks_0),
              (norm_1, w_in_1, w_out_1, None),
              (norm_2, w_in_2, w_out_2, None),
              (norm_3, w_in_3, w_out_3, sinks_3)]
    mkv = rmsnorm(mem, mem_norm) @ w_mem_kv
    mem_k = mkv[..., :MEM_WIDTH].reshape(B, N_MEM, MEM_HEADS, MEM_HEAD_DIM)
    mem_v = mkv[..., MEM_WIDTH:].reshape(B, N_MEM, MEM_HEADS, MEM_HEAD_DIM)
    rope_a = rope_angles(positions, SWA_HEAD_DIM // ROPE_FRACTION, ROPE_THETA)
    rope_b = rope_angles(positions, MOBA_HEAD_DIM // ROPE_FRACTION, ROPE_THETA)
    rope_c = rope_angles(positions, RET_QK_DIM, RET_THETA)
    h = x
    for i in range(DEPTH):
        g, w_in, w_out, sinks = layers[i]
        h = hybrid_layer(h, i % N_MIXERS, g, w_in, w_out, sinks, rope_a, rope_b, rope_c, mem_k, mem_v)
    return rmsnorm(h, final_norm)
```

```cpp
#include <hip/hip_runtime.h>
#include <hip/hip_cooperative_groups.h>
#include <cstdio>
#include <cstdint>
namespace cg = cooperative_groups;
namespace pg8 {
#define PG8_LAS __attribute__((address_space(3)))
typedef unsigned short bf16_t;
typedef short bf16x8 __attribute__((ext_vector_type(8)));
typedef float f32x4 __attribute__((ext_vector_type(4)));
typedef unsigned u32x4 __attribute__((ext_vector_type(4)));
constexpr int BM = 256, BK = 64, HALF = 128, HTB = HALF * BK * 2  , STAGE_BYTES = 8 * HTB, NXCD = 8, WGM = 8;

__host__ __device__ __forceinline__ int lds_byte(int r, int c) { const int st = (r >> 4) * 2 + (c >> 5), rr = r & 15, cc = c & 31, ob = rr * 64 + cc * 2; return st * 1024 + (ob ^ (((ob >> 9) & 1) << 5)); }
__host__ __device__ __forceinline__ void stage_rc(int b, int& R, int& C) { const int st = b / 1024, sb = b % 1024, swz = sb ^ (((sb >> 9) & 1) << 5); R = (st >> 1) * 16 + swz / 64; C = (st & 1) * 32 + (swz % 64) / 2; }
__host__ __device__ __forceinline__ int perm32(int rho) { const int n = rho >> 4, i = rho & 15; return 8 * (i >> 2) + 4 * n + (i & 3); }

struct Unit { int pm, pn; };
struct Gemm { const bf16_t* A; const bf16_t* Bt; int lda, K; };

struct StaticOrder {
    int nM, nN, nwg, G, c;
    __host__ __device__ void init(int M, int N, int G_, int c_) { nM = M / BM; nN = N / BM; nwg = nM * nN; G = G_; c = c_; }
    __host__ __device__ bool next(int i, Unit& u) const {
        const long L = (long)i * G + c; if (L >= nwg || c < 0) return false;
        int wgid = (int)L; { const int q = nwg / NXCD, r = nwg % NXCD, xcd = wgid % NXCD, off = wgid / NXCD; wgid = (xcd < r ? xcd * (q + 1) : r * (q + 1) + (xcd - r) * q) + off; }
        const int nig = WGM * nN, gid = wgid / nig, fm = gid * WGM, gsz = (nM - fm) < WGM ? (nM - fm) : WGM;
        u.pm = fm + ((wgid % nig) % gsz); u.pn = (wgid % nig) / gsz; return true;
    }
    __device__ __forceinline__ void a_ready(const Unit&) const {}
    __device__ __forceinline__ void done(const Unit&) const {}
};

__device__ __forceinline__ unsigned cvt_pk_bf16(float lo, float hi) { unsigned r; asm volatile("v_cvt_pk_bf16_f32 %0, %1, %2" : "=v"(r) : "v"(lo), "v"(hi)); return r; }
constexpr int NB = 4, SEQ = 4096, DMODEL = 2048, MTOK = NB * SEQ, NMEMTOK = 256, LDP = 7168;
constexpr float EPSN = 1e-6f;
__host__ __device__ constexpr int nc_of(int mid)   { return mid == 0 ? 4480 : (mid == 1 ? 7168 : 5632); }
__host__ __device__ constexpr int npad_of(int mid) { return mid == 0 ? 4608 : (mid == 1 ? 7168 : 5632); }
__host__ __device__ constexpr int nmix_of(int mid) { return mid == 0 ? 1920 : (mid == 1 ? 4608 : 3072); }

struct GDesc { int dst0, dst1, rope, rstr; float scale; };
__device__ __forceinline__ GDesc gdesc(int mid, int j0) {
    GDesc d; d.dst0 = j0; d.dst1 = j0 + 4; d.rope = -1; d.rstr = 0; d.scale = 1.f;
    const float L2E = 1.4426950408889634f, R128 = 0.08838834764831845f;
    if (mid == 0) {
        if (j0 >= 4480) { d.dst0 = -1; return d; }
        if (j0 < 1728) { const int hb = j0 & ~63, lg = (j0 & 63) >> 3;
            if (lg < 2) { d.dst0 = hb + 4 * lg; d.dst1 = hb + 8 + 4 * lg; d.rope = 4 * lg; d.rstr = 16; }
            if (j0 < 1536) d.scale = 0.125f * L2E; }
        else if (j0 >= 1920 && j0 < 2432) d.scale = R128 * L2E;
    } else if (mid == 1) {
        if (j0 < 3072) { const int hb = j0 & ~127, lg = (j0 & 127) >> 3;
            if (lg < 4) { d.dst0 = hb + 4 * lg; d.dst1 = hb + 16 + 4 * lg; d.rope = MTOK * 16 + 4 * lg; d.rstr = 32; }
            if (j0 < 1536) d.scale = R128 * L2E; }
        else if (j0 >= 4608 && j0 < 5120) d.scale = R128 * L2E;
    } else if (mid == 2) {
        if (j0 < 1536) { const int hb = j0 & ~127, lg = (j0 & 127) >> 3;
            d.dst0 = hb + 4 * lg; d.dst1 = hb + 64 + 4 * lg; d.rope = MTOK * 48 + 4 * lg; d.rstr = 128;
            if (j0 >= 768) d.scale = R128; }
        else if (j0 >= 3072 && j0 < 3584) d.scale = R128 * L2E;
    }
    return d;
}
__device__ __forceinline__ int src_col(int mid, int j) { const GDesc d = gdesc(mid, j & ~7); if (d.dst0 < 0) return -1; return (j & 4) ? d.dst1 + (j & 3) : d.dst0 + (j & 3); }

typedef unsigned u32x2 __attribute__((ext_vector_type(2)));
struct EpiIn {
    static constexpr bool PERM = true, AFTER_DRAIN = false;
    bf16_t* O; int ldc, mid; const float* rss; const float* rope0;
    __device__ __forceinline__ void operator()(const f32x4 (&acc)[2][2][4][2], const Unit& u, int wr, int wc, int fr, int fq) const {
        const int row0 = u.pm * BM + wr * 64 + fr;
        GDesc d[2];
#pragma unroll
        for (int bj = 0; bj < 2; ++bj) d[bj] = gdesc(mid, u.pn * BM + bj * HALF + wc * 32 + 8 * fq);
#pragma unroll
        for (int ai = 0; ai < 2; ++ai)
#pragma unroll
            for (int m = 0; m < 4; ++m) {
                const int r = row0 + ai * HALF + m * 16;
                const float s = __builtin_amdgcn_rsqf(rss[r] * (1.0f / DMODEL) + EPSN);
                bf16_t* rowp = O + (size_t)r * ldc;
#pragma unroll
                for (int bj = 0; bj < 2; ++bj) {
                    if (d[bj].dst0 < 0) continue;
                    const float sc = s * d[bj].scale;
                    f32x4 v0 = acc[ai][bj][m][0] * sc, v1 = acc[ai][bj][m][1] * sc;
                    if (d[bj].rope >= 0) {
                        const float* t = rope0 + d[bj].rope + (size_t)r * d[bj].rstr; const int F = d[bj].rstr >> 1;
                        const f32x4 c = *(const f32x4*)t, sn = *(const f32x4*)(t + F);
                        const f32x4 n0 = v0 * c - v1 * sn, n1 = v1 * c + v0 * sn; v0 = n0; v1 = n1;
                    }
                    u32x2 w0, w1; w0.x = cvt_pk_bf16(v0[0], v0[1]); w0.y = cvt_pk_bf16(v0[2], v0[3]); w1.x = cvt_pk_bf16(v1[0], v1[1]); w1.y = cvt_pk_bf16(v1[2], v1[3]);
                    if (d[bj].dst1 == d[bj].dst0 + 4) { u32x4 w; w.x = w0.x; w.y = w0.y; w.z = w1.x; w.w = w1.y; *(u32x4*)(rowp + d[bj].dst0) = w; }
                    else { *(u32x2*)(rowp + d[bj].dst0) = w0; *(u32x2*)(rowp + d[bj].dst1) = w1; }
                }
            }
    }
};
struct EpiOut {
    static constexpr bool PERM = true, AFTER_DRAIN = false;
    const float* basef; float* out; bf16_t* hb; float* rssn; int mode;
    __device__ __forceinline__ void operator()(const f32x4 (&acc)[2][2][4][2], const Unit& u, int wr, int wc, int fr, int fq) const {
        const int row0 = u.pm * BM + wr * 64 + fr, col0 = u.pn * BM + wc * 32 + 8 * fq;
#pragma unroll
        for (int ai = 0; ai < 2; ++ai)
#pragma unroll
            for (int m = 0; m < 4; ++m) {
                const int r = row0 + ai * HALF + m * 16; float ss = 0.f;
#pragma unroll
                for (int bj = 0; bj < 2; ++bj) {
                    const size_t off = (size_t)r * DMODEL + col0 + bj * HALF;
                    f32x4 b0, b1;
                    if (mode == 0) { b0 = *(const f32x4*)(basef + off); b1 = *(const f32x4*)(basef + off + 4); }
                    else { const u32x4 hw = *(const u32x4*)(hb + off);
                        b0 = (f32x4){__builtin_bit_cast(float, hw.x << 16), __builtin_bit_cast(float, hw.x & 0xffff0000u), __builtin_bit_cast(float, hw.y << 16), __builtin_bit_cast(float, hw.y & 0xffff0000u)};
                        b1 = (f32x4){__builtin_bit_cast(float, hw.z << 16), __builtin_bit_cast(float, hw.z & 0xffff0000u), __builtin_bit_cast(float, hw.w << 16), __builtin_bit_cast(float, hw.w & 0xffff0000u)}; }
                    const f32x4 v0 = acc[ai][bj][m][0] + b0, v1 = acc[ai][bj][m][1] + b1;
                    if (mode == 2) { *(f32x4*)(out + off) = v0; *(f32x4*)(out + off + 4) = v1; }
                    else { u32x4 w; w.x = cvt_pk_bf16(v0[0], v0[1]); w.y = cvt_pk_bf16(v0[2], v0[3]); w.z = cvt_pk_bf16(v1[0], v1[1]); w.w = cvt_pk_bf16(v1[2], v1[3]);
                        *(u32x4*)(hb + off) = w; }
                    ss += (v0[0] * v0[0] + v0[1] * v0[1]) + (v0[2] * v0[2] + v0[3] * v0[3]) + (v1[0] * v1[0] + v1[1] * v1[1]) + (v1[2] * v1[2] + v1[3] * v1[3]);
                }
                ss += __shfl_xor(ss, 16); ss += __shfl_xor(ss, 32);
                if (fq == 0) atomicAdd(rssn + r, ss);
                if (m & 1) asm volatile("" ::: "memory");
            }
    }
};

template <class Epi, class Sched, bool ALIGN_EPI = false, bool SP2 = false>
__device__ __forceinline__ void gemm_phase(PG8_LAS unsigned char* lds, const Gemm g, const Sched& S, const Epi& E) {
    int tid_ = threadIdx.x; asm volatile("" : "+v"(tid_));
    const int tid = tid_, wid = __builtin_amdgcn_readfirstlane(tid >> 6), lane = tid & 63, wr = wid >> 2, wc = wid & 3, fr = lane & 15, fq = lane >> 4;
    const int K = g.K, nt = K / BK;
    unsigned voffA[2], voffB[2];
#pragma unroll
    for (int i = 0; i < 2; ++i) { int R, C; stage_rc(tid * 16 + i * 8192, R, C); const int Rb = Epi::PERM ? ((R & ~31) + perm32(R & 31)) : R;
        voffA[i] = (unsigned)(R * g.lda + C) * 2u; voffB[i] = (unsigned)(Rb * K + C) * 2u; }
    const size_t kstep = (size_t)(BK * 2);
    const size_t hstepA = (size_t)HALF * g.lda * 2, hstepB = (size_t)HALF * K * 2;
    const size_t tstepA = 2 * hstepA, tstepB = 2 * hstepB;
    const unsigned ldsw = (unsigned)wid * 1024u;
    const int aoff = lds_byte(wr * 64 + fr, fq * 8), boff = lds_byte(wc * 32 + fr, fq * 8);
#define PG8_SA(b, h) (((b) * 2 + (h)) * HTB)
#define PG8_SB(b, h) ((4 + (b) * 2 + (h)) * HTB)
#define PG8_STAGE(bufoff, gbase, voff) do { _Pragma("unroll") for (int _i = 0; _i < 2; ++_i) \
        __builtin_amdgcn_global_load_lds((const unsigned*)((const char*)(gbase) + (voff)[_i]), (PG8_LAS unsigned*)(lds + (bufoff) + ldsw + _i * 8192), 16, 0, 0); } while (0)
#define PG8_LDA(dst, b, h) do { _Pragma("unroll") for (int m = 0; m < 4; ++m) _Pragma("unroll") for (int k = 0; k < 2; ++k) dst[m][k] = *(const PG8_LAS bf16x8*)(lds + PG8_SA(b, h) + aoff + m * 2048 + k * 1024); } while (0)
#define PG8_LDB(dst, b, h) do { _Pragma("unroll") for (int n = 0; n < 2; ++n) _Pragma("unroll") for (int k = 0; k < 2; ++k) dst[n][k] = *(const PG8_LAS bf16x8*)(lds + PG8_SB(b, h) + boff + n * 2048 + k * 1024); } while (0)
#define PG8_MMA(ai, bj, At, Bt) do { __builtin_amdgcn_s_setprio(1); _Pragma("unroll") for (int m = 0; m < 4; ++m) _Pragma("unroll") for (int n = 0; n < 2; ++n) _Pragma("unroll") for (int k = 0; k < 2; ++k) \
        acc[ai][bj][m][n] = __builtin_amdgcn_mfma_f32_16x16x32_bf16(Bt[n][k], At[m][k], acc[ai][bj][m][n], 0, 0, 0); __builtin_amdgcn_s_setprio(0); } while (0)
#define PG8_WAIT_V(n) asm volatile("s_waitcnt vmcnt(" #n ")" ::: "memory")
#define PG8_WAIT_L(n) asm volatile("s_waitcnt lgkmcnt(" #n ")" ::: "memory")
#define PG8_BAR __builtin_amdgcn_s_barrier()
#define PG8_SCHED __builtin_amdgcn_sched_barrier(0)
    Unit cur, nxt; int ui = 0;
    if (!S.next(0, cur)) return;
    f32x4 acc[2][2][4][2];
#pragma unroll
    for (int a = 0; a < 2; ++a)
#pragma unroll
        for (int b = 0; b < 2; ++b)
#pragma unroll
            for (int m = 0; m < 4; ++m)
#pragma unroll
                for (int n = 0; n < 2; ++n) acc[a][b][m][n] = (f32x4){0.f, 0.f, 0.f, 0.f};
    bf16x8 At[4][2], B0[2][2], B1[2][2];
    const char* cA = (const char*)g.A + (size_t)cur.pm * tstepA; const char* cB = (const char*)g.Bt + (size_t)cur.pn * tstepB;
    S.a_ready(cur);
    if constexpr (SP2) {
        PG8_STAGE(PG8_SB(0, 0), cB, voffB); PG8_STAGE(PG8_SB(0, 1), cB + hstepB, voffB); PG8_STAGE(PG8_SA(0, 0), cA, voffA); PG8_STAGE(PG8_SA(0, 1), cA + hstepA, voffA);
        if (wr == 1) PG8_BAR;
        PG8_WAIT_V(2); PG8_BAR;
        PG8_STAGE(PG8_SB(1, 0), cB + kstep, voffB); PG8_STAGE(PG8_SA(1, 0), cA + kstep, voffA); PG8_STAGE(PG8_SB(1, 1), cB + hstepB + kstep, voffB);
        PG8_WAIT_V(6); PG8_BAR;
    } else {
        PG8_STAGE(PG8_SB(0, 0), cB, voffB); PG8_STAGE(PG8_SA(0, 0), cA, voffA); PG8_STAGE(PG8_SB(0, 1), cB + hstepB, voffB); PG8_STAGE(PG8_SA(0, 1), cA + hstepA, voffA);
        if (wr == 1) PG8_BAR;
        PG8_WAIT_V(4); PG8_BAR;
        PG8_STAGE(PG8_SB(1, 0), cB + kstep, voffB); PG8_STAGE(PG8_SA(1, 0), cA + kstep, voffA); PG8_STAGE(PG8_SB(1, 1), cB + hstepB + kstep, voffB);
        PG8_WAIT_V(6); PG8_BAR;
    }
    for (;;) {
        const bool has_next = S.next(ui + 1, nxt);
        const char* nA = has_next ? (const char*)g.A + (size_t)nxt.pm * tstepA : cA; const char* nB = has_next ? (const char*)g.Bt + (size_t)nxt.pn * tstepB : cB;
        for (int t = 0; t < nt; t += 2) {
            const bool last = (t == nt - 2);
            const char* a1 = cA + (size_t)(t + 1) * kstep;
            const char* a2 = last ? nA : cA + (size_t)(t + 2) * kstep; const char* b2 = last ? nB : cB + (size_t)(t + 2) * kstep;
            const char* a3 = a2 + kstep; const char* b3 = b2 + kstep;
            if (last && has_next) S.a_ready(nxt);
            if constexpr (SP2) {
            PG8_LDB(B0, 0, 0); PG8_LDB(B1, 0, 1); PG8_SCHED; PG8_LDA(At, 0, 0); PG8_STAGE(PG8_SA(1, 1), a1 + hstepA, voffA);
            PG8_WAIT_V(8); PG8_WAIT_L(0); PG8_BAR; PG8_MMA(0, 0, At, B0); PG8_MMA(0, 1, At, B1); PG8_BAR; PG8_SCHED;
            PG8_LDA(At, 0, 1); PG8_STAGE(PG8_SB(0, 0), b2, voffB); PG8_STAGE(PG8_SB(0, 1), b2 + hstepB, voffB); PG8_STAGE(PG8_SA(0, 0), a2, voffA);
            PG8_WAIT_V(8); PG8_WAIT_L(0); PG8_BAR; PG8_MMA(1, 0, At, B0); PG8_MMA(1, 1, At, B1); PG8_BAR; PG8_SCHED;
            PG8_LDB(B0, 1, 0); PG8_LDB(B1, 1, 1); PG8_SCHED; PG8_LDA(At, 1, 0); PG8_STAGE(PG8_SA(0, 1), a2 + hstepA, voffA);
            PG8_WAIT_V(8); PG8_WAIT_L(0); PG8_BAR; PG8_MMA(0, 0, At, B0); PG8_MMA(0, 1, At, B1); PG8_BAR; PG8_SCHED;
            PG8_LDA(At, 1, 1); PG8_STAGE(PG8_SB(1, 0), b3, voffB); PG8_STAGE(PG8_SB(1, 1), b3 + hstepB, voffB); PG8_STAGE(PG8_SA(1, 0), a3, voffA);
            PG8_WAIT_V(8); PG8_WAIT_L(0); PG8_BAR; PG8_MMA(1, 0, At, B0); PG8_MMA(1, 1, At, B1); PG8_BAR; PG8_SCHED;
            } else {
            PG8_LDB(B0, 0, 0); PG8_SCHED; PG8_LDA(At, 0, 0); PG8_STAGE(PG8_SA(1, 1), a1 + hstepA, voffA);
            PG8_WAIT_L(8); PG8_BAR; PG8_WAIT_L(0); PG8_MMA(0, 0, At, B0); PG8_BAR; PG8_SCHED;
            PG8_LDB(B1, 0, 1); PG8_STAGE(PG8_SB(0, 0), b2, voffB);
            PG8_BAR; PG8_WAIT_L(0); PG8_MMA(0, 1, At, B1); PG8_BAR;
            PG8_LDA(At, 0, 1); PG8_STAGE(PG8_SA(0, 0), a2, voffA);
            PG8_BAR; PG8_WAIT_L(0); PG8_MMA(1, 0, At, B0); PG8_BAR; PG8_SCHED;
            PG8_STAGE(PG8_SB(0, 1), b2 + hstepB, voffB);
            PG8_WAIT_V(6); PG8_BAR; PG8_MMA(1, 1, At, B1); PG8_BAR;
            PG8_LDB(B0, 1, 0); PG8_SCHED; PG8_LDA(At, 1, 0); PG8_STAGE(PG8_SA(0, 1), a2 + hstepA, voffA);
            PG8_WAIT_L(8); PG8_BAR; PG8_WAIT_L(0); PG8_MMA(0, 0, At, B0); PG8_BAR; PG8_SCHED;
            PG8_LDB(B1, 1, 1); PG8_STAGE(PG8_SB(1, 0), b3, voffB);
            PG8_BAR; PG8_WAIT_L(0); PG8_MMA(0, 1, At, B1); PG8_BAR;
            PG8_LDA(At, 1, 1); PG8_STAGE(PG8_SA(1, 0), a3, voffA);
            PG8_BAR; PG8_WAIT_L(0); PG8_MMA(1, 0, At, B0); PG8_BAR; PG8_SCHED;
            PG8_STAGE(PG8_SB(1, 1), b3 + hstepB, voffB);
            PG8_WAIT_V(6); PG8_BAR; PG8_MMA(1, 1, At, B1); PG8_BAR;
            }
        }
        if constexpr (ALIGN_EPI) { if (wr == 0) PG8_BAR; }
        if constexpr (!Epi::AFTER_DRAIN) { E(acc, cur, wr, wc, fr, fq); S.done(cur); }
        if (!has_next) break;
#pragma unroll
        for (int a = 0; a < 2; ++a)
#pragma unroll
            for (int b = 0; b < 2; ++b)
#pragma unroll
                for (int m = 0; m < 4; ++m)
#pragma unroll
                    for (int n = 0; n < 2; ++n) acc[a][b][m][n] = (f32x4){0.f, 0.f, 0.f, 0.f};
        cur = nxt; cA = nA; cB = nB; ++ui;
        if constexpr (ALIGN_EPI) { if (wr == 1) PG8_BAR; }
    }
    PG8_WAIT_V(0);
    if constexpr (!ALIGN_EPI) { if (wr == 0) PG8_BAR; }
    PG8_BAR;
    if constexpr (Epi::AFTER_DRAIN) { E.fused(acc, cur, wr, wc, fr, fq, lds, wid, lane); S.done(cur); }
#undef PG8_SA
#undef PG8_SB
#undef PG8_STAGE
#undef PG8_LDA
#undef PG8_LDB
#undef PG8_MMA
#undef PG8_WAIT_V
#undef PG8_WAIT_L
#undef PG8_BAR
#undef PG8_SCHED
}
}

using pg8::bf16_t; using pg8::bf16x8; using pg8::f32x4; using pg8::u32x4; using pg8::u32x2; using pg8::cvt_pk_bf16;
using pg8::NB; using pg8::SEQ; using pg8::DMODEL; using pg8::MTOK; using pg8::NMEMTOK; using pg8::LDP; using pg8::EPSN;
#define LAS __attribute__((address_space(3)))
typedef short s16x4 __attribute__((ext_vector_type(4)));
typedef float f32x2 __attribute__((ext_vector_type(2)));

constexpr int NTHREADS = 512, NWAVES = 8;
constexpr int LDS_BYTES = 147456;
constexpr int LDS_MISC = 139264;

constexpr size_t al256(size_t x) { return (x + 255) & ~(size_t)255; }
constexpr size_t WS_CTL   = 0;
constexpr size_t WS_WIN0  = 1u << 20;
constexpr size_t WS_WIN1  = WS_WIN0 + (size_t)4608 * 2048 * 2;
constexpr size_t WS_WIN2  = WS_WIN1 + (size_t)7168 * 2048 * 2;
constexpr size_t WS_WIN3  = WS_WIN2 + (size_t)5632 * 2048 * 2;
constexpr size_t WS_WOUT  = WS_WIN3 + (size_t)4608 * 2048 * 2;
constexpr size_t WS_WMEM  = WS_WOUT + (size_t)4 * 2048 * 2048 * 2;
constexpr size_t WS_HB    = WS_WMEM + (size_t)1024 * 2048 * 2;
constexpr size_t WS_PROJ  = WS_HB + (size_t)MTOK * 2048 * 2;
constexpr size_t WS_MEMB  = WS_PROJ + (size_t)MTOK * LDP * 2;
constexpr size_t WS_MKV   = WS_MEMB + (size_t)1024 * 2048 * 2;
constexpr size_t WS_RSS   = WS_MKV + (size_t)1024 * 1024 * 2;
constexpr size_t WS_RSSM  = WS_RSS + (size_t)5 * MTOK * 4;
constexpr size_t WS_ROPEA = WS_RSSM + 4096;
constexpr size_t WS_ROPEB = WS_ROPEA + (size_t)MTOK * 16 * 4;
constexpr size_t WS_ROPEC = WS_ROPEB + (size_t)MTOK * 32 * 4;
constexpr size_t WS_KMEAN = WS_ROPEC + (size_t)MTOK * 128 * 4;
constexpr size_t WS_RPREV = WS_KMEAN + (size_t)4 * 12 * 16 * 128 * 4;
constexpr size_t WS_END   = WS_RPREV + (size_t)4 * 32 * 6 * 256 * 128 * 2;

__constant__ double INVF[88] = {
 1.0, 0.19392274474868576, 0.03760603093086393, 0.007292664737217109, 0.001414213562373095, 0.0002742481756762073, 5.318295896944988e-05, 1.031338537721246e-05,
 1.0, 0.44036660267178046, 0.19392274474868576, 0.08539710028576561, 0.03760603093086393, 0.016560440080994446, 0.007292664737217109, 0.003211445994752591, 0.001414213562373095, 0.000622772421914596, 0.0002742481756762073, 0.00012076973741146504, 5.318295896944988e-05, 2.341999896140934e-05, 1.031338537721246e-05, 4.5416704806078695e-06,
 1.0, 0.8659643233600653, 0.7498942093324559, 0.6493816315762113, 0.5623413251903491, 0.4869675251658631, 0.4216965034285822, 0.3651741272548377, 0.31622776601683794, 0.27384196342643613, 0.23713737056616552, 0.2053525026457146, 0.1778279410038923, 0.1539926526059492, 0.1333521432163324, 0.11547819846894582, 0.1, 0.08659643233600653, 0.07498942093324558, 0.06493816315762113, 0.05623413251903491, 0.04869675251658631, 0.042169650342858224, 0.03651741272548377, 0.03162277660168379, 0.027384196342643614, 0.023713737056616554, 0.02053525026457146, 0.01778279410038923, 0.01539926526059492, 0.01333521432163324, 0.011547819846894581, 0.01, 0.008659643233600654, 0.007498942093324558, 0.006493816315762113, 0.005623413251903491, 0.004869675251658631, 0.004216965034285823, 0.003651741272548377, 0.0031622776601683794, 0.0027384196342643613, 0.0023713737056616554, 0.002053525026457146, 0.0017782794100389228, 0.001539926526059492, 0.001333521432163324, 0.0011547819846894581, 0.001, 0.0008659643233600654, 0.0007498942093324559, 0.0006493816315762113, 0.0005623413251903491, 0.0004869675251658631, 0.00042169650342858224, 0.0003651741272548377, 0.00031622776601683794, 0.0002738419634264361, 0.00023713737056616554, 0.0002053525026457146, 0.00017782794100389227, 0.0001539926526059492, 0.0001333521432163324, 0.00011547819846894582 };
__device__ __forceinline__ float log2gamma(int h) {
    return h == 0 ? -0.04580368961312479f : h == 1 ? -0.02612928206836121f : h == 2 ? -0.014949433599796901f : h == 3 ? -0.008567249848519122f : h == 4 ? -0.004914372264518986f : -0.002820519062378663f;
}

#define LDS_WAIT() asm volatile("s_waitcnt lgkmcnt(0)" ::: "memory")
__device__ __forceinline__ unsigned f2bf(float f) { unsigned u = __builtin_bit_cast(unsigned, f); return (u + 0x7fffu + ((u >> 16) & 1u)) >> 16; }
__device__ __forceinline__ unsigned pk2(float lo, float hi) { return f2bf(lo) | (f2bf(hi) << 16); }
__device__ __forceinline__ float bflo(unsigned w) { return __builtin_bit_cast(float, w << 16); }
__device__ __forceinline__ float bfhi(unsigned w) { return __builtin_bit_cast(float, w & 0xffff0000u); }
__device__ __forceinline__ float wave_sum(float v) {
#pragma unroll
    for (int o = 1; o < 64; o <<= 1) v += __shfl_xor(v, o);
    return v;
}
__device__ __forceinline__ float fexp2(float x) { return __builtin_amdgcn_exp2f(x); }
__device__ __forceinline__ s16x4 vtr(const LAS unsigned char* p) { return __builtin_bit_cast(s16x4, __builtin_amdgcn_ds_read_tr16_b64_v4i16((LAS s16x4*)p)); }
__device__ __forceinline__ bf16x8 cat8(s16x4 a, s16x4 b) { bf16x8 r; r[0] = a[0]; r[1] = a[1]; r[2] = a[2]; r[3] = a[3]; r[4] = b[0]; r[5] = b[1]; r[6] = b[2]; r[7] = b[3]; return r; }
typedef float f32x2_t __attribute__((ext_vector_type(2)));
typedef __bf16 bf16x2_t __attribute__((ext_vector_type(2)));
__device__ __forceinline__ unsigned cvtpk(float lo, float hi) { f32x2_t v = {lo, hi}; bf16x2_t b = __builtin_convertvector(v, bf16x2_t); return __builtin_bit_cast(unsigned, b); }
__device__ __forceinline__ float xmax16(float x) { const auto r = __builtin_amdgcn_permlane16_swap(__builtin_bit_cast(unsigned, x), __builtin_bit_cast(unsigned, x), false, false); return fmaxf(__builtin_bit_cast(float, r[0]), __builtin_bit_cast(float, r[1])); }
__device__ __forceinline__ float xmax32(float x) { const auto r = __builtin_amdgcn_permlane32_swap(__builtin_bit_cast(unsigned, x), __builtin_bit_cast(unsigned, x), false, false); return fmaxf(__builtin_bit_cast(float, r[0]), __builtin_bit_cast(float, r[1])); }
__device__ __forceinline__ bf16x8 pack8s(f32x4 a, f32x4 b) { u32x4 w; w.x = cvtpk(a[0], a[1]); w.y = cvtpk(a[2], a[3]); w.z = cvtpk(b[0], b[1]); w.w = cvtpk(b[2], b[3]); return __builtin_bit_cast(bf16x8, w); }
__device__ __forceinline__ bf16x8 pack8(f32x4 a, f32x4 b) { u32x4 w; w.x = cvt_pk_bf16(a[0], a[1]); w.y = cvt_pk_bf16(a[2], a[3]); w.z = cvt_pk_bf16(b[0], b[1]); w.w = cvt_pk_bf16(b[2], b[3]); return __builtin_bit_cast(bf16x8, w); }
__device__ __forceinline__ float silu_mul(float o, float z) { return o * z * __builtin_amdgcn_rcpf(1.0f + fexp2(-1.4426950408889634f * z)); }

__device__ __forceinline__ void transpose_item(const float* W, int N, int mid, const float* gvec, bf16_t* WT, int nblk, int item, int lane, LAS float* scr) {
    const int kb = item / nblk, nb = item % nblk, k0 = 64 * kb, n0 = 64 * nb;
    const int c4 = lane & 15, r4 = lane >> 4, j = n0 + 4 * c4;
    const int sc = (mid < 0) ? j : pg8::src_col(mid, j);
    f32x4 v[16];
#pragma unroll
    for (int i = 0; i < 16; ++i) { v[i] = (f32x4){0.f, 0.f, 0.f, 0.f}; if (sc >= 0) v[i] = *(const f32x4*)(W + (size_t)(k0 + 4 * i + r4) * N + sc); }
#pragma unroll
    for (int i = 0; i < 16; ++i) { const int kk = 4 * i + r4; const float gk = gvec ? gvec[k0 + kk] : 1.0f; LAS float* d = scr + kk * 65 + 4 * c4;
        d[0] = v[i][0] * gk; d[1] = v[i][1] * gk; d[2] = v[i][2] * gk; d[3] = v[i][3] * gk; }
    LDS_WAIT(); asm volatile("" ::: "memory");
    const int c = lane & 7;
#pragma unroll
    for (int jj = 0; jj < 8; ++jj) { const int n = (lane >> 3) + 8 * jj; const LAS float* sp = scr + (8 * c) * 65 + n;
        u32x4 o; o.x = pk2(sp[0 * 65], sp[1 * 65]); o.y = pk2(sp[2 * 65], sp[3 * 65]); o.z = pk2(sp[4 * 65], sp[5 * 65]); o.w = pk2(sp[6 * 65], sp[7 * 65]);
        *(u32x4*)(WT + (size_t)(n0 + n) * 2048 + k0 + 8 * c) = o; }
    LDS_WAIT(); asm volatile("" ::: "memory");
}
__device__ __forceinline__ void row_to_bf16(const float* xrow, bf16_t* orow, float* rss, int lane) {
    const f32x4* xr = (const f32x4*)xrow + lane; float s = 0.f;
    u32x2* o8 = (u32x2*)orow + lane;
#pragma unroll
    for (int j = 0; j < 8; ++j) { const f32x4 v = xr[64 * j]; s += (v.x * v.x + v.y * v.y) + (v.z * v.z + v.w * v.w);
        u32x2 w; w.x = pk2(v.x, v.y); w.y = pk2(v.z, v.w); o8[64 * j] = w; }
    s = wave_sum(s);
    if (lane == 0) *rss = s;
}

enum { MODE_SWA = 0, MODE_MOBA = 1, MODE_MEM = 2 };
template <int DH, int MODE>
__device__ __forceinline__ void attn_unit(LAS unsigned char* lds, int tid, int wid, int lane,
        const bf16_t* Q,
        int qrow0,
        const bf16_t* Kb, const bf16_t* Vb, int ldkv,
        int nt, int krow_a, int krow_b,
        float m_init, float l_init, unsigned sel0, unsigned sel1,
        bf16_t* Zy,
        bool dry = false)
{
    asm volatile("" : "+v"(tid), "+v"(lane)); asm volatile("" : "+s"(wid));
    constexpr int KSTR = DH * 2 + 16, VSTR = DH * 2 + 32, KBYTES = 64 * KSTR, VBYTES = 64 * VSTR, STG = KBYTES + VBYTES;
    constexpr int CPR = DH / 8  , CPT = (64 * CPR) / NTHREADS  ;
    constexpr int NK = DH / 32, NDB = DH / 16;
    const int g = lane >> 4, l15 = lane & 15, q4 = l15 >> 2, p4 = l15 & 3;
    bf16x8 Qf[2][NK];
#pragma unroll
    for (int j = 0; j < 2; ++j)
#pragma unroll
        for (int k = 0; k < NK; ++k) Qf[j][k] = *(const bf16x8*)(Q + (size_t)(qrow0 + j * 16 + l15) * LDP + k * 32 + g * 8);
    f32x4 O[NDB][2];
#pragma unroll
    for (int db = 0; db < NDB; ++db) { O[db][0] = (f32x4){0.f, 0.f, 0.f, 0.f}; O[db][1] = (f32x4){0.f, 0.f, 0.f, 0.f}; }
    const float m0 = (MODE == MODE_SWA) ? m_init : 0.f;
    float mrow[2] = {m0, m0}, lrow[2] = {g == 0 ? l_init : 0.f, g == 0 ? l_init : 0.f};
    bool first = (MODE != MODE_SWA);
    const unsigned sel[2] = {sel0, sel1};

    u32x4 kreg[2][CPT], vreg[2][CPT];
#define ATT_KROW(it) ((MODE == MODE_MOBA && (it) >= 4) ? (krow_b + 64 * ((it) - 4)) : (krow_a + 64 * (it)))
#define ATT_ISSUE(hf_, it) do { const int kr_ = ATT_KROW(it); _Pragma("unroll") for (int i_ = 0; i_ < CPT; ++i_) { const int c_ = tid + NTHREADS * i_, r_ = c_ / CPR, cc_ = c_ % CPR; \
        kreg[hf_][i_] = *(const u32x4*)(Kb + (size_t)(kr_ + r_) * ldkv + cc_ * 8); vreg[hf_][i_] = *(const u32x4*)(Vb + (size_t)(kr_ + r_) * ldkv + cc_ * 8); } } while (0)
    constexpr bool PF2 = false;
    if (wid >= 4) __builtin_amdgcn_s_setprio(1);
    ATT_ISSUE(0, 0);
    if (PF2 && nt > 1) ATT_ISSUE(1, 1);
    for (int it0 = 0; it0 < nt; it0 += 2) {
#pragma unroll
      for (int hf = 0; hf < 2; ++hf) {
        const int it = it0 + hf;
        if (it >= nt) break;
        LAS unsigned char* Kt = lds + hf * STG; LAS unsigned char* Vt = Kt + KBYTES;
#pragma unroll
        for (int i = 0; i < CPT; ++i) { const int c = tid + NTHREADS * i, r = c / CPR, cc = c % CPR;
            *(LAS u32x4*)(Kt + r * KSTR + cc * 16) = kreg[PF2 ? hf : 0][i]; *(LAS u32x4*)(Vt + r * VSTR + cc * 16) = vreg[PF2 ? hf : 0][i]; }
        if (PF2) { if (it + 2 < nt) ATT_ISSUE(hf, it + 2); } else { if (it + 1 < nt) ATT_ISSUE(0, it + 1); }
        __syncthreads();
        const int kp = ATT_KROW(it);
        bool active = true;
        if (MODE == MODE_SWA) active = !(kp > qrow0 + 31 || kp + 63 <= qrow0 - 128);
        if (MODE == MODE_MOBA) active = !(kp > qrow0 + 31);
        if (active) {
            f32x4 S[4][2];
            float sinit[2] = {-mrow[0], -mrow[1]};
            if (MODE == MODE_MOBA && it >= 4) {
                const int pb = (it - 4) >> 2;
                sinit[0] = ((sel[0] >> pb) & 1u) ? sinit[0] : -INFINITY; sinit[1] = ((sel[1] >> pb) & 1u) ? sinit[1] : -INFINITY;
            }
#pragma unroll
            for (int kb = 0; kb < 4; ++kb) { S[kb][0] = (f32x4){sinit[0], sinit[0], sinit[0], sinit[0]}; S[kb][1] = (f32x4){sinit[1], sinit[1], sinit[1], sinit[1]}; }
#pragma unroll
            for (int kb = 0; kb < 4; ++kb) {
#pragma unroll
                for (int k = 0; k < NK; ++k) {
                    const bf16x8 a = *(const LAS bf16x8*)(Kt + (kb * 16 + l15) * KSTR + (k * 32 + g * 8) * 2);
                    S[kb][0] = __builtin_amdgcn_mfma_f32_16x16x32_bf16(a, Qf[0][k], S[kb][0], 0, 0, 0);
                    S[kb][1] = __builtin_amdgcn_mfma_f32_16x16x32_bf16(a, Qf[1][k], S[kb][1], 0, 0, 0);
                }
                if (kb & 1) __builtin_amdgcn_sched_barrier(0);
            }
            bf16x8 Pb[2][2];
#pragma unroll
            for (int j = 0; j < 2; ++j) {
                const int qi = qrow0 + j * 16 + l15;
                if (MODE == MODE_SWA) {
                    if (!(kp + 63 <= qrow0 && kp > qrow0 + 31 - 128)) {
                        const unsigned dbase = (unsigned)(qi - kp - 4 * g);
#pragma unroll
                        for (int kb = 0; kb < 4; ++kb)
#pragma unroll
                            for (int i = 0; i < 4; ++i) S[kb][j][i] = ((dbase - (unsigned)(kb * 16 + i)) < 128u) ? S[kb][j][i] : -INFINITY;
                    }
                } else if (MODE == MODE_MOBA) {
                    if (kp + 63 > qrow0) {
#pragma unroll
                        for (int kb = 0; kb < 4; ++kb)
#pragma unroll
                            for (int i = 0; i < 4; ++i) S[kb][j][i] = ((qi - kp - 4 * g) >= (kb * 16 + i)) ? S[kb][j][i] : -INFINITY;
                    }
                }
                float mx = -INFINITY;
#pragma unroll
                for (int kb = 0; kb < 4; ++kb) mx = fmaxf(mx, fmaxf(fmaxf(S[kb][j][0], S[kb][j][1]), fmaxf(S[kb][j][2], S[kb][j][3])));
                mx = xmax16(mx); mx = xmax32(mx);
                const bool need = (first && mx > -INFINITY) || (mx > 8.0f);
                if (__builtin_amdgcn_ballot_w64(need) != 0ull) {
                    const float dlt = need ? mx : 0.f, alpha = fexp2(-dlt);
#pragma unroll
                    for (int kb = 0; kb < 4; ++kb) S[kb][j] = S[kb][j] - dlt;
                    mrow[j] += dlt; lrow[j] *= alpha;
#pragma unroll
                    for (int db = 0; db < NDB; ++db) O[db][j] = O[db][j] * alpha;
                }
                float ps = 0.f;
#pragma unroll
                for (int kb = 0; kb < 4; ++kb)
#pragma unroll
                    for (int i = 0; i < 4; ++i) { const float p = fexp2(S[kb][j][i]); S[kb][j][i] = p; ps += p; }
                lrow[j] += ps;
                Pb[j][0] = pack8s(S[0][j], S[1][j]); Pb[j][1] = pack8s(S[2][j], S[3][j]);
            }
#pragma unroll
            for (int s = 0; s < 2; ++s)
#pragma unroll
                for (int db = 0; db < NDB; ++db) {
                    const s16x4 lo = vtr(Vt + (32 * s + 4 * g + q4) * VSTR + (16 * db + 4 * p4) * 2);
                    const s16x4 hi = vtr(Vt + (32 * s + 16 + 4 * g + q4) * VSTR + (16 * db + 4 * p4) * 2);
                    const bf16x8 a = cat8(lo, hi);
                    O[db][0] = __builtin_amdgcn_mfma_f32_16x16x32_bf16(a, Pb[0][s], O[db][0], 0, 0, 0);
                    O[db][1] = __builtin_amdgcn_mfma_f32_16x16x32_bf16(a, Pb[1][s], O[db][1], 0, 0, 0);
                    if ((db & 3) == 3) __builtin_amdgcn_sched_barrier(0);
                }
            first = false;
        }
      }
    }
#undef ATT_ISSUE
#undef ATT_KROW
    __builtin_amdgcn_s_setprio(0);
#pragma unroll
    for (int j = 0; j < 2; ++j) {
        float l = lrow[j]; l += __shfl_xor(l, 16); l += __shfl_xor(l, 32);
        const float inv = 1.0f / l;
        bf16_t* zp = Zy + (size_t)(qrow0 + j * 16 + l15) * LDP + 4 * g;
#pragma unroll
        for (int db = 0; db < NDB; ++db) {
            const u32x2 z = *(const u32x2*)(zp + 16 * db);
            const f32x4 o = O[db][j] * inv;
            u32x2 w; w.x = cvt_pk_bf16(silu_mul(o[0], bflo(z.x)), silu_mul(o[1], bfhi(z.x))); w.y = cvt_pk_bf16(silu_mul(o[2], bflo(z.y)), silu_mul(o[3], bfhi(z.y)));
            if (!dry) *(u32x2*)(zp + 16 * db) = w;
        }
    }
    __syncthreads();
}

__device__ __forceinline__ void moba_gate(LAS unsigned char* lds, int tid, const bf16_t* proj, const float* kmean, int b, int h, int qb) {
    asm volatile("" : "+v"(tid));
    LAS float* km = (LAS float*)lds;
    LAS unsigned* selm = (LAS unsigned*)(lds + LDS_MISC - 2048);
    for (int i = tid; i < 16 * 128; i += NTHREADS) km[i] = kmean[(size_t)((b * 12 + h) * 16) * 128 + i];
    __syncthreads();
    const int q = tid >> 1, half = tid & 1;
    const bf16_t* qp = proj + (size_t)(b * SEQ + qb * 256 + q) * LDP + h * 128 + half * 64;
    float gsc[15];
#pragma unroll
    for (int n = 0; n < 15; ++n) gsc[n] = 0.f;
#pragma unroll 1
    for (int c = 0; c < 8; ++c) {
        const u32x4 w = *(const u32x4*)(qp + c * 8);
        float qv[8] = {bflo(w.x), bfhi(w.x), bflo(w.y), bfhi(w.y), bflo(w.z), bfhi(w.z), bflo(w.w), bfhi(w.w)};
#pragma unroll
        for (int n = 0; n < 15; ++n) if (n < qb) {
            const LAS float* kr = km + n * 128 + half * 64 + c * 8;
#pragma unroll
            for (int e = 0; e < 8; ++e) gsc[n] += qv[e] * kr[e];
        }
    }
    unsigned mask = 0u;
#pragma unroll
    for (int n = 0; n < 15; ++n) { gsc[n] += __shfl_xor(gsc[n], 1); if (n >= qb) gsc[n] = -INFINITY; }
#pragma unroll
    for (int r = 0; r < 3; ++r) {
        float best = -INFINITY; int bi = -1;
#pragma unroll
        for (int n = 0; n < 15; ++n) { const bool taken = (mask >> n) & 1u; if (!taken && gsc[n] > best) { best = gsc[n]; bi = n; } }
        if (bi >= 0) mask |= 1u << bi;
    }
    if (half == 0) selm[q] = mask;
    __syncthreads();
}

__device__ __forceinline__ void kmean_unit(LAS unsigned char* lds, int tid, const bf16_t* proj, float* kmean, int u) {
    asm volatile("" : "+v"(tid));
    const int blk = u & 15, bh = u >> 4, b = bh / 12, h = bh % 12;
    const int cc = tid & 15, kg = tid >> 4;
    float s[8] = {0.f, 0.f, 0.f, 0.f, 0.f, 0.f, 0.f, 0.f};
    const bf16_t* kp = proj + (size_t)(b * SEQ + blk * 256 + kg * 8) * LDP + 1536 + h * 128 + cc * 8;
#pragma unroll
    for (int r = 0; r < 8; ++r) { const u32x4 w = *(const u32x4*)(kp + (size_t)r * LDP);
        s[0] += bflo(w.x); s[1] += bfhi(w.x); s[2] += bflo(w.y); s[3] += bfhi(w.y); s[4] += bflo(w.z); s[5] += bfhi(w.z); s[6] += bflo(w.w); s[7] += bfhi(w.w); }
    LAS float* red = (LAS float*)lds;
#pragma unroll
    for (int e = 0; e < 8; ++e) red[kg * 128 + cc * 8 + e] = s[e];
    __syncthreads();
    if (tid < 128) { float a = 0.f;
#pragma unroll 8
        for (int k = 0; k < 32; ++k) a += red[k * 128 + tid];
        kmean[(size_t)u * 128 + tid] = a * (1.0f / 256.0f); }
    __syncthreads();
}

__device__ __forceinline__ void ret_scan_item(LAS unsigned char* lds, int tid, int wid, int lane, const bf16_t* proj, bf16_t* rprev, int item) {
    asm volatile("" : "+v"(tid), "+v"(lane)); asm volatile("" : "+s"(wid));
    constexpr int KS = 288, VS = 96, KB = 128 * KS, STG = KB + 128 * VS;
    const int es = item & 7, bh = item >> 3, b = bh / 6, h = bh % 6;
    const float lg = log2gamma(h), gchunk = fexp2(128.f * lg);
    const int g = lane >> 4, l15 = lane & 15, q4 = l15 >> 2, p4 = l15 & 3;
    const bf16_t* kbase = proj + (size_t)(b * SEQ) * LDP + 768 + h * 128;
    const bf16_t* vbase = proj + (size_t)(b * SEQ) * LDP + 1536 + h * 256 + es * 32;
    f32x4 R[2] = {(f32x4){0.f, 0.f, 0.f, 0.f}, (f32x4){0.f, 0.f, 0.f, 0.f}};
    u32x4 kreg[4], vreg;
#define RS_ISSUE(n) do { _Pragma("unroll") for (int i_ = 0; i_ < 4; ++i_) { const int c_ = tid + NTHREADS * i_; kreg[i_] = *(const u32x4*)(kbase + (size_t)((n) * 128 + (c_ >> 4)) * LDP + (c_ & 15) * 8); } \
        vreg = *(const u32x4*)(vbase + (size_t)((n) * 128 + (tid >> 2)) * LDP + (tid & 3) * 8); } while (0)
    RS_ISSUE(0);
    for (int n = 0; n < 32; ++n) {
        bf16_t* rp = rprev + ((size_t)((b * 32 + n) * 6 + h) * 256 + es * 32 + l15) * 128 + wid * 16 + 4 * g;
#pragma unroll
        for (int eb = 0; eb < 2; ++eb) { u32x2 w; w.x = cvt_pk_bf16(R[eb][0], R[eb][1]); w.y = cvt_pk_bf16(R[eb][2], R[eb][3]); *(u32x2*)(rp + (size_t)eb * 16 * 128) = w; }
        if (n == 31) break;
        LAS unsigned char* Kt = lds + (n & 1) * STG; LAS unsigned char* Vt = Kt + KB;
#pragma unroll
        for (int i = 0; i < 4; ++i) { const int c = tid + NTHREADS * i, t = c >> 4, cc = c & 15;
            const float zt = fexp2((float)(127 - t) * lg);
            const u32x4 w = kreg[i]; u32x4 o;
            o.x = cvt_pk_bf16(bflo(w.x) * zt, bfhi(w.x) * zt); o.y = cvt_pk_bf16(bflo(w.y) * zt, bfhi(w.y) * zt); o.z = cvt_pk_bf16(bflo(w.z) * zt, bfhi(w.z) * zt); o.w = cvt_pk_bf16(bflo(w.w) * zt, bfhi(w.w) * zt);
            *(LAS u32x4*)(Kt + t * KS + cc * 16) = o; }
        *(LAS u32x4*)(Vt + (tid >> 2) * VS + (tid & 3) * 16) = vreg;
        __syncthreads();
        if (n + 1 < 31) RS_ISSUE(n + 1);
        R[0] = R[0] * gchunk; R[1] = R[1] * gchunk;
#pragma unroll
        for (int s = 0; s < 4; ++s) {
            const bf16x8 a = cat8(vtr(Kt + (32 * s + 8 * g + q4) * KS + (16 * wid + 4 * p4) * 2), vtr(Kt + (32 * s + 8 * g + 4 + q4) * KS + (16 * wid + 4 * p4) * 2));
#pragma unroll
            for (int eb = 0; eb < 2; ++eb) {
                const bf16x8 bb = cat8(vtr(Vt + (32 * s + 8 * g + q4) * VS + (16 * eb + 4 * p4) * 2), vtr(Vt + (32 * s + 8 * g + 4 + q4) * VS + (16 * eb + 4 * p4) * 2));
                R[eb] = __builtin_amdgcn_mfma_f32_16x16x32_bf16(a, bb, R[eb], 0, 0, 0);
            }
        }
    }
#undef RS_ISSUE
    __syncthreads();
}

__device__ __forceinline__ void ret_out_unit(LAS unsigned char* lds, int tid, int wid, int lane, bf16_t* proj, const bf16_t* rprev, int u, bool dry = false) {
    asm volatile("" : "+v"(tid), "+v"(lane)); asm volatile("" : "+s"(wid));
    constexpr int KS = 272, VS = 544, KB = 128 * KS;
    const int h = u % 6, bn = u / 6, n = bn & 31, b = bn >> 5;
    const float lg = log2gamma(h);
    const int g = lane >> 4, l15 = lane & 15, q4 = l15 >> 2, p4 = l15 & 3;
    const int row0 = b * SEQ + n * 128;
    LAS unsigned char* Kt = lds; LAS unsigned char* Vt = lds + KB;
    const bf16_t* kbase = proj + (size_t)row0 * LDP + 768 + h * 128;
    const bf16_t* vbase = proj + (size_t)row0 * LDP + 1536 + h * 256;
#pragma unroll
    for (int i = 0; i < 4; ++i) { const int c = tid + NTHREADS * i, t = c >> 4, cc = c & 15; *(LAS u32x4*)(Kt + t * KS + cc * 16) = *(const u32x4*)(kbase + (size_t)t * LDP + cc * 8); }
#pragma unroll
    for (int i = 0; i < 8; ++i) { const int c = tid + NTHREADS * i, t = c >> 5, cc = c & 31; *(LAS u32x4*)(Vt + t * VS + cc * 16) = *(const u32x4*)(vbase + (size_t)t * LDP + cc * 8); }
    const int qrow = row0 + wid * 16 + l15;
    bf16x8 Qf[4];
#pragma unroll
    for (int k = 0; k < 4; ++k) Qf[k] = *(const bf16x8*)(proj + (size_t)qrow * LDP + h * 128 + k * 32 + g * 8);
    u32x4 rreg[8];
    const bf16_t* rbase = rprev + (size_t)((b * 32 + n) * 6 + h) * 256 * 128;
#pragma unroll
    for (int i = 0; i < 8; ++i) { const int c = tid + NTHREADS * i; rreg[i] = *(const u32x4*)(rbase + (size_t)c * 8); }
    __syncthreads();
    f32x4 S[8];
#pragma unroll
    for (int kb = 0; kb < 8; ++kb) S[kb] = (f32x4){0.f, 0.f, 0.f, 0.f};
#pragma unroll
    for (int kb = 0; kb < 8; ++kb) if (kb <= wid) {
#pragma unroll
        for (int k = 0; k < 4; ++k) {
            const bf16x8 a = *(const LAS bf16x8*)(Kt + (kb * 16 + l15) * KS + (k * 32 + g * 8) * 2);
            S[kb] = __builtin_amdgcn_mfma_f32_16x16x32_bf16(a, Qf[k], S[kb], 0, 0, 0);
        }
    }
    const int tq = wid * 16 + l15;
    bf16x8 Pb[4];
#pragma unroll
    for (int kb = 0; kb < 8; ++kb)
#pragma unroll
        for (int i = 0; i < 4; ++i) { const int tk = kb * 16 + 4 * g + i; S[kb][i] = (tk <= tq) ? S[kb][i] * fexp2(-(float)(tk + 1) * lg) : 0.f; }
#pragma unroll
    for (int s = 0; s < 4; ++s) Pb[s] = pack8(S[2 * s], S[2 * s + 1]);
    f32x4 O[16];
#pragma unroll
    for (int eb = 0; eb < 16; ++eb) O[eb] = (f32x4){0.f, 0.f, 0.f, 0.f};
#pragma unroll
    for (int s = 0; s < 4; ++s) if (2 * s <= wid) {
#pragma unroll
        for (int eb = 0; eb < 16; ++eb) {
            const bf16x8 a = cat8(vtr(Vt + (32 * s + 4 * g + q4) * VS + (16 * eb + 4 * p4) * 2), vtr(Vt + (32 * s + 16 + 4 * g + q4) * VS + (16 * eb + 4 * p4) * 2));
            O[eb] = __builtin_amdgcn_mfma_f32_16x16x32_bf16(a, Pb[s], O[eb], 0, 0, 0);
        }
    }
    __syncthreads();
#pragma unroll
    for (int i = 0; i < 8; ++i) { const int c = tid + NTHREADS * i; *(LAS u32x4*)(Vt + (c >> 4) * KS + (c & 15) * 16) = rreg[i]; }
    __syncthreads();
#pragma unroll
    for (int eb = 0; eb < 16; ++eb)
#pragma unroll
        for (int k = 0; k < 4; ++k) {
            const bf16x8 a = *(const LAS bf16x8*)(Vt + (eb * 16 + l15) * KS + (k * 32 + g * 8) * 2);
            O[eb] = __builtin_amdgcn_mfma_f32_16x16x32_bf16(a, Qf[k], O[eb], 0, 0, 0);
        }
    const float xi = fexp2((float)(tq + 1) * lg);
    float ss = 0.f;
#pragma unroll
    for (int eb = 0; eb < 16; ++eb) { O[eb] = O[eb] * xi; ss += (O[eb][0] * O[eb][0] + O[eb][1] * O[eb][1]) + (O[eb][2] * O[eb][2] + O[eb][3] * O[eb][3]); }
    ss += __shfl_xor(ss, 16); ss += __shfl_xor(ss, 32);
    const float rstd = __builtin_amdgcn_rsqf(ss * (1.0f / 256.0f) + EPSN);
    bf16_t* zp = proj + (size_t)qrow * LDP + 3584 + h * 256 + 4 * g;
#pragma unroll
    for (int eb = 0; eb < 16; ++eb) {
        const u32x2 z = *(const u32x2*)(zp + 16 * eb);
        const f32x4 o = O[eb] * rstd;
        u32x2 w; w.x = cvt_pk_bf16(silu_mul(o[0], bflo(z.x)), silu_mul(o[1], bfhi(z.x))); w.y = cvt_pk_bf16(silu_mul(o[2], bflo(z.y)), silu_mul(o[3], bfhi(z.y)));
        if (!dry) *(u32x2*)(zp + 16 * eb) = w;
    }
    __syncthreads();
}

#define XB_TMO      128
#define XB_XCNT(j)  (256  + 64 * (j))
#define XB_XSUB(j)  (1280 + 64 * (j))
#define XB_XGEN(j)  (2304 + 64 * (j))
#define XB_TOP      3328
#define XB_TOPGEN   3392
#define XCD_BAR_WORDS 3456
#define XB_SPIN_CAP (1u << 18)

__device__ __forceinline__ unsigned xb_ld(unsigned* p)              { return __hip_atomic_load(p, __ATOMIC_RELAXED, __HIP_MEMORY_SCOPE_AGENT); }
__device__ __forceinline__ unsigned xb_add(unsigned* p, unsigned v) { return __hip_atomic_fetch_add(p, v, __ATOMIC_RELAXED, __HIP_MEMORY_SCOPE_AGENT); }
__device__ __forceinline__ unsigned xb_xcc_id() { return (unsigned)__builtin_amdgcn_s_getreg((3 << 11) | 20) & 0xFu; }
#define XB_SPIN(cond, bar) do { unsigned _sp = 0; while (cond) { __builtin_amdgcn_s_sleep(1); \
    if ((++_sp & 255u) == 0u) { if (xb_ld(&(bar)[XB_TMO])) break; if (_sp > XB_SPIN_CAP) { atomicAdd(&(bar)[XB_TMO], 1u); break; } } } } while (0)

struct XcdBarrier {
    unsigned* bar; unsigned x;
    volatile LAS unsigned* st;
};

__device__ __forceinline__ XcdBarrier xcd_barrier_post(unsigned* bar, volatile LAS unsigned* st) {
    XcdBarrier b; b.bar = bar; b.x = xb_xcc_id(); b.st = st;
    if (threadIdx.x == 0) (void)xb_add(&bar[XB_XCNT(b.x)], 1u);
    return b;
}
__device__ __forceinline__ void xcd_barrier_complete(unsigned* bar, unsigned x, unsigned& nloc, unsigned& nx) {
    const unsigned G = gridDim.x * gridDim.y * gridDim.z;
    unsigned sum, cnt, mine, sp = 0u;
    for (;;) {
        sum = 0u; cnt = 0u; mine = 0u;
#pragma unroll
        for (unsigned j = 0; j < 16; ++j) { const unsigned c = xb_ld(&bar[XB_XCNT(j)]); sum += c; cnt += (c > 0u) ? 1u : 0u; mine = (j == x) ? c : mine; }
        if (sum == G) break;
        __builtin_amdgcn_s_sleep(1);
        if ((++sp & 255u) == 0u) { if (xb_ld(&bar[XB_TMO])) break; if (sp > XB_SPIN_CAP) { atomicAdd(&bar[XB_TMO], 1u); break; } }
    }
    nloc = mine > 0u ? mine : 1u; nx = cnt > 0u ? cnt : 1u;
}

__device__ __forceinline__ void xcd_barrier(const XcdBarrier& b) {
    asm volatile("s_waitcnt vmcnt(0)" ::: "memory");
    __syncthreads();
    if (threadIdx.x == 0) {
        unsigned* bar = b.bar;
        __builtin_amdgcn_s_waitcnt(0);
        unsigned nloc = b.st[0], nx = b.st[1];
        if (nloc == 0u) { xcd_barrier_complete(bar, b.x, nloc, nx); b.st[0] = nloc; b.st[1] = nx; }
        const unsigned old = xb_add(&bar[XB_XSUB(b.x)], 1u);
        const unsigned gen = old / nloc;
        if (old + 1u == (gen + 1u) * nloc) {
            __builtin_amdgcn_fence(__ATOMIC_RELEASE, "agent");
            asm volatile("s_waitcnt vmcnt(0)" ::: "memory");
            const unsigned og = xb_add(&bar[XB_TOP], 1u);
            const unsigned tg = og / nx;
            if (og + 1u == (tg + 1u) * nx) xb_add(&bar[XB_TOPGEN], 1u);
            else XB_SPIN(xb_ld(&bar[XB_TOPGEN]) == tg, bar);
            __builtin_amdgcn_fence(__ATOMIC_ACQUIRE, "agent");
            xb_add(&bar[XB_XGEN(b.x)], 1u);
            asm volatile("s_waitcnt vmcnt(0)" ::: "memory");
        } else {
            XB_SPIN(xb_ld(&bar[XB_XGEN(b.x)]) == gen, bar);
            __builtin_amdgcn_fence(__ATOMIC_ACQUIRE, "agent");
            asm volatile("s_waitcnt vmcnt(0)" ::: "memory");
        }
    }
    __syncthreads();
}


#define CONV_WEIGHTS(MASK, worker, nworkers) do { \
        int lane_ = lane, wid_ = wid; asm volatile("" : "+v"(lane_)); asm volatile("" : "+s"(wid_)); LAS float* scr_ = (LAS float*)(lds + wid_ * 16640); \
        int total_ = 0; \
        _Pragma("unroll 1") for (int mi_ = 0; mi_ < 9; ++mi_) if (((MASK) >> mi_) & 1u) total_ += 32 * (mi_ < 4 ? pg8::npad_of(mi_ == 3 ? 0 : mi_) / 64 : (mi_ < 8 ? 32 : 16)); \
        for (int it_ = (worker); it_ < total_; it_ += (nworkers)) { \
            int r_ = it_; \
            _Pragma("unroll 1") for (int mi = 0; mi < 9; ++mi) { \
                if (!(((MASK) >> mi) & 1u)) continue; \
                const float* W; int N, mid_, nblk; const float* gv; bf16_t* WT; \
                if (mi < 4) { const int l_ = mi; mid_ = l_ == 3 ? 0 : l_; N = pg8::nc_of(mid_); nblk = pg8::npad_of(mid_) / 64; \
                    W = args.in[l_ == 0 ? 6 : l_ == 1 ? 10 : l_ == 2 ? 13 : 16]; gv = args.in[l_ == 0 ? 5 : l_ == 1 ? 9 : l_ == 2 ? 12 : 15]; \
                    WT = (bf16_t*)(ws + (l_ == 0 ? WS_WIN0 : l_ == 1 ? WS_WIN1 : l_ == 2 ? WS_WIN2 : WS_WIN3)); } \
                else if (mi < 8) { const int l_ = mi - 4; mid_ = -1; N = 2048; nblk = 32; W = args.in[l_ == 0 ? 8 : l_ == 1 ? 11 : l_ == 2 ? 14 : 18]; gv = nullptr; WT = woutT + (size_t)l_ * 2048 * 2048; } \
                else { mid_ = -1; N = 1024; nblk = 16; W = args.in[4]; gv = args.in[3]; WT = wmemT; } \
                const int cnt_ = 32 * nblk; \
                if (r_ < cnt_) { transpose_item(W, N, mid_, gv, WT, nblk, r_, lane_, scr_); break; } \
                r_ -= cnt_; \
            } \
        } } while (0)

struct Args { const float* in[20]; float* out; unsigned char* ws; };

__device__ __forceinline__ int fetch_unit(unsigned* ctr, volatile LAS unsigned* slot, int tid) {
    if (tid == 0) *slot = atomicAdd(ctr, 1u);
    __syncthreads();
    const unsigned v = *slot;
    __syncthreads();
    return __builtin_amdgcn_readfirstlane((int)v);
}

__global__ void __launch_bounds__(NTHREADS, 2) trunk_fwd(Args args) {
    extern __shared__ __attribute__((aligned(16))) unsigned char lds_raw[];
    cg::grid_group grid = cg::this_grid();
    LAS unsigned char* lds = (LAS unsigned char*)lds_raw;
    volatile LAS unsigned* misc = (volatile LAS unsigned*)(lds + LDS_MISC);
    const int tid = threadIdx.x, lane = tid & 63, wid = __builtin_amdgcn_readfirstlane(tid >> 6);
    const int G = gridDim.x, bx = blockIdx.x;
#define WS_PTRS() unsigned char* ws = args.ws; asm volatile("" : "+s"(ws)); \
    unsigned* ctl = (unsigned*)(ws + WS_CTL); bf16_t* hb = (bf16_t*)(ws + WS_HB); bf16_t* proj = (bf16_t*)(ws + WS_PROJ); \
    bf16_t* memb = (bf16_t*)(ws + WS_MEMB); bf16_t* mkv = (bf16_t*)(ws + WS_MKV); float* rss = (float*)(ws + WS_RSS); float* rssm = (float*)(ws + WS_RSSM); \
    float* ropeA = (float*)(ws + WS_ROPEA); float* ropeB = (float*)(ws + WS_ROPEB); float* ropeC = (float*)(ws + WS_ROPEC); \
    float* kmean = (float*)(ws + WS_KMEAN); bf16_t* rprev = (bf16_t*)(ws + WS_RPREV); bf16_t* woutT = (bf16_t*)(ws + WS_WOUT); bf16_t* wmemT = (bf16_t*)(ws + WS_WMEM); \
    (void)ctl; (void)hb; (void)proj; (void)memb; (void)mkv; (void)rss; (void)rssm; (void)ropeA; (void)ropeB; (void)ropeC; (void)kmean; (void)rprev; (void)woutT; (void)wmemT
#ifndef REP_P0
#define REP_P0 1
#endif
    for (int rep0 = 0; rep0 < REP_P0; ++rep0) {
        if (rep0) grid.sync();
        WS_PTRS(); const float* x = args.in[0];
        const int gw = bx * NWAVES + wid, NGW = G * NWAVES;
        LAS float* scr = (LAS float*)(lds + wid * 16640);
        if (G == 256) CONV_WEIGHTS(0x111u, gw, NGW); else CONV_WEIGHTS(0x1FFu, gw, NGW);
        for (int m = gw; m < MTOK; m += NGW) row_to_bf16(x + (size_t)m * DMODEL, hb + (size_t)m * DMODEL, rss + m, lane);
        for (int m = gw; m < NB * NMEMTOK; m += NGW) row_to_bf16(args.in[1] + (size_t)m * DMODEL, memb + (size_t)m * DMODEL, rssm + m, lane);
        const int* positions = (const int*)args.in[2];
        const int gt = bx * NTHREADS + tid, NGT = G * NTHREADS;
        for (int i = gt; i < MTOK * 88; i += NGT) {
            const int tok = i / 88, f = i % 88;
            float* tb; int F, fl;
            if (f < 8) { tb = ropeA; F = 8; fl = f; } else if (f < 24) { tb = ropeB; F = 16; fl = f - 8; } else { tb = ropeC; F = 64; fl = f - 24; }
            const double rev = (double)positions[tok] * INVF[f] * 0.15915494309189535;
            const float fr = (float)(rev - __builtin_rint(rev));
            tb[(size_t)tok * 2 * F + fl] = __builtin_amdgcn_cosf(fr); tb[(size_t)tok * 2 * F + F + fl] = __builtin_amdgcn_sinf(fr);
        }
        for (int i = gt; i < 4 * MTOK; i += NGT) rss[MTOK + i] = 0.f;
        if (bx == 0) for (int i = tid; i < 1024 + XCD_BAR_WORDS; i += NTHREADS) ctl[i] = 0u;
    }
    grid.sync();
    if (tid < 2) misc[8 + tid] = 0u;
    __syncthreads();
    XcdBarrier xbar;
    { unsigned char* ws0 = args.ws; xbar = xcd_barrier_post((unsigned*)(ws0 + WS_CTL) + 1024, misc + 8); }
#define GRID_SYNC() xcd_barrier(xbar)

    const float L2E = 1.4426950408889634f;
#pragma unroll 1
    for (int l = 0; l < 4; ++l) {
        const int mid = (l == 3) ? 0 : l;
        const int nmix = pg8::nmix_of(mid), zoff = nmix + 512;
#pragma unroll 1
#ifndef REP_P1
#define REP_P1 1
#endif
        for (int rep1 = 0; rep1 < REP_P1; ++rep1)
        for (int pass = 0; pass < (l == 0 ? 2 : 1); ++pass) {
            WS_PTRS();
            pg8::Gemm g; pg8::StaticOrder S; pg8::EpiIn E;
            if (pass == 0) {
                g.A = hb; g.Bt = (const bf16_t*)(ws + (l == 0 ? WS_WIN0 : l == 1 ? WS_WIN1 : l == 2 ? WS_WIN2 : WS_WIN3)); g.lda = DMODEL; g.K = DMODEL;
                S.init(MTOK, pg8::npad_of(mid), G, bx);
                E.O = proj; E.ldc = LDP; E.mid = mid; E.rss = rss + (size_t)l * MTOK;
            } else {
                g.A = memb; g.Bt = wmemT; g.lda = DMODEL; g.K = DMODEL;
                S.init(NB * NMEMTOK, 1024, 1 << 20, bx - (G == 256 ? 240 : 0));
                E.O = mkv; E.ldc = 1024; E.mid = 3; E.rss = rssm;
            }
            E.rope0 = ropeA;

#ifndef SK_P1
pg8::gemm_phase<pg8::EpiIn, pg8::StaticOrder, true, true>(lds, g, S, E);
#endif

            __syncthreads();
        }
        if (l == 0 && G == 256 && bx >= 128 && bx < 240) {
            WS_PTRS();
            CONV_WEIGHTS(0x066u, (bx - 128) * NWAVES + wid, 112 * NWAVES);
        } else if (l == 2 && G == 256 && bx >= 128) {
            WS_PTRS();
            CONV_WEIGHTS(0x088u, (bx - 128) * NWAVES + wid, 128 * NWAVES);
        }
        GRID_SYNC();

        const int nsub = (mid == 0) ? 1 : 2;
#pragma unroll 1
        for (int sub = 0; sub < nsub; ++sub) {
            int nA, nMem;
            if (mid == 0) { nA = 1536; nMem = 256; } else if (sub == 0) { nA = (mid == 1) ? 768 : 192; nMem = 256; } else { nA = (mid == 1) ? 96 : 768; nMem = 0; }
#ifndef REP_P2
#define REP_P2 1
#endif
#ifndef REP_MID
#define REP_MID mid
#endif
            const int nrep = (mid == (REP_MID)) ? REP_P2 : 1;
            for (int rep = 0; rep < nrep; ++rep) {
            const bool dry = rep < nrep - 1;
            WS_PTRS();
            unsigned* ctr = ctl + (l * 2 + sub) + 16 * rep;
            if (mid == 1 && sub == 1) ctr = ctl + 128 + 64 * (bx & 7) + 16 * rep;
            int u = fetch_unit(ctr, misc, tid);
            if (mid == 0) {
                while (u < nA) {
                    const int hp = u & 3, n = (u >> 2) & 31, r = u >> 7, kvh = r % 3, b = r / 3;
                    const int head = kvh * 8 + hp * 2 + (wid >> 2);
                    const float sink = args.in[l == 0 ? 7 : 17][head] * L2E;
#ifndef SK_SWA
                    attn_unit<64, MODE_SWA>(lds, tid, wid, lane, proj + head * 64, b * SEQ + n * 128 + (wid & 3) * 32, proj + 1536 + kvh * 64, proj + 1728 + kvh * 64, LDP,
                                            n == 0 ? 2 : 4, b * SEQ + n * 128 - (n ? 128 : 0), 0, sink, 1.f, 0u, 0u, proj + zoff + head * 64, dry);
#endif
                    u = fetch_unit(ctr, misc, tid);
                }
            } else if (mid == 1 && sub == 0) {
                while (u < nA) {
#ifndef SK_KMEAN
                    kmean_unit(lds, tid, proj, kmean, u);
#endif
                    u = fetch_unit(ctr, misc, tid);
                }
            } else if (mid == 1) {
                while (u < nA) {
                    const int qb = 15 - u / 6, bh = (bx & 7) + 8 * (u % 6), b = bh / 12, h = bh % 12;
#ifndef SK_MOBA
                    moba_gate(lds, tid, proj, kmean, b, h, qb);
                    volatile LAS unsigned* selm = (volatile LAS unsigned*)(lds + LDS_MISC - 2048);
                    const unsigned s0 = selm[wid * 32 + (lane & 15)], s1 = selm[wid * 32 + 16 + (lane & 15)];
                    __syncthreads();
                    attn_unit<128, MODE_MOBA>(lds, tid, wid, lane, proj + h * 128, b * SEQ + qb * 256 + wid * 32, proj + 1536 + h * 128, proj + 3072 + h * 128, LDP,
                                              4 + 4 * qb, b * SEQ + qb * 256, b * SEQ, -1e30f, 0.f, s0, s1, proj + zoff + h * 128, dry);
#endif
                    u = fetch_unit(ctr, misc, tid);
                }
            } else if (sub == 0) {
                while (u < nA) {
#ifndef SK_SCAN
                    ret_scan_item(lds, tid, wid, lane, proj, rprev, u);
#endif
                    u = fetch_unit(ctr, misc, tid);
                }
            } else {
                while (u < nA) {
#ifndef SK_ROUT
                    ret_out_unit(lds, tid, wid, lane, proj, rprev, u, dry);
#endif
                    u = fetch_unit(ctr, misc, tid);
                }
            }
            while (u < nA + nMem) {
                const int v = u - nA, hm = v & 3, qt = (v >> 2) & 15, b = v >> 6;
#ifndef SK_MEM
                attn_unit<128, MODE_MEM>(lds, tid, wid, lane, proj + nmix + hm * 128, b * SEQ + qt * 256 + wid * 32, mkv + hm * 128, mkv + 512 + hm * 128, 1024,
                                         4, b * NMEMTOK, 0, -1e30f, 0.f, 0u, 0u, proj + zoff + 1536 + hm * 128, dry);
#endif
                u = fetch_unit(ctr, misc, tid);
            }
            GRID_SYNC();
            }
        }

        {
            WS_PTRS(); const float* x = args.in[0]; float* out = args.out;
            pg8::Gemm g; g.A = proj + zoff; g.Bt = woutT + (size_t)l * 2048 * 2048; g.lda = LDP; g.K = DMODEL;
            pg8::StaticOrder S; S.init(MTOK, DMODEL, G, bx);
            pg8::EpiOut E; E.basef = x; E.out = out; E.hb = hb; E.rssn = rss + (size_t)(l + 1) * MTOK; E.mode = (l == 0) ? 0 : (l == 3 ? 2 : 1);

#ifndef SK_P3
pg8::gemm_phase<pg8::EpiOut, pg8::StaticOrder, true, true>(lds, g, S, E);
#endif

            __syncthreads();
        }
        GRID_SYNC();
    }

#ifdef EXTRA_SYNCS
    for (int i = 0; i < EXTRA_SYNCS; ++i) GRID_SYNC();
#endif
    {
        const int gw = bx * NWAVES + wid, NGW = G * NWAVES;
        WS_PTRS(); float* out = args.out;
        const float* gf = args.in[19];
        for (int m = gw; m < MTOK; m += NGW) {
            const float s = __builtin_amdgcn_rsqf(rss[4 * MTOK + m] * (1.0f / DMODEL) + EPSN);
            f32x4* xr = (f32x4*)(out + (size_t)m * DMODEL) + lane; const f32x4* gr = (const f32x4*)gf + lane;
#pragma unroll
            for (int j = 0; j < 8; ++j) { const f32x4 v = xr[64 * j]; xr[64 * j] = v * s * gr[64 * j]; }
        }
    }
}

extern "C" void kernel_launch(void* const* d_in, const int* in_sizes, int n_in, void* d_out, int out_size, void* d_ws, size_t ws_size, hipStream_t stream) {
    static int grid = 0;
    if (grid == 0) {
        if (n_in != 20 || out_size != MTOK * DMODEL || ws_size < WS_END) { fprintf(stderr, "kernel_launch: unexpected shapes (n_in %d, out %d, ws %zu, need %zu)\n", n_in, out_size, ws_size, (size_t)WS_END); grid = -1; return; }
        int dev = 0, cus = 0, per_cu = 0;
        hipGetDevice(&dev); hipDeviceGetAttribute(&cus, hipDeviceAttributeMultiprocessorCount, dev);
        hipFuncSetAttribute((const void*)trunk_fwd, hipFuncAttributeMaxDynamicSharedMemorySize, LDS_BYTES);
        if (hipOccupancyMaxActiveBlocksPerMultiprocessor(&per_cu, (const void*)trunk_fwd, NTHREADS, LDS_BYTES) != hipSuccess || per_cu < 1) { fprintf(stderr, "kernel_launch: occupancy query gave %d\n", per_cu); per_cu = 1; }
        (void)hipGetLastError();
        grid = cus;
        if (grid != 256) fprintf(stderr, "kernel_launch: note: %d CUs\n", grid);
    }
    if (grid < 0) return;
    Args a{};
    for (int i = 0; i < 20; ++i) a.in[i] = (const float*)d_in[i];
    a.out = (float*)d_out; a.ws = (unsigned char*)d_ws;
    void* kargs[] = {&a};
    hipError_t e = hipLaunchCooperativeKernel((const void*)trunk_fwd, dim3(grid), dim3(NTHREADS), kargs, LDS_BYTES, stream);
    if (e != hipSuccess) fprintf(stderr, "cooperative launch failed: %s (grid %d)\n", hipGetErrorString(e), grid);
}
```

```cpp
#include <hip/hip_runtime.h>
#include <hip/hip_cooperative_groups.h>
#include <cstdio>
#include <cstdint>
namespace cg = cooperative_groups;
#define GAS __attribute__((address_space(1)))
namespace pg8 {
#define PG8_LAS __attribute__((address_space(3)))
typedef unsigned short bf16_t;
typedef short bf16x8 __attribute__((ext_vector_type(8)));
typedef float f32x4 __attribute__((ext_vector_type(4)));
typedef unsigned u32x4 __attribute__((ext_vector_type(4)));
constexpr int BM = 256, BK = 64, HALF = 128, HTB = HALF * BK * 2  , STAGE_BYTES = 8 * HTB, NXCD = 8, WGM = 8;

__host__ __device__ __forceinline__ int lds_byte(int r, int c) { const int st = (r >> 4) * 2 + (c >> 5), rr = r & 15, cc = c & 31, ob = rr * 64 + cc * 2; return st * 1024 + (ob ^ (((ob >> 9) & 1) << 5)); }
__host__ __device__ __forceinline__ void stage_rc(int b, int& R, int& C) { const int st = b / 1024, sb = b % 1024, swz = sb ^ (((sb >> 9) & 1) << 5); R = (st >> 1) * 16 + swz / 64; C = (st & 1) * 32 + (swz % 64) / 2; }
__host__ __device__ __forceinline__ int perm32(int rho) { const int n = rho >> 4, i = rho & 15; return 8 * (i >> 2) + 4 * n + (i & 3); }

struct Unit { int pm, pn; };
struct Gemm { const bf16_t* A; const bf16_t* Bt; int lda, K; };

struct StaticOrder {
    int nM, nN, nwg, G, c;
    __host__ __device__ void init(int M, int N, int G_, int c_) { nM = M / BM; nN = N / BM; nwg = nM * nN; G = G_; c = c_; }
    __host__ __device__ bool next(int i, Unit& u) const {
        const long L = (long)i * G + c; if (L >= nwg || c < 0) return false;
        int wgid = (int)L; { const int q = nwg / NXCD, r = nwg % NXCD, xcd = wgid % NXCD, off = wgid / NXCD; wgid = (xcd < r ? xcd * (q + 1) : r * (q + 1) + (xcd - r) * q) + off; }
        const int nig = WGM * nN, gid = wgid / nig, fm = gid * WGM, gsz = (nM - fm) < WGM ? (nM - fm) : WGM;
        u.pm = fm + ((wgid % nig) % gsz); u.pn = (wgid % nig) / gsz; return true;
    }
    __device__ __forceinline__ void a_ready(const Unit&) const {}
    __device__ __forceinline__ void done(const Unit&) const {}
};

__device__ __forceinline__ unsigned cvt_pk_bf16(float lo, float hi) { unsigned r; asm volatile("v_cvt_pk_bf16_f32 %0, %1, %2" : "=v"(r) : "v"(lo), "v"(hi)); return r; }
constexpr int NB = 4, SEQ = 4096, DMODEL = 2048, MTOK = NB * SEQ, NMEMTOK = 256, LDP = 7168;
constexpr float EPSN = 1e-6f;
__host__ __device__ constexpr int nc_of(int mid)   { return mid == 0 ? 4480 : (mid == 1 ? 7168 : 5632); }
__host__ __device__ constexpr int npad_of(int mid) { return mid == 0 ? 4608 : (mid == 1 ? 7168 : 5632); }
__host__ __device__ constexpr int nmix_of(int mid) { return mid == 0 ? 1920 : (mid == 1 ? 4608 : 3072); }

struct GDesc { int dst0, dst1, rope, rstr; float scale; };
__device__ __forceinline__ GDesc gdesc(int mid, int j0) {
    GDesc d; d.dst0 = j0; d.dst1 = j0 + 4; d.rope = -1; d.rstr = 0; d.scale = 1.f;
    const float L2E = 1.4426950408889634f, R128 = 0.08838834764831845f;
    if (mid == 0) {
        if (j0 >= 4480) { d.dst0 = -1; return d; }
        if (j0 < 1728) { const int hb = j0 & ~63, lg = (j0 & 63) >> 3;
            if (lg < 2) { d.dst0 = hb + 4 * lg; d.dst1 = hb + 8 + 4 * lg; d.rope = 4 * lg; d.rstr = 16; }
            if (j0 < 1536) d.scale = 0.125f * L2E; }
        else if (j0 >= 1920 && j0 < 2432) d.scale = R128 * L2E;
    } else if (mid == 1) {
        if (j0 < 3072) { const int hb = j0 & ~127, lg = (j0 & 127) >> 3;
            if (lg < 4) { d.dst0 = hb + 4 * lg; d.dst1 = hb + 16 + 4 * lg; d.rope = MTOK * 16 + 4 * lg; d.rstr = 32; }
            if (j0 < 1536) d.scale = R128 * L2E; }
        else if (j0 >= 4608 && j0 < 5120) d.scale = R128 * L2E;
    } else if (mid == 2) {
        if (j0 < 1536) { const int hb = j0 & ~127, lg = (j0 & 127) >> 3;
            d.dst0 = hb + 4 * lg; d.dst1 = hb + 64 + 4 * lg; d.rope = MTOK * 48 + 4 * lg; d.rstr = 128;
            if (j0 >= 768) d.scale = R128; }
        else if (j0 >= 3072 && j0 < 3584) d.scale = R128 * L2E;
    }
    return d;
}
__device__ __forceinline__ int src_col(int mid, int j) { const GDesc d = gdesc(mid, j & ~7); if (d.dst0 < 0) return -1; return (j & 4) ? d.dst1 + (j & 3) : d.dst0 + (j & 3); }

typedef unsigned u32x2 __attribute__((ext_vector_type(2)));
struct EpiIn {
    static constexpr bool PERM = true, AFTER_DRAIN = false;
    bf16_t* O; int ldc, mid; const float* rss; const float* rope0;
    __device__ __forceinline__ void operator()(const f32x4 (&acc)[2][2][4][2], const Unit& u, int wr, int wc, int fr, int fq) const {
        const int row0 = u.pm * BM + wr * 64 + fr;
        GDesc d[2];
#pragma unroll
        for (int bj = 0; bj < 2; ++bj) d[bj] = gdesc(mid, u.pn * BM + bj * HALF + wc * 32 + 8 * fq);
#pragma unroll
        for (int ai = 0; ai < 2; ++ai)
#pragma unroll
            for (int m = 0; m < 4; ++m) {
                const int r = row0 + ai * HALF + m * 16;
                const float s = __builtin_amdgcn_rsqf(rss[r] * (1.0f / DMODEL) + EPSN);
                bf16_t* rowp = O + (size_t)r * ldc;
#pragma unroll
                for (int bj = 0; bj < 2; ++bj) {
                    if (d[bj].dst0 < 0) continue;
                    const float sc = s * d[bj].scale;
                    f32x4 v0 = acc[ai][bj][m][0] * sc, v1 = acc[ai][bj][m][1] * sc;
                    if (d[bj].rope >= 0) {
                        const float* t = rope0 + d[bj].rope + (size_t)r * d[bj].rstr; const int F = d[bj].rstr >> 1;
                        const f32x4 c = *(const GAS f32x4*)t, sn = *(const GAS f32x4*)(t + F);
                        const f32x4 n0 = v0 * c - v1 * sn, n1 = v1 * c + v0 * sn; v0 = n0; v1 = n1;
                    }
                    u32x2 w0, w1; w0.x = cvt_pk_bf16(v0[0], v0[1]); w0.y = cvt_pk_bf16(v0[2], v0[3]); w1.x = cvt_pk_bf16(v1[0], v1[1]); w1.y = cvt_pk_bf16(v1[2], v1[3]);
                    if (d[bj].dst1 == d[bj].dst0 + 4) { u32x4 w; w.x = w0.x; w.y = w0.y; w.z = w1.x; w.w = w1.y; *(GAS u32x4*)(rowp + d[bj].dst0) = w; }
                    else { *(GAS u32x2*)(rowp + d[bj].dst0) = w0; *(GAS u32x2*)(rowp + d[bj].dst1) = w1; }
                }
            }
    }
};
struct EpiOut {
    static constexpr bool PERM = true, AFTER_DRAIN = false;
    const float* basef; float* out; bf16_t* hb; float* rssn; int mode;
    __device__ __forceinline__ void operator()(const f32x4 (&acc)[2][2][4][2], const Unit& u, int wr, int wc, int fr, int fq) const {
        const int row0 = u.pm * BM + wr * 64 + fr, col0 = u.pn * BM + wc * 32 + 8 * fq;
#pragma unroll
        for (int ai = 0; ai < 2; ++ai)
#pragma unroll
            for (int m = 0; m < 4; ++m) {
                const int r = row0 + ai * HALF + m * 16; float ss = 0.f;
#pragma unroll
                for (int bj = 0; bj < 2; ++bj) {
                    const size_t off = (size_t)r * DMODEL + col0 + bj * HALF;
                    f32x4 b0, b1;
                    if (mode == 0) { b0 = *(const GAS f32x4*)(basef + off); b1 = *(const GAS f32x4*)(basef + off + 4); }
                    else { const u32x4 hw = *(const GAS u32x4*)(hb + off);
                        b0 = (f32x4){__builtin_bit_cast(float, hw.x << 16), __builtin_bit_cast(float, hw.x & 0xffff0000u), __builtin_bit_cast(float, hw.y << 16), __builtin_bit_cast(float, hw.y & 0xffff0000u)};
                        b1 = (f32x4){__builtin_bit_cast(float, hw.z << 16), __builtin_bit_cast(float, hw.z & 0xffff0000u), __builtin_bit_cast(float, hw.w << 16), __builtin_bit_cast(float, hw.w & 0xffff0000u)}; }
                    const f32x4 v0 = acc[ai][bj][m][0] + b0, v1 = acc[ai][bj][m][1] + b1;
                    if (mode == 2) { *(GAS f32x4*)(out + off) = v0; *(GAS f32x4*)(out + off + 4) = v1; }
                    else { u32x4 w; w.x = cvt_pk_bf16(v0[0], v0[1]); w.y = cvt_pk_bf16(v0[2], v0[3]); w.z = cvt_pk_bf16(v1[0], v1[1]); w.w = cvt_pk_bf16(v1[2], v1[3]);
                        *(GAS u32x4*)(hb + off) = w; }
                    ss += (v0[0] * v0[0] + v0[1] * v0[1]) + (v0[2] * v0[2] + v0[3] * v0[3]) + (v1[0] * v1[0] + v1[1] * v1[1]) + (v1[2] * v1[2] + v1[3] * v1[3]);
                }
                ss += __shfl_xor(ss, 16); ss += __shfl_xor(ss, 32);
                if (fq == 0) atomicAdd(rssn + r, ss);
                if (m & 1) asm volatile("" ::: "memory");
            }
    }
};

template <class Epi, class Sched, bool ALIGN_EPI = false, bool SP2 = false>
__device__ __forceinline__ void gemm_phase(PG8_LAS unsigned char* lds, const Gemm g, const Sched& S, const Epi& E) {
    int tid_ = threadIdx.x; asm volatile("" : "+v"(tid_));
    const int tid = tid_, wid = __builtin_amdgcn_readfirstlane(tid >> 6), lane = tid & 63, wr = wid >> 2, wc = wid & 3, fr = lane & 15, fq = lane >> 4;
    const int K = g.K, nt = K / BK;
    unsigned voffA[2], voffB[2];
#pragma unroll
    for (int i = 0; i < 2; ++i) { int R, C; stage_rc(tid * 16 + i * 8192, R, C); const int Rb = Epi::PERM ? ((R & ~31) + perm32(R & 31)) : R;
        voffA[i] = (unsigned)(R * g.lda + C) * 2u; voffB[i] = (unsigned)(Rb * K + C) * 2u; }
    const size_t kstep = (size_t)(BK * 2);
    const size_t hstepA = (size_t)HALF * g.lda * 2, hstepB = (size_t)HALF * K * 2;
    const size_t tstepA = 2 * hstepA, tstepB = 2 * hstepB;
    const unsigned ldsw = (unsigned)wid * 1024u;
    const int aoff = lds_byte(wr * 64 + fr, fq * 8), boff = lds_byte(wc * 32 + fr, fq * 8);
#define PG8_SA(b, h) (((b) * 2 + (h)) * HTB)
#define PG8_SB(b, h) ((4 + (b) * 2 + (h)) * HTB)
#define PG8_STAGE(bufoff, gbase, voff) do { _Pragma("unroll") for (int _i = 0; _i < 2; ++_i) \
        __builtin_amdgcn_global_load_lds((const unsigned*)((const char*)(gbase) + (voff)[_i]), (PG8_LAS unsigned*)(lds + (bufoff) + ldsw + _i * 8192), 16, 0, 0); } while (0)
#define PG8_LDA(dst, b, h) do { _Pragma("unroll") for (int m = 0; m < 4; ++m) _Pragma("unroll") for (int k = 0; k < 2; ++k) dst[m][k] = *(const PG8_LAS bf16x8*)(lds + PG8_SA(b, h) + aoff + m * 2048 + k * 1024); } while (0)
#define PG8_LDB(dst, b, h) do { _Pragma("unroll") for (int n = 0; n < 2; ++n) _Pragma("unroll") for (int k = 0; k < 2; ++k) dst[n][k] = *(const PG8_LAS bf16x8*)(lds + PG8_SB(b, h) + boff + n * 2048 + k * 1024); } while (0)
#define PG8_MMA(ai, bj, At, Bt) do { __builtin_amdgcn_s_setprio(1); _Pragma("unroll") for (int m = 0; m < 4; ++m) _Pragma("unroll") for (int n = 0; n < 2; ++n) _Pragma("unroll") for (int k = 0; k < 2; ++k) \
        acc[ai][bj][m][n] = __builtin_amdgcn_mfma_f32_16x16x32_bf16(Bt[n][k], At[m][k], acc[ai][bj][m][n], 0, 0, 0); __builtin_amdgcn_s_setprio(0); } while (0)
#define PG8_WAIT_V(n) asm volatile("s_waitcnt vmcnt(" #n ")" ::: "memory")
#define PG8_WAIT_L(n) asm volatile("s_waitcnt lgkmcnt(" #n ")" ::: "memory")
#define PG8_BAR __builtin_amdgcn_s_barrier()
#define PG8_SCHED __builtin_amdgcn_sched_barrier(0)
    Unit cur, nxt; int ui = 0;
    if (!S.next(0, cur)) return;
    f32x4 acc[2][2][4][2];
#pragma unroll
    for (int a = 0; a < 2; ++a)
#pragma unroll
        for (int b = 0; b < 2; ++b)
#pragma unroll
            for (int m = 0; m < 4; ++m)
#pragma unroll
                for (int n = 0; n < 2; ++n) acc[a][b][m][n] = (f32x4){0.f, 0.f, 0.f, 0.f};
    bf16x8 At[4][2], B0[2][2], B1[2][2];
    const char* cA = (const char*)g.A + (size_t)cur.pm * tstepA; const char* cB = (const char*)g.Bt + (size_t)cur.pn * tstepB;
    S.a_ready(cur);
    if constexpr (SP2) {
        PG8_STAGE(PG8_SB(0, 0), cB, voffB); PG8_STAGE(PG8_SB(0, 1), cB + hstepB, voffB); PG8_STAGE(PG8_SA(0, 0), cA, voffA); PG8_STAGE(PG8_SA(0, 1), cA + hstepA, voffA);
        if (wr == 1) PG8_BAR;
        PG8_WAIT_V(2); PG8_BAR;
        PG8_STAGE(PG8_SB(1, 0), cB + kstep, voffB); PG8_STAGE(PG8_SA(1, 0), cA + kstep, voffA); PG8_STAGE(PG8_SB(1, 1), cB + hstepB + kstep, voffB);
        PG8_WAIT_V(6); PG8_BAR;
    } else {
        PG8_STAGE(PG8_SB(0, 0), cB, voffB); PG8_STAGE(PG8_SA(0, 0), cA, voffA); PG8_STAGE(PG8_SB(0, 1), cB + hstepB, voffB); PG8_STAGE(PG8_SA(0, 1), cA + hstepA, voffA);
        if (wr == 1) PG8_BAR;
        PG8_WAIT_V(4); PG8_BAR;
        PG8_STAGE(PG8_SB(1, 0), cB + kstep, voffB); PG8_STAGE(PG8_SA(1, 0), cA + kstep, voffA); PG8_STAGE(PG8_SB(1, 1), cB + hstepB + kstep, voffB);
        PG8_WAIT_V(6); PG8_BAR;
    }
    for (;;) {
        const bool has_next = S.next(ui + 1, nxt);
        const char* nA = has_next ? (const char*)g.A + (size_t)nxt.pm * tstepA : cA; const char* nB = has_next ? (const char*)g.Bt + (size_t)nxt.pn * tstepB : cB;
        for (int t = 0; t < nt; t += 2) {
            const bool last = (t == nt - 2);
            const char* a1 = cA + (size_t)(t + 1) * kstep;
            const char* a2 = last ? nA : cA + (size_t)(t + 2) * kstep; const char* b2 = last ? nB : cB + (size_t)(t + 2) * kstep;
            const char* a3 = a2 + kstep; const char* b3 = b2 + kstep;
            if (last && has_next) S.a_ready(nxt);
            if constexpr (SP2) {
            PG8_LDB(B0, 0, 0); PG8_LDB(B1, 0, 1); PG8_SCHED; PG8_LDA(At, 0, 0); PG8_STAGE(PG8_SA(1, 1), a1 + hstepA, voffA);
            PG8_WAIT_V(8); PG8_WAIT_L(0); PG8_BAR; PG8_MMA(0, 0, At, B0); PG8_MMA(0, 1, At, B1); PG8_BAR; PG8_SCHED;
            PG8_LDA(At, 0, 1); PG8_STAGE(PG8_SB(0, 0), b2, voffB); PG8_STAGE(PG8_SB(0, 1), b2 + hstepB, voffB); PG8_STAGE(PG8_SA(0, 0), a2, voffA);
            PG8_WAIT_V(8); PG8_WAIT_L(0); PG8_BAR; PG8_MMA(1, 0, At, B0); PG8_MMA(1, 1, At, B1); PG8_BAR; PG8_SCHED;
            PG8_LDB(B0, 1, 0); PG8_LDB(B1, 1, 1); PG8_SCHED; PG8_LDA(At, 1, 0); PG8_STAGE(PG8_SA(0, 1), a2 + hstepA, voffA);
            PG8_WAIT_V(8); PG8_WAIT_L(0); PG8_BAR; PG8_MMA(0, 0, At, B0); PG8_MMA(0, 1, At, B1); PG8_BAR; PG8_SCHED;
            PG8_LDA(At, 1, 1); PG8_STAGE(PG8_SB(1, 0), b3, voffB); PG8_STAGE(PG8_SB(1, 1), b3 + hstepB, voffB); PG8_STAGE(PG8_SA(1, 0), a3, voffA);
            PG8_WAIT_V(8); PG8_WAIT_L(0); PG8_BAR; PG8_MMA(1, 0, At, B0); PG8_MMA(1, 1, At, B1); PG8_BAR; PG8_SCHED;
            } else {
            PG8_LDB(B0, 0, 0); PG8_SCHED; PG8_LDA(At, 0, 0); PG8_STAGE(PG8_SA(1, 1), a1 + hstepA, voffA);
            PG8_WAIT_L(8); PG8_BAR; PG8_WAIT_L(0); PG8_MMA(0, 0, At, B0); PG8_BAR; PG8_SCHED;
            PG8_LDB(B1, 0, 1); PG8_STAGE(PG8_SB(0, 0), b2, voffB);
            PG8_BAR; PG8_WAIT_L(0); PG8_MMA(0, 1, At, B1); PG8_BAR;
            PG8_LDA(At, 0, 1); PG8_STAGE(PG8_SA(0, 0), a2, voffA);
            PG8_BAR; PG8_WAIT_L(0); PG8_MMA(1, 0, At, B0); PG8_BAR; PG8_SCHED;
            PG8_STAGE(PG8_SB(0, 1), b2 + hstepB, voffB);
            PG8_WAIT_V(6); PG8_BAR; PG8_MMA(1, 1, At, B1); PG8_BAR;
            PG8_LDB(B0, 1, 0); PG8_SCHED; PG8_LDA(At, 1, 0); PG8_STAGE(PG8_SA(0, 1), a2 + hstepA, voffA);
            PG8_WAIT_L(8); PG8_BAR; PG8_WAIT_L(0); PG8_MMA(0, 0, At, B0); PG8_BAR; PG8_SCHED;
            PG8_LDB(B1, 1, 1); PG8_STAGE(PG8_SB(1, 0), b3, voffB);
            PG8_BAR; PG8_WAIT_L(0); PG8_MMA(0, 1, At, B1); PG8_BAR;
            PG8_LDA(At, 1, 1); PG8_STAGE(PG8_SA(1, 0), a3, voffA);
            PG8_BAR; PG8_WAIT_L(0); PG8_MMA(1, 0, At, B0); PG8_BAR; PG8_SCHED;
            PG8_STAGE(PG8_SB(1, 1), b3 + hstepB, voffB);
            PG8_WAIT_V(6); PG8_BAR; PG8_MMA(1, 1, At, B1); PG8_BAR;
            }
        }
        if constexpr (ALIGN_EPI) { if (wr == 0) PG8_BAR; }
        if constexpr (!Epi::AFTER_DRAIN) { E(acc, cur, wr, wc, fr, fq); S.done(cur); }
        if (!has_next) break;
#pragma unroll
        for (int a = 0; a < 2; ++a)
#pragma unroll
            for (int b = 0; b < 2; ++b)
#pragma unroll
                for (int m = 0; m < 4; ++m)
#pragma unroll
                    for (int n = 0; n < 2; ++n) acc[a][b][m][n] = (f32x4){0.f, 0.f, 0.f, 0.f};
        cur = nxt; cA = nA; cB = nB; ++ui;
        if constexpr (ALIGN_EPI) { if (wr == 1) PG8_BAR; }
    }
    PG8_WAIT_V(0);
    if constexpr (!ALIGN_EPI) { if (wr == 0) PG8_BAR; }
    PG8_BAR;
    if constexpr (Epi::AFTER_DRAIN) { E.fused(acc, cur, wr, wc, fr, fq, lds, wid, lane); S.done(cur); }
#undef PG8_SA
#undef PG8_SB
#undef PG8_STAGE
#undef PG8_LDA
#undef PG8_LDB
#undef PG8_MMA
#undef PG8_WAIT_V
#undef PG8_WAIT_L
#undef PG8_BAR
#undef PG8_SCHED
}
}

using pg8::bf16_t; using pg8::bf16x8; using pg8::f32x4; using pg8::u32x4; using pg8::u32x2; using pg8::cvt_pk_bf16;
using pg8::NB; using pg8::SEQ; using pg8::DMODEL; using pg8::MTOK; using pg8::NMEMTOK; using pg8::LDP; using pg8::EPSN;
#define LAS __attribute__((address_space(3)))
typedef short s16x4 __attribute__((ext_vector_type(4)));
typedef float f32x2 __attribute__((ext_vector_type(2)));

constexpr int NTHREADS = 512, NWAVES = 8;
constexpr int LDS_BYTES = 147456;
constexpr int LDS_MISC = 139264;

constexpr size_t al256(size_t x) { return (x + 255) & ~(size_t)255; }
constexpr size_t WS_CTL   = 0;
constexpr size_t WS_WIN0  = 1u << 20;
constexpr size_t WS_WIN1  = WS_WIN0 + (size_t)4608 * 2048 * 2;
constexpr size_t WS_WIN2  = WS_WIN1 + (size_t)7168 * 2048 * 2;
constexpr size_t WS_WIN3  = WS_WIN2 + (size_t)5632 * 2048 * 2;
constexpr size_t WS_WOUT  = WS_WIN3 + (size_t)4608 * 2048 * 2;
constexpr size_t WS_WMEM  = WS_WOUT + (size_t)4 * 2048 * 2048 * 2;
constexpr size_t WS_HB    = WS_WMEM + (size_t)1024 * 2048 * 2;
constexpr size_t WS_PROJ  = WS_HB + (size_t)MTOK * 2048 * 2;
constexpr size_t WS_MEMB  = WS_PROJ + (size_t)MTOK * LDP * 2;
constexpr size_t WS_MKV   = WS_MEMB + (size_t)1024 * 2048 * 2;
constexpr size_t WS_RSS   = WS_MKV + (size_t)1024 * 1024 * 2;
constexpr size_t WS_RSSM  = WS_RSS + (size_t)5 * MTOK * 4;
constexpr size_t WS_ROPEA = WS_RSSM + 4096;
constexpr size_t WS_ROPEB = WS_ROPEA + (size_t)MTOK * 16 * 4;
constexpr size_t WS_ROPEC = WS_ROPEB + (size_t)MTOK * 32 * 4;
constexpr size_t WS_KMEAN = WS_ROPEC + (size_t)MTOK * 128 * 4;
constexpr size_t WS_RPREV = WS_KMEAN + (size_t)4 * 12 * 16 * 128 * 4;
constexpr size_t WS_END   = WS_RPREV + (size_t)4 * 32 * 6 * 256 * 128 * 2;

__constant__ double INVF[88] = {
 1.0, 0.19392274474868576, 0.03760603093086393, 0.007292664737217109, 0.001414213562373095, 0.0002742481756762073, 5.318295896944988e-05, 1.031338537721246e-05,
 1.0, 0.44036660267178046, 0.19392274474868576, 0.08539710028576561, 0.03760603093086393, 0.016560440080994446, 0.007292664737217109, 0.003211445994752591, 0.001414213562373095, 0.000622772421914596, 0.0002742481756762073, 0.00012076973741146504, 5.318295896944988e-05, 2.341999896140934e-05, 1.031338537721246e-05, 4.5416704806078695e-06,
 1.0, 0.8659643233600653, 0.7498942093324559, 0.6493816315762113, 0.5623413251903491, 0.4869675251658631, 0.4216965034285822, 0.3651741272548377, 0.31622776601683794, 0.27384196342643613, 0.23713737056616552, 0.2053525026457146, 0.1778279410038923, 0.1539926526059492, 0.1333521432163324, 0.11547819846894582, 0.1, 0.08659643233600653, 0.07498942093324558, 0.06493816315762113, 0.05623413251903491, 0.04869675251658631, 0.042169650342858224, 0.03651741272548377, 0.03162277660168379, 0.027384196342643614, 0.023713737056616554, 0.02053525026457146, 0.01778279410038923, 0.01539926526059492, 0.01333521432163324, 0.011547819846894581, 0.01, 0.008659643233600654, 0.007498942093324558, 0.006493816315762113, 0.005623413251903491, 0.004869675251658631, 0.004216965034285823, 0.003651741272548377, 0.0031622776601683794, 0.0027384196342643613, 0.0023713737056616554, 0.002053525026457146, 0.0017782794100389228, 0.001539926526059492, 0.001333521432163324, 0.0011547819846894581, 0.001, 0.0008659643233600654, 0.0007498942093324559, 0.0006493816315762113, 0.0005623413251903491, 0.0004869675251658631, 0.00042169650342858224, 0.0003651741272548377, 0.00031622776601683794, 0.0002738419634264361, 0.00023713737056616554, 0.0002053525026457146, 0.00017782794100389227, 0.0001539926526059492, 0.0001333521432163324, 0.00011547819846894582 };
__device__ __forceinline__ float log2gamma(int h) {
    return h == 0 ? -0.04580368961312479f : h == 1 ? -0.02612928206836121f : h == 2 ? -0.014949433599796901f : h == 3 ? -0.008567249848519122f : h == 4 ? -0.004914372264518986f : -0.002820519062378663f;
}

#define LDS_WAIT() asm volatile("s_waitcnt lgkmcnt(0)" ::: "memory")
__device__ __forceinline__ unsigned f2bf(float f) { unsigned u = __builtin_bit_cast(unsigned, f); return (u + 0x7fffu + ((u >> 16) & 1u)) >> 16; }
__device__ __forceinline__ unsigned pk2(float lo, float hi) { return f2bf(lo) | (f2bf(hi) << 16); }
__device__ __forceinline__ float bflo(unsigned w) { return __builtin_bit_cast(float, w << 16); }
__device__ __forceinline__ float bfhi(unsigned w) { return __builtin_bit_cast(float, w & 0xffff0000u); }
__device__ __forceinline__ float wave_sum(float v) {
#pragma unroll
    for (int o = 1; o < 64; o <<= 1) v += __shfl_xor(v, o);
    return v;
}
__device__ __forceinline__ float fexp2(float x) { return __builtin_amdgcn_exp2f(x); }
__device__ __forceinline__ s16x4 vtr(const LAS unsigned char* p) { return __builtin_bit_cast(s16x4, __builtin_amdgcn_ds_read_tr16_b64_v4i16((LAS s16x4*)p)); }
__device__ __forceinline__ bf16x8 cat8(s16x4 a, s16x4 b) { bf16x8 r; r[0] = a[0]; r[1] = a[1]; r[2] = a[2]; r[3] = a[3]; r[4] = b[0]; r[5] = b[1]; r[6] = b[2]; r[7] = b[3]; return r; }
typedef float f32x2_t __attribute__((ext_vector_type(2)));
typedef __bf16 bf16x2_t __attribute__((ext_vector_type(2)));
__device__ __forceinline__ unsigned cvtpk(float lo, float hi) { f32x2_t v = {lo, hi}; bf16x2_t b = __builtin_convertvector(v, bf16x2_t); return __builtin_bit_cast(unsigned, b); }
__device__ __forceinline__ float xmax16(float x) { const auto r = __builtin_amdgcn_permlane16_swap(__builtin_bit_cast(unsigned, x), __builtin_bit_cast(unsigned, x), false, false); return fmaxf(__builtin_bit_cast(float, r[0]), __builtin_bit_cast(float, r[1])); }
__device__ __forceinline__ float xmax32(float x) { const auto r = __builtin_amdgcn_permlane32_swap(__builtin_bit_cast(unsigned, x), __builtin_bit_cast(unsigned, x), false, false); return fmaxf(__builtin_bit_cast(float, r[0]), __builtin_bit_cast(float, r[1])); }
__device__ __forceinline__ bf16x8 pack8s(f32x4 a, f32x4 b) { u32x4 w; w.x = cvtpk(a[0], a[1]); w.y = cvtpk(a[2], a[3]); w.z = cvtpk(b[0], b[1]); w.w = cvtpk(b[2], b[3]); return __builtin_bit_cast(bf16x8, w); }
__device__ __forceinline__ bf16x8 pack8(f32x4 a, f32x4 b) { u32x4 w; w.x = cvt_pk_bf16(a[0], a[1]); w.y = cvt_pk_bf16(a[2], a[3]); w.z = cvt_pk_bf16(b[0], b[1]); w.w = cvt_pk_bf16(b[2], b[3]); return __builtin_bit_cast(bf16x8, w); }
__device__ __forceinline__ float silu_mul(float o, float z) { return o * z * __builtin_amdgcn_rcpf(1.0f + fexp2(-1.4426950408889634f * z)); }

__device__ __forceinline__ void transpose_item(const float* W, int N, int mid, const float* gvec, bf16_t* WT, int nblk, int item, int lane, LAS float* scr) {
    const int kb = item / nblk, nb = item % nblk, k0 = 64 * kb, n0 = 64 * nb;
    const int c4 = lane & 15, r4 = lane >> 4, j = n0 + 4 * c4;
    const int sc = (mid < 0) ? j : pg8::src_col(mid, j);
    f32x4 v[16];
#pragma unroll
    for (int i = 0; i < 16; ++i) { v[i] = (f32x4){0.f, 0.f, 0.f, 0.f}; if (sc >= 0) v[i] = *(const GAS f32x4*)(W + (size_t)(k0 + 4 * i + r4) * N + sc); }
#pragma unroll
    for (int i = 0; i < 16; ++i) { const int kk = 4 * i + r4; const float gk = gvec ? gvec[k0 + kk] : 1.0f; LAS float* d = scr + kk * 65 + 4 * c4;
        d[0] = v[i][0] * gk; d[1] = v[i][1] * gk; d[2] = v[i][2] * gk; d[3] = v[i][3] * gk; }
    LDS_WAIT(); asm volatile("" ::: "memory");
    const int c = lane & 7;
#pragma unroll
    for (int jj = 0; jj < 8; ++jj) { const int n = (lane >> 3) + 8 * jj; const LAS float* sp = scr + (8 * c) * 65 + n;
        u32x4 o; o.x = pk2(sp[0 * 65], sp[1 * 65]); o.y = pk2(sp[2 * 65], sp[3 * 65]); o.z = pk2(sp[4 * 65], sp[5 * 65]); o.w = pk2(sp[6 * 65], sp[7 * 65]);
        *(GAS u32x4*)(WT + (size_t)(n0 + n) * 2048 + k0 + 8 * c) = o; }
    LDS_WAIT(); asm volatile("" ::: "memory");
}
__device__ __forceinline__ void row_to_bf16(const float* xrow, bf16_t* orow, float* rss, int lane) {
    const f32x4* xr = (const f32x4*)xrow + lane; float s = 0.f;
    u32x2* o8 = (u32x2*)orow + lane;
#pragma unroll
    for (int j = 0; j < 8; ++j) { const f32x4 v = xr[64 * j]; s += (v.x * v.x + v.y * v.y) + (v.z * v.z + v.w * v.w);
        u32x2 w; w.x = pk2(v.x, v.y); w.y = pk2(v.z, v.w); o8[64 * j] = w; }
    s = wave_sum(s);
    if (lane == 0) *rss = s;
}

enum { MODE_SWA = 0, MODE_MOBA = 1, MODE_MEM = 2 };
template <int DH, int MODE>
__device__ __forceinline__ void attn_unit(LAS unsigned char* lds, int tid, int wid, int lane,
        const bf16_t* Q,
        int qrow0,
        const bf16_t* Kb, const bf16_t* Vb, int ldkv,
        int nt, int krow_a, int krow_b,
        float m_init, float l_init, unsigned sel0, unsigned sel1,
        bf16_t* Zy,
        bool dry = false)
{
    asm volatile("" : "+v"(tid), "+v"(lane)); asm volatile("" : "+s"(wid));
    constexpr int KSTR = DH * 2 + 16, VSTR = DH * 2 + 32, KBYTES = 64 * KSTR, VBYTES = 64 * VSTR, STG = KBYTES + VBYTES;
    constexpr int CPR = DH / 8  , CPT = (64 * CPR) / NTHREADS  ;
    constexpr int NK = DH / 32, NDB = DH / 16;
    const int g = lane >> 4, l15 = lane & 15, q4 = l15 >> 2, p4 = l15 & 3;
    bf16x8 Qf[2][NK];
#pragma unroll
    for (int j = 0; j < 2; ++j)
#pragma unroll
        for (int k = 0; k < NK; ++k) Qf[j][k] = *(const GAS bf16x8*)(Q + (size_t)(qrow0 + j * 16 + l15) * LDP + k * 32 + g * 8);
    f32x4 O[NDB][2];
#pragma unroll
    for (int db = 0; db < NDB; ++db) { O[db][0] = (f32x4){0.f, 0.f, 0.f, 0.f}; O[db][1] = (f32x4){0.f, 0.f, 0.f, 0.f}; }
    const float m0 = (MODE == MODE_SWA) ? m_init : 0.f;
    float mrow[2] = {m0, m0}, lrow[2] = {g == 0 ? l_init : 0.f, g == 0 ? l_init : 0.f};
    bool first = (MODE != MODE_SWA);
    const unsigned sel[2] = {sel0, sel1};

    u32x4 kreg[2][CPT], vreg[2][CPT];
#define ATT_KROW(it) ((MODE == MODE_MOBA && (it) >= 4) ? (krow_b + 64 * ((it) - 4)) : (krow_a + 64 * (it)))
#define ATT_ISSUE(hf_, it) do { const int kr_ = ATT_KROW(it); _Pragma("unroll") for (int i_ = 0; i_ < CPT; ++i_) { const int c_ = tid + NTHREADS * i_, r_ = c_ / CPR, cc_ = c_ % CPR; \
        kreg[hf_][i_] = *(const GAS u32x4*)(Kb + (size_t)(kr_ + r_) * ldkv + cc_ * 8); vreg[hf_][i_] = *(const GAS u32x4*)(Vb + (size_t)(kr_ + r_) * ldkv + cc_ * 8); } } while (0)
    constexpr bool PF2 = false;
    ATT_ISSUE(0, 0);
    if (PF2 && nt > 1) ATT_ISSUE(1, 1);
    for (int it0 = 0; it0 < nt; it0 += 2) {
#pragma unroll
      for (int hf = 0; hf < 2; ++hf) {
        const int it = it0 + hf;
        if (it >= nt) break;
        LAS unsigned char* Kt = lds + hf * STG; LAS unsigned char* Vt = Kt + KBYTES;
#pragma unroll
        for (int i = 0; i < CPT; ++i) { const int c = tid + NTHREADS * i, r = c / CPR, cc = c % CPR;
            *(LAS u32x4*)(Kt + r * KSTR + cc * 16) = kreg[PF2 ? hf : 0][i]; *(LAS u32x4*)(Vt + r * VSTR + cc * 16) = vreg[PF2 ? hf : 0][i]; }
        if (PF2) { if (it + 2 < nt) ATT_ISSUE(hf, it + 2); } else { if (it + 1 < nt) ATT_ISSUE(0, it + 1); }
        __syncthreads();
        const int kp = ATT_KROW(it);
        bool active = true;
        if (MODE == MODE_SWA) active = !(kp > qrow0 + 31 || kp + 63 <= qrow0 - 128);
        if (MODE == MODE_MOBA) active = !(kp > qrow0 + 31);
        if (active) {
            f32x4 S[4][2];
            float sinit[2] = {-mrow[0], -mrow[1]};
            if (MODE == MODE_MOBA && it >= 4) {
                const int pb = (it - 4) >> 2;
                sinit[0] = ((sel[0] >> pb) & 1u) ? sinit[0] : -INFINITY; sinit[1] = ((sel[1] >> pb) & 1u) ? sinit[1] : -INFINITY;
            }
#pragma unroll
            for (int kb = 0; kb < 4; ++kb) { S[kb][0] = (f32x4){sinit[0], sinit[0], sinit[0], sinit[0]}; S[kb][1] = (f32x4){sinit[1], sinit[1], sinit[1], sinit[1]}; }
#pragma unroll
            for (int kb = 0; kb < 4; ++kb) {
#pragma unroll
                for (int k = 0; k < NK; ++k) {
                    const bf16x8 a = *(const LAS bf16x8*)(Kt + (kb * 16 + l15) * KSTR + (k * 32 + g * 8) * 2);
                    S[kb][0] = __builtin_amdgcn_mfma_f32_16x16x32_bf16(a, Qf[0][k], S[kb][0], 0, 0, 0);
                    S[kb][1] = __builtin_amdgcn_mfma_f32_16x16x32_bf16(a, Qf[1][k], S[kb][1], 0, 0, 0);
                }
                if (kb & 1) __builtin_amdgcn_sched_barrier(0);
            }
            bf16x8 Pb[2][2];
#pragma unroll
            for (int j = 0; j < 2; ++j) {
                const int qi = qrow0 + j * 16 + l15;
                if (MODE == MODE_SWA) {
                    if (!(kp + 63 <= qrow0 && kp > qrow0 + 31 - 128)) {
                        const unsigned dbase = (unsigned)(qi - kp - 4 * g);
#pragma unroll
                        for (int kb = 0; kb < 4; ++kb)
#pragma unroll
                            for (int i = 0; i < 4; ++i) S[kb][j][i] = ((dbase - (unsigned)(kb * 16 + i)) < 128u) ? S[kb][j][i] : -INFINITY;
                    }
                } else if (MODE == MODE_MOBA) {
                    if (kp + 63 > qrow0) {
#pragma unroll
                        for (int kb = 0; kb < 4; ++kb)
#pragma unroll
                            for (int i = 0; i < 4; ++i) S[kb][j][i] = ((qi - kp - 4 * g) >= (kb * 16 + i)) ? S[kb][j][i] : -INFINITY;
                    }
                }
                float mx = -INFINITY;
#pragma unroll
                for (int kb = 0; kb < 4; ++kb) mx = fmaxf(mx, fmaxf(fmaxf(S[kb][j][0], S[kb][j][1]), fmaxf(S[kb][j][2], S[kb][j][3])));
                mx = xmax16(mx); mx = xmax32(mx);
                const bool need = (first && mx > -INFINITY) || (mx > 8.0f);
                if (__builtin_amdgcn_ballot_w64(need) != 0ull) {
                    const float dlt = need ? mx : 0.f, alpha = fexp2(-dlt);
#pragma unroll
                    for (int kb = 0; kb < 4; ++kb) S[kb][j] = S[kb][j] - dlt;
                    mrow[j] += dlt; lrow[j] *= alpha;
#pragma unroll
                    for (int db = 0; db < NDB; ++db) O[db][j] = O[db][j] * alpha;
                }
                float ps = 0.f;
#pragma unroll
                for (int kb = 0; kb < 4; ++kb)
#pragma unroll
                    for (int i = 0; i < 4; ++i) { const float p = fexp2(S[kb][j][i]); S[kb][j][i] = p; ps += p; }
                lrow[j] += ps;
                Pb[j][0] = pack8s(S[0][j], S[1][j]); Pb[j][1] = pack8s(S[2][j], S[3][j]);
            }
#pragma unroll
            for (int s = 0; s < 2; ++s)
#pragma unroll
                for (int db = 0; db < NDB; ++db) {
                    const s16x4 lo = vtr(Vt + (32 * s + 4 * g + q4) * VSTR + (16 * db + 4 * p4) * 2);
                    const s16x4 hi = vtr(Vt + (32 * s + 16 + 4 * g + q4) * VSTR + (16 * db + 4 * p4) * 2);
                    const bf16x8 a = cat8(lo, hi);
                    O[db][0] = __builtin_amdgcn_mfma_f32_16x16x32_bf16(a, Pb[0][s], O[db][0], 0, 0, 0);
                    O[db][1] = __builtin_amdgcn_mfma_f32_16x16x32_bf16(a, Pb[1][s], O[db][1], 0, 0, 0);
                    if ((db & 3) == 3) __builtin_amdgcn_sched_barrier(0);
                }
            first = false;
        }
      }
    }
#undef ATT_ISSUE
#undef ATT_KROW
#pragma unroll
    for (int j = 0; j < 2; ++j) {
        float l = lrow[j]; l += __shfl_xor(l, 16); l += __shfl_xor(l, 32);
        const float inv = 1.0f / l;
        bf16_t* zp = Zy + (size_t)(qrow0 + j * 16 + l15) * LDP + 4 * g;
#pragma unroll
        for (int db = 0; db < NDB; ++db) {
            const u32x2 z = *(const GAS u32x2*)(zp + 16 * db);
            const f32x4 o = O[db][j] * inv;
            u32x2 w; w.x = cvt_pk_bf16(silu_mul(o[0], bflo(z.x)), silu_mul(o[1], bfhi(z.x))); w.y = cvt_pk_bf16(silu_mul(o[2], bflo(z.y)), silu_mul(o[3], bfhi(z.y)));
            if (!dry) *(GAS u32x2*)(zp + 16 * db) = w;
        }
    }
    __syncthreads();
}

__device__ __forceinline__ void moba_gate(LAS unsigned char* lds, int tid, const bf16_t* proj, const float* kmean, int b, int h, int qb) {
    asm volatile("" : "+v"(tid));
    LAS float* km = (LAS float*)lds;
    LAS unsigned* selm = (LAS unsigned*)(lds + LDS_MISC - 2048);
    for (int i = tid; i < 16 * 128; i += NTHREADS) km[i] = kmean[(size_t)((b * 12 + h) * 16) * 128 + i];
    __syncthreads();
    const int q = tid >> 1, half = tid & 1;
    const bf16_t* qp = proj + (size_t)(b * SEQ + qb * 256 + q) * LDP + h * 128 + half * 64;
    float gsc[15];
#pragma unroll
    for (int n = 0; n < 15; ++n) gsc[n] = 0.f;
#pragma unroll 1
    for (int c = 0; c < 8; ++c) {
        const u32x4 w = *(const GAS u32x4*)(qp + c * 8);
        float qv[8] = {bflo(w.x), bfhi(w.x), bflo(w.y), bfhi(w.y), bflo(w.z), bfhi(w.z), bflo(w.w), bfhi(w.w)};
#pragma unroll
        for (int n = 0; n < 15; ++n) if (n < qb) {
            const LAS float* kr = km + n * 128 + half * 64 + c * 8;
#pragma unroll
            for (int e = 0; e < 8; ++e) gsc[n] += qv[e] * kr[e];
        }
    }
    unsigned mask = 0u;
#pragma unroll
    for (int n = 0; n < 15; ++n) { gsc[n] += __shfl_xor(gsc[n], 1); if (n >= qb) gsc[n] = -INFINITY; }
#pragma unroll
    for (int r = 0; r < 3; ++r) {
        float best = -INFINITY; int bi = -1;
#pragma unroll
        for (int n = 0; n < 15; ++n) { const bool taken = (mask >> n) & 1u; if (!taken && gsc[n] > best) { best = gsc[n]; bi = n; } }
        if (bi >= 0) mask |= 1u << bi;
    }
    if (half == 0) selm[q] = mask;
    __syncthreads();
}

__device__ __forceinline__ void kmean_unit(LAS unsigned char* lds, int tid, const bf16_t* proj, float* kmean, int u) {
    asm volatile("" : "+v"(tid));
    const int blk = u & 15, bh = u >> 4, b = bh / 12, h = bh % 12;
    const int cc = tid & 15, kg = tid >> 4;
    float s[8] = {0.f, 0.f, 0.f, 0.f, 0.f, 0.f, 0.f, 0.f};
    const bf16_t* kp = proj + (size_t)(b * SEQ + blk * 256 + kg * 8) * LDP + 1536 + h * 128 + cc * 8;
#pragma unroll
    for (int r = 0; r < 8; ++r) { const u32x4 w = *(const GAS u32x4*)(kp + (size_t)r * LDP);
        s[0] += bflo(w.x); s[1] += bfhi(w.x); s[2] += bflo(w.y); s[3] += bfhi(w.y); s[4] += bflo(w.z); s[5] += bfhi(w.z); s[6] += bflo(w.w); s[7] += bfhi(w.w); }
    LAS float* red = (LAS float*)lds;
#pragma unroll
    for (int e = 0; e < 8; ++e) red[kg * 128 + cc * 8 + e] = s[e];
    __syncthreads();
    if (tid < 128) { float a = 0.f;
#pragma unroll 8
        for (int k = 0; k < 32; ++k) a += red[k * 128 + tid];
        kmean[(size_t)u * 128 + tid] = a * (1.0f / 256.0f); }
    __syncthreads();
}

__device__ __forceinline__ void ret_scan_item(LAS unsigned char* lds, int tid, int wid, int lane, const bf16_t* proj, bf16_t* rprev, int item) {
    asm volatile("" : "+v"(tid), "+v"(lane)); asm volatile("" : "+s"(wid));
    constexpr int KS = 288, VS = 96, KB = 128 * KS, STG = KB + 128 * VS;
    const int es = item & 7, bh = item >> 3, b = bh / 6, h = bh % 6;
    const float lg = log2gamma(h), gchunk = fexp2(128.f * lg);
    const int g = lane >> 4, l15 = lane & 15, q4 = l15 >> 2, p4 = l15 & 3;
    const bf16_t* kbase = proj + (size_t)(b * SEQ) * LDP + 768 + h * 128;
    const bf16_t* vbase = proj + (size_t)(b * SEQ) * LDP + 1536 + h * 256 + es * 32;
    f32x4 R[2] = {(f32x4){0.f, 0.f, 0.f, 0.f}, (f32x4){0.f, 0.f, 0.f, 0.f}};
    u32x4 kreg[4], vreg;
#define RS_ISSUE(n) do { _Pragma("unroll") for (int i_ = 0; i_ < 4; ++i_) { const int c_ = tid + NTHREADS * i_; kreg[i_] = *(const GAS u32x4*)(kbase + (size_t)((n) * 128 + (c_ >> 4)) * LDP + (c_ & 15) * 8); } \
        vreg = *(const GAS u32x4*)(vbase + (size_t)((n) * 128 + (tid >> 2)) * LDP + (tid & 3) * 8); } while (0)
    RS_ISSUE(0);
    for (int n = 0; n < 32; ++n) {
        bf16_t* rp = rprev + ((size_t)((b * 32 + n) * 6 + h) * 256 + es * 32 + l15) * 128 + wid * 16 + 4 * g;
#pragma unroll
        for (int eb = 0; eb < 2; ++eb) { u32x2 w; w.x = cvt_pk_bf16(R[eb][0], R[eb][1]); w.y = cvt_pk_bf16(R[eb][2], R[eb][3]); *(GAS u32x2*)(rp + (size_t)eb * 16 * 128) = w; }
        if (n == 31) break;
        LAS unsigned char* Kt = lds + (n & 1) * STG; LAS unsigned char* Vt = Kt + KB;
#pragma unroll
        for (int i = 0; i < 4; ++i) { const int c = tid + NTHREADS * i, t = c >> 4, cc = c & 15;
            const float zt = fexp2((float)(127 - t) * lg);
            const u32x4 w = kreg[i]; u32x4 o;
            o.x = cvt_pk_bf16(bflo(w.x) * zt, bfhi(w.x) * zt); o.y = cvt_pk_bf16(bflo(w.y) * zt, bfhi(w.y) * zt); o.z = cvt_pk_bf16(bflo(w.z) * zt, bfhi(w.z) * zt); o.w = cvt_pk_bf16(bflo(w.w) * zt, bfhi(w.w) * zt);
            *(LAS u32x4*)(Kt + t * KS + cc * 16) = o; }
        *(LAS u32x4*)(Vt + (tid >> 2) * VS + (tid & 3) * 16) = vreg;
        __syncthreads();
        if (n + 1 < 31) RS_ISSUE(n + 1);
        R[0] = R[0] * gchunk; R[1] = R[1] * gchunk;
#pragma unroll
        for (int s = 0; s < 4; ++s) {
            const bf16x8 a = cat8(vtr(Kt + (32 * s + 8 * g + q4) * KS + (16 * wid + 4 * p4) * 2), vtr(Kt + (32 * s + 8 * g + 4 + q4) * KS + (16 * wid + 4 * p4) * 2));
#pragma unroll
            for (int eb = 0; eb < 2; ++eb) {
                const bf16x8 bb = cat8(vtr(Vt + (32 * s + 8 * g + q4) * VS + (16 * eb + 4 * p4) * 2), vtr(Vt + (32 * s + 8 * g + 4 + q4) * VS + (16 * eb + 4 * p4) * 2));
                R[eb] = __builtin_amdgcn_mfma_f32_16x16x32_bf16(a, bb, R[eb], 0, 0, 0);
            }
        }
    }
#undef RS_ISSUE
    __syncthreads();
}

__device__ __forceinline__ void ret_out_unit(LAS unsigned char* lds, int tid, int wid, int lane, bf16_t* proj, const bf16_t* rprev, int u, bool dry = false) {
    asm volatile("" : "+v"(tid), "+v"(lane)); asm volatile("" : "+s"(wid));
    constexpr int KS = 272, VS = 544, KB = 128 * KS;
    const int h = u % 6, bn = u / 6, n = bn & 31, b = bn >> 5;
    const float lg = log2gamma(h);
    const int g = lane >> 4, l15 = lane & 15, q4 = l15 >> 2, p4 = l15 & 3;
    const int row0 = b * SEQ + n * 128;
    LAS unsigned char* Kt = lds; LAS unsigned char* Vt = lds + KB;
    const bf16_t* kbase = proj + (size_t)row0 * LDP + 768 + h * 128;
    const bf16_t* vbase = proj + (size_t)row0 * LDP + 1536 + h * 256;
#pragma unroll
    for (int i = 0; i < 4; ++i) { const int c = tid + NTHREADS * i, t = c >> 4, cc = c & 15; *(LAS u32x4*)(Kt + t * KS + cc * 16) = *(const GAS u32x4*)(kbase + (size_t)t * LDP + cc * 8); }
#pragma unroll
    for (int i = 0; i < 8; ++i) { const int c = tid + NTHREADS * i, t = c >> 5, cc = c & 31; *(LAS u32x4*)(Vt + t * VS + cc * 16) = *(const GAS u32x4*)(vbase + (size_t)t * LDP + cc * 8); }
    const int qrow = row0 + wid * 16 + l15;
    bf16x8 Qf[4];
#pragma unroll
    for (int k = 0; k < 4; ++k) Qf[k] = *(const GAS bf16x8*)(proj + (size_t)qrow * LDP + h * 128 + k * 32 + g * 8);
    u32x4 rreg[8];
    const bf16_t* rbase = rprev + (size_t)((b * 32 + n) * 6 + h) * 256 * 128;
#pragma unroll
    for (int i = 0; i < 8; ++i) { const int c = tid + NTHREADS * i; rreg[i] = *(const GAS u32x4*)(rbase + (size_t)c * 8); }
    __syncthreads();
    f32x4 S[8];
#pragma unroll
    for (int kb = 0; kb < 8; ++kb) S[kb] = (f32x4){0.f, 0.f, 0.f, 0.f};
#pragma unroll
    for (int kb = 0; kb < 8; ++kb) if (kb <= wid) {
#pragma unroll
        for (int k = 0; k < 4; ++k) {
            const bf16x8 a = *(const LAS bf16x8*)(Kt + (kb * 16 + l15) * KS + (k * 32 + g * 8) * 2);
            S[kb] = __builtin_amdgcn_mfma_f32_16x16x32_bf16(a, Qf[k], S[kb], 0, 0, 0);
        }
    }
    const int tq = wid * 16 + l15;
    bf16x8 Pb[4];
#pragma unroll
    for (int kb = 0; kb < 8; ++kb)
#pragma unroll
        for (int i = 0; i < 4; ++i) { const int tk = kb * 16 + 4 * g + i; S[kb][i] = (tk <= tq) ? S[kb][i] * fexp2(-(float)(tk + 1) * lg) : 0.f; }
#pragma unroll
    for (int s = 0; s < 4; ++s) Pb[s] = pack8(S[2 * s], S[2 * s + 1]);
    f32x4 O[16];
#pragma unroll
    for (int eb = 0; eb < 16; ++eb) O[eb] = (f32x4){0.f, 0.f, 0.f, 0.f};
#pragma unroll
    for (int s = 0; s < 4; ++s) if (2 * s <= wid) {
#pragma unroll
        for (int eb = 0; eb < 16; ++eb) {
            const bf16x8 a = cat8(vtr(Vt + (32 * s + 4 * g + q4) * VS + (16 * eb + 4 * p4) * 2), vtr(Vt + (32 * s + 16 + 4 * g + q4) * VS + (16 * eb + 4 * p4) * 2));
            O[eb] = __builtin_amdgcn_mfma_f32_16x16x32_bf16(a, Pb[s], O[eb], 0, 0, 0);
        }
    }
    __syncthreads();
#pragma unroll
    for (int i = 0; i < 8; ++i) { const int c = tid + NTHREADS * i; *(LAS u32x4*)(Vt + (c >> 4) * KS + (c & 15) * 16) = rreg[i]; }
    __syncthreads();
#pragma unroll
    for (int eb = 0; eb < 16; ++eb)
#pragma unroll
        for (int k = 0; k < 4; ++k) {
            const bf16x8 a = *(const LAS bf16x8*)(Vt + (eb * 16 + l15) * KS + (k * 32 + g * 8) * 2);
            O[eb] = __builtin_amdgcn_mfma_f32_16x16x32_bf16(a, Qf[k], O[eb], 0, 0, 0);
        }
    const float xi = fexp2((float)(tq + 1) * lg);
    float ss = 0.f;
#pragma unroll
    for (int eb = 0; eb < 16; ++eb) { O[eb] = O[eb] * xi; ss += (O[eb][0] * O[eb][0] + O[eb][1] * O[eb][1]) + (O[eb][2] * O[eb][2] + O[eb][3] * O[eb][3]); }
    ss += __shfl_xor(ss, 16); ss += __shfl_xor(ss, 32);
    const float rstd = __builtin_amdgcn_rsqf(ss * (1.0f / 256.0f) + EPSN);
    bf16_t* zp = proj + (size_t)qrow * LDP + 3584 + h * 256 + 4 * g;
#pragma unroll
    for (int eb = 0; eb < 16; ++eb) {
        const u32x2 z = *(const GAS u32x2*)(zp + 16 * eb);
        const f32x4 o = O[eb] * rstd;
        u32x2 w; w.x = cvt_pk_bf16(silu_mul(o[0], bflo(z.x)), silu_mul(o[1], bfhi(z.x))); w.y = cvt_pk_bf16(silu_mul(o[2], bflo(z.y)), silu_mul(o[3], bfhi(z.y)));
        if (!dry) *(GAS u32x2*)(zp + 16 * eb) = w;
    }
    __syncthreads();
}

#define XB_TMO      128
#define XB_XCNT(j)  (256  + 64 * (j))
#define XB_XSUB(j)  (1280 + 64 * (j))
#define XB_XGEN(j)  (2304 + 64 * (j))
#define XB_TOP      3328
#define XB_TOPGEN   3392
#define XCD_BAR_WORDS 3456
#define XB_SPIN_CAP (1u << 18)

__device__ __forceinline__ unsigned xb_ld(unsigned* p)              { return __hip_atomic_load(p, __ATOMIC_RELAXED, __HIP_MEMORY_SCOPE_AGENT); }
__device__ __forceinline__ unsigned xb_add(unsigned* p, unsigned v) { return __hip_atomic_fetch_add(p, v, __ATOMIC_RELAXED, __HIP_MEMORY_SCOPE_AGENT); }
__device__ __forceinline__ unsigned xb_xcc_id() { return (unsigned)__builtin_amdgcn_s_getreg((3 << 11) | 20) & 0xFu; }
#define XB_SPIN(cond, bar) do { unsigned _sp = 0; while (cond) { __builtin_amdgcn_s_sleep(1); \
    if ((++_sp & 255u) == 0u) { if (xb_ld(&(bar)[XB_TMO])) break; if (_sp > XB_SPIN_CAP) { atomicAdd(&(bar)[XB_TMO], 1u); break; } } } } while (0)

struct XcdBarrier {
    unsigned* bar; unsigned x;
    volatile LAS unsigned* st;
};

__device__ __forceinline__ XcdBarrier xcd_barrier_post(unsigned* bar, volatile LAS unsigned* st) {
    XcdBarrier b; b.bar = bar; b.x = xb_xcc_id(); b.st = st;
    if (threadIdx.x == 0) (void)xb_add(&bar[XB_XCNT(b.x)], 1u);
    return b;
}
__device__ __forceinline__ void xcd_barrier_complete(unsigned* bar, unsigned x, unsigned& nloc, unsigned& nx) {
    const unsigned G = gridDim.x * gridDim.y * gridDim.z;
    unsigned sum, cnt, mine, sp = 0u;
    for (;;) {
        sum = 0u; cnt = 0u; mine = 0u;
#pragma unroll
        for (unsigned j = 0; j < 16; ++j) { const unsigned c = xb_ld(&bar[XB_XCNT(j)]); sum += c; cnt += (c > 0u) ? 1u : 0u; mine = (j == x) ? c : mine; }
        if (sum == G) break;
        __builtin_amdgcn_s_sleep(1);
        if ((++sp & 255u) == 0u) { if (xb_ld(&bar[XB_TMO])) break; if (sp > XB_SPIN_CAP) { atomicAdd(&bar[XB_TMO], 1u); break; } }
    }
    nloc = mine > 0u ? mine : 1u; nx = cnt > 0u ? cnt : 1u;
}

__device__ __forceinline__ void xcd_barrier(const XcdBarrier& b) {
    asm volatile("s_waitcnt vmcnt(0)" ::: "memory");
    __syncthreads();
    if (threadIdx.x == 0) {
        unsigned* bar = b.bar;
        __builtin_amdgcn_s_waitcnt(0);
        unsigned nloc = b.st[0], nx = b.st[1];
        if (nloc == 0u) { xcd_barrier_complete(bar, b.x, nloc, nx); b.st[0] = nloc; b.st[1] = nx; }
        const unsigned old = xb_add(&bar[XB_XSUB(b.x)], 1u);
        const unsigned gen = old / nloc;
        if (old + 1u == (gen + 1u) * nloc) {
            __builtin_amdgcn_fence(__ATOMIC_RELEASE, "agent");
            asm volatile("s_waitcnt vmcnt(0)" ::: "memory");
            const unsigned og = xb_add(&bar[XB_TOP], 1u);
            const unsigned tg = og / nx;
            if (og + 1u == (tg + 1u) * nx) xb_add(&bar[XB_TOPGEN], 1u);
            else XB_SPIN(xb_ld(&bar[XB_TOPGEN]) == tg, bar);
            __builtin_amdgcn_fence(__ATOMIC_ACQUIRE, "agent");
            xb_add(&bar[XB_XGEN(b.x)], 1u);
            asm volatile("s_waitcnt vmcnt(0)" ::: "memory");
        } else {
            XB_SPIN(xb_ld(&bar[XB_XGEN(b.x)]) == gen, bar);
            __builtin_amdgcn_fence(__ATOMIC_ACQUIRE, "agent");
            asm volatile("s_waitcnt vmcnt(0)" ::: "memory");
        }
    }
    __syncthreads();
}


#define CONV_WEIGHTS(MASK, worker, nworkers) do { \
        int lane_ = lane, wid_ = wid; asm volatile("" : "+v"(lane_)); asm volatile("" : "+s"(wid_)); LAS float* scr_ = (LAS float*)(lds + wid_ * 16640); \
        int total_ = 0; \
        _Pragma("unroll 1") for (int mi_ = 0; mi_ < 9; ++mi_) if (((MASK) >> mi_) & 1u) total_ += 32 * (mi_ < 4 ? pg8::npad_of(mi_ == 3 ? 0 : mi_) / 64 : (mi_ < 8 ? 32 : 16)); \
        for (int it_ = (worker); it_ < total_; it_ += (nworkers)) { \
            int r_ = it_; \
            _Pragma("unroll 1") for (int mi = 0; mi < 9; ++mi) { \
                if (!(((MASK) >> mi) & 1u)) continue; \
                const float* W; int N, mid_, nblk; const float* gv; bf16_t* WT; \
                if (mi < 4) { const int l_ = mi; mid_ = l_ == 3 ? 0 : l_; N = pg8::nc_of(mid_); nblk = pg8::npad_of(mid_) / 64; \
                    W = args.in[l_ == 0 ? 6 : l_ == 1 ? 10 : l_ == 2 ? 13 : 16]; gv = args.in[l_ == 0 ? 5 : l_ == 1 ? 9 : l_ == 2 ? 12 : 15]; \
                    WT = (bf16_t*)(ws + (l_ == 0 ? WS_WIN0 : l_ == 1 ? WS_WIN1 : l_ == 2 ? WS_WIN2 : WS_WIN3)); } \
                else if (mi < 8) { const int l_ = mi - 4; mid_ = -1; N = 2048; nblk = 32; W = args.in[l_ == 0 ? 8 : l_ == 1 ? 11 : l_ == 2 ? 14 : 18]; gv = nullptr; WT = woutT + (size_t)l_ * 2048 * 2048; } \
                else { mid_ = -1; N = 1024; nblk = 16; W = args.in[4]; gv = args.in[3]; WT = wmemT; } \
                const int cnt_ = 32 * nblk; \
                if (r_ < cnt_) { transpose_item(W, N, mid_, gv, WT, nblk, r_, lane_, scr_); break; } \
                r_ -= cnt_; \
            } \
        } } while (0)

struct Args { const float* in[20]; float* out; unsigned char* ws; };

__device__ __forceinline__ int fetch_unit(unsigned* ctr, volatile LAS unsigned* slot, int tid) {
    if (tid == 0) *slot = atomicAdd(ctr, 1u);
    __syncthreads();
    const unsigned v = *slot;
    __syncthreads();
    return __builtin_amdgcn_readfirstlane((int)v);
}

__global__ void __launch_bounds__(NTHREADS, 2) trunk_fwd(Args args) {
    extern __shared__ __attribute__((aligned(16))) unsigned char lds_raw[];
    cg::grid_group grid = cg::this_grid();
    LAS unsigned char* lds = (LAS unsigned char*)lds_raw;
    volatile LAS unsigned* misc = (volatile LAS unsigned*)(lds + LDS_MISC);
    const int tid = threadIdx.x, lane = tid & 63, wid = __builtin_amdgcn_readfirstlane(tid >> 6);
    const int G = gridDim.x, bx = blockIdx.x;
#define WS_PTRS() unsigned char* ws = args.ws; asm volatile("" : "+s"(ws)); \
    unsigned* ctl = (unsigned*)(ws + WS_CTL); bf16_t* hb = (bf16_t*)(ws + WS_HB); bf16_t* proj = (bf16_t*)(ws + WS_PROJ); \
    bf16_t* memb = (bf16_t*)(ws + WS_MEMB); bf16_t* mkv = (bf16_t*)(ws + WS_MKV); float* rss = (float*)(ws + WS_RSS); float* rssm = (float*)(ws + WS_RSSM); \
    float* ropeA = (float*)(ws + WS_ROPEA); float* ropeB = (float*)(ws + WS_ROPEB); float* ropeC = (float*)(ws + WS_ROPEC); \
    float* kmean = (float*)(ws + WS_KMEAN); bf16_t* rprev = (bf16_t*)(ws + WS_RPREV); bf16_t* woutT = (bf16_t*)(ws + WS_WOUT); bf16_t* wmemT = (bf16_t*)(ws + WS_WMEM); \
    (void)ctl; (void)hb; (void)proj; (void)memb; (void)mkv; (void)rss; (void)rssm; (void)ropeA; (void)ropeB; (void)ropeC; (void)kmean; (void)rprev; (void)woutT; (void)wmemT
#ifndef REP_P0
#define REP_P0 1
#endif
    for (int rep0 = 0; rep0 < REP_P0; ++rep0) {
        if (rep0) grid.sync();
        WS_PTRS(); const float* x = args.in[0];
        const int gw = bx * NWAVES + wid, NGW = G * NWAVES;
        LAS float* scr = (LAS float*)(lds + wid * 16640);
        if (G == 256) CONV_WEIGHTS(0x111u, gw, NGW); else CONV_WEIGHTS(0x1FFu, gw, NGW);
        for (int m = gw; m < MTOK; m += NGW) row_to_bf16(x + (size_t)m * DMODEL, hb + (size_t)m * DMODEL, rss + m, lane);
        for (int m = gw; m < NB * NMEMTOK; m += NGW) row_to_bf16(args.in[1] + (size_t)m * DMODEL, memb + (size_t)m * DMODEL, rssm + m, lane);
        const int* positions = (const int*)args.in[2];
        const int gt = bx * NTHREADS + tid, NGT = G * NTHREADS;
        for (int i = gt; i < MTOK * 88; i += NGT) {
            const int tok = i / 88, f = i % 88;
            float* tb; int F, fl;
            if (f < 8) { tb = ropeA; F = 8; fl = f; } else if (f < 24) { tb = ropeB; F = 16; fl = f - 8; } else { tb = ropeC; F = 64; fl = f - 24; }
            const double rev = (double)positions[tok] * INVF[f] * 0.15915494309189535;
            const float fr = (float)(rev - __builtin_rint(rev));
            tb[(size_t)tok * 2 * F + fl] = __builtin_amdgcn_cosf(fr); tb[(size_t)tok * 2 * F + F + fl] = __builtin_amdgcn_sinf(fr);
        }
        for (int i = gt; i < 4 * MTOK; i += NGT) rss[MTOK + i] = 0.f;
        if (bx == 0) for (int i = tid; i < 1024 + XCD_BAR_WORDS; i += NTHREADS) ctl[i] = 0u;
    }
    grid.sync();
    if (tid < 2) misc[8 + tid] = 0u;
    __syncthreads();
    XcdBarrier xbar;
    { unsigned char* ws0 = args.ws; xbar = xcd_barrier_post((unsigned*)(ws0 + WS_CTL) + 1024, misc + 8); }
#define GRID_SYNC() xcd_barrier(xbar)

    const float L2E = 1.4426950408889634f;
#pragma unroll 1
    for (int l = 0; l < 4; ++l) {
        const int mid = (l == 3) ? 0 : l;
        const int nmix = pg8::nmix_of(mid), zoff = nmix + 512;
#pragma unroll 1
#ifndef REP_P1
#define REP_P1 1
#endif
        for (int rep1 = 0; rep1 < REP_P1; ++rep1)
        for (int pass = 0; pass < (l == 0 ? 2 : 1); ++pass) {
            WS_PTRS();
            pg8::Gemm g; pg8::StaticOrder S; pg8::EpiIn E;
            if (pass == 0) {
                g.A = hb; g.Bt = (const bf16_t*)(ws + (l == 0 ? WS_WIN0 : l == 1 ? WS_WIN1 : l == 2 ? WS_WIN2 : WS_WIN3)); g.lda = DMODEL; g.K = DMODEL;
                S.init(MTOK, pg8::npad_of(mid), G, bx);
                E.O = proj; E.ldc = LDP; E.mid = mid; E.rss = rss + (size_t)l * MTOK;
            } else {
                g.A = memb; g.Bt = wmemT; g.lda = DMODEL; g.K = DMODEL;
                S.init(NB * NMEMTOK, 1024, 1 << 20, bx - (G == 256 ? 240 : 0));
                E.O = mkv; E.ldc = 1024; E.mid = 3; E.rss = rssm;
            }
            E.rope0 = ropeA;

#ifndef SK_P1
pg8::gemm_phase<pg8::EpiIn, pg8::StaticOrder, true, true>(lds, g, S, E);
#endif

            __syncthreads();
        }
        if (l == 0 && G == 256 && bx >= 128 && bx < 240) {
            WS_PTRS();
            CONV_WEIGHTS(0x066u, (bx - 128) * NWAVES + wid, 112 * NWAVES);
        } else if (l == 2 && G == 256 && bx >= 128) {
            WS_PTRS();
            CONV_WEIGHTS(0x088u, (bx - 128) * NWAVES + wid, 128 * NWAVES);
        }
        GRID_SYNC();

        const int nsub = (mid == 0) ? 1 : 2;
#pragma unroll 1
        for (int sub = 0; sub < nsub; ++sub) {
            int nA, nMem;
            if (mid == 0) { nA = 1536; nMem = 256; } else if (sub == 0) { nA = (mid == 1) ? 768 : 192; nMem = 256; } else { nA = (mid == 1) ? 96 : 768; nMem = 0; }
#ifndef REP_P2
#define REP_P2 1
#endif
#ifndef REP_MID
#define REP_MID mid
#endif
            const int nrep = (mid == (REP_MID)) ? REP_P2 : 1;
            for (int rep = 0; rep < nrep; ++rep) {
            const bool dry = rep < nrep - 1;
            WS_PTRS();
            unsigned* ctr = ctl + (l * 2 + sub) + 16 * rep;
            if (mid == 1 && sub == 1) ctr = ctl + 128 + 64 * (bx & 7) + 16 * rep;
            int u = fetch_unit(ctr, misc, tid);
            if (mid == 0) {
                while (u < nA) {
                    const int hp = u & 3, n = (u >> 2) & 31, r = u >> 7, kvh = r % 3, b = r / 3;
                    const int head = kvh * 8 + hp * 2 + (wid >> 2);
                    const float sink = args.in[l == 0 ? 7 : 17][head] * L2E;
#ifndef SK_SWA
                    attn_unit<64, MODE_SWA>(lds, tid, wid, lane, proj + head * 64, b * SEQ + n * 128 + (wid & 3) * 32, proj + 1536 + kvh * 64, proj + 1728 + kvh * 64, LDP,
                                            n == 0 ? 2 : 4, b * SEQ + n * 128 - (n ? 128 : 0), 0, sink, 1.f, 0u, 0u, proj + zoff + head * 64, dry);
#endif
                    u = fetch_unit(ctr, misc, tid);
                }
            } else if (mid == 1 && sub == 0) {
                while (u < nA) {
#ifndef SK_KMEAN
                    kmean_unit(lds, tid, proj, kmean, u);
#endif
                    u = fetch_unit(ctr, misc, tid);
                }
            } else if (mid == 1) {
                while (u < nA) {
                    const int qb = 15 - u / 6, bh = (bx & 7) + 8 * (u % 6), b = bh / 12, h = bh % 12;
#ifndef SK_MOBA
                    moba_gate(lds, tid, proj, kmean, b, h, qb);
                    volatile LAS unsigned* selm = (volatile LAS unsigned*)(lds + LDS_MISC - 2048);
                    const unsigned s0 = selm[wid * 32 + (lane & 15)], s1 = selm[wid * 32 + 16 + (lane & 15)];
                    __syncthreads();
                    attn_unit<128, MODE_MOBA>(lds, tid, wid, lane, proj + h * 128, b * SEQ + qb * 256 + wid * 32, proj + 1536 + h * 128, proj + 3072 + h * 128, LDP,
                                              4 + 4 * qb, b * SEQ + qb * 256, b * SEQ, -1e30f, 0.f, s0, s1, proj + zoff + h * 128, dry);
#endif
                    u = fetch_unit(ctr, misc, tid);
                }
            } else if (sub == 0) {
                while (u < nA) {
#ifndef SK_SCAN
                    ret_scan_item(lds, tid, wid, lane, proj, rprev, u);
#endif
                    u = fetch_unit(ctr, misc, tid);
                }
            } else {
                while (u < nA) {
#ifndef SK_ROUT
                    ret_out_unit(lds, tid, wid, lane, proj, rprev, u, dry);
#endif
                    u = fetch_unit(ctr, misc, tid);
                }
            }
            while (u < nA + nMem) {
                const int v = u - nA, hm = v & 3, qt = (v >> 2) & 15, b = v >> 6;
#ifndef SK_MEM
                attn_unit<128, MODE_MEM>(lds, tid, wid, lane, proj + nmix + hm * 128, b * SEQ + qt * 256 + wid * 32, mkv + hm * 128, mkv + 512 + hm * 128, 1024,
                                         4, b * NMEMTOK, 0, -1e30f, 0.f, 0u, 0u, proj + zoff + 1536 + hm * 128, dry);
#endif
                u = fetch_unit(ctr, misc, tid);
            }
            GRID_SYNC();
            }
        }

        {
            WS_PTRS(); const float* x = args.in[0]; float* out = args.out;
            pg8::Gemm g; g.A = proj + zoff; g.Bt = woutT + (size_t)l * 2048 * 2048; g.lda = LDP; g.K = DMODEL;
            pg8::StaticOrder S; S.init(MTOK, DMODEL, G, bx);
            pg8::EpiOut E; E.basef = x; E.out = out; E.hb = hb; E.rssn = rss + (size_t)(l + 1) * MTOK; E.mode = (l == 0) ? 0 : (l == 3 ? 2 : 1);

#ifndef SK_P3
pg8::gemm_phase<pg8::EpiOut, pg8::StaticOrder, true, true>(lds, g, S, E);
#endif

            __syncthreads();
        }
        GRID_SYNC();
    }

#ifdef EXTRA_SYNCS
    for (int i = 0; i < EXTRA_SYNCS; ++i) GRID_SYNC();
#endif
    {
        const int gw = bx * NWAVES + wid, NGW = G * NWAVES;
        WS_PTRS(); float* out = args.out;
        const float* gf = args.in[19];
        for (int m = gw; m < MTOK; m += NGW) {
            const float s = __builtin_amdgcn_rsqf(rss[4 * MTOK + m] * (1.0f / DMODEL) + EPSN);
            f32x4* xr = (f32x4*)(out + (size_t)m * DMODEL) + lane; const f32x4* gr = (const f32x4*)gf + lane;
#pragma unroll
            for (int j = 0; j < 8; ++j) { const f32x4 v = xr[64 * j]; xr[64 * j] = v * s * gr[64 * j]; }
        }
    }
}

extern "C" void kernel_launch(void* const* d_in, const int* in_sizes, int n_in, void* d_out, int out_size, void* d_ws, size_t ws_size, hipStream_t stream) {
    static int grid = 0;
    if (grid == 0) {
        if (n_in != 20 || out_size != MTOK * DMODEL || ws_size < WS_END) { fprintf(stderr, "kernel_launch: unexpected shapes (n_in %d, out %d, ws %zu, need %zu)\n", n_in, out_size, ws_size, (size_t)WS_END); grid = -1; return; }
        int dev = 0, cus = 0, per_cu = 0;
        hipGetDevice(&dev); hipDeviceGetAttribute(&cus, hipDeviceAttributeMultiprocessorCount, dev);
        hipFuncSetAttribute((const void*)trunk_fwd, hipFuncAttributeMaxDynamicSharedMemorySize, LDS_BYTES);
        if (hipOccupancyMaxActiveBlocksPerMultiprocessor(&per_cu, (const void*)trunk_fwd, NTHREADS, LDS_BYTES) != hipSuccess || per_cu < 1) { fprintf(stderr, "kernel_launch: occupancy query gave %d\n", per_cu); per_cu = 1; }
        (void)hipGetLastError();
        grid = cus;
        if (grid != 256) fprintf(stderr, "kernel_launch: note: %d CUs\n", grid);
    }
    if (grid < 0) return;
    Args a{};
    for (int i = 0; i < 20; ++i) a.in[i] = (const float*)d_in[i];
    a.out = (float*)d_out; a.ws = (unsigned char*)d_ws;
    void* kargs[] = {&a};
    hipError_t e = hipLaunchCooperativeKernel((const void*)trunk_fwd, dim3(grid), dim3(NTHREADS), kargs, LDS_BYTES, stream);
    if (e != hipSuccess) fprintf(stderr, "cooperative launch failed: %s (grid %d)\n", hipGetErrorString(e), grid);
}
```

```cpp
#include <hip/hip_runtime.h>
#include <hip/hip_cooperative_groups.h>
#include <cstdio>
#include <cstdint>
namespace cg = cooperative_groups;
#define GAS __attribute__((address_space(1)))
namespace pg8 {
#define PG8_LAS __attribute__((address_space(3)))
typedef unsigned short bf16_t;
typedef short bf16x8 __attribute__((ext_vector_type(8)));
typedef float f32x4 __attribute__((ext_vector_type(4)));
typedef unsigned u32x4 __attribute__((ext_vector_type(4)));
constexpr int BM = 256, BK = 64, HALF = 128, HTB = HALF * BK * 2  , STAGE_BYTES = 8 * HTB, NXCD = 8, WGM = 8;

__host__ __device__ __forceinline__ int lds_byte(int r, int c) { const int st = (r >> 4) * 2 + (c >> 5), rr = r & 15, cc = c & 31, ob = rr * 64 + cc * 2; return st * 1024 + (ob ^ (((ob >> 9) & 1) << 5)); }
__host__ __device__ __forceinline__ void stage_rc(int b, int& R, int& C) { const int st = b / 1024, sb = b % 1024, swz = sb ^ (((sb >> 9) & 1) << 5); R = (st >> 1) * 16 + swz / 64; C = (st & 1) * 32 + (swz % 64) / 2; }
__host__ __device__ __forceinline__ int perm32(int rho) { const int n = rho >> 4, i = rho & 15; return 8 * (i >> 2) + 4 * n + (i & 3); }

struct Unit { int pm, pn; };
struct Gemm { const bf16_t* A; const bf16_t* Bt; int lda, K; };

struct StaticOrder {
    int nM, nN, nwg, G, c;
    __host__ __device__ void init(int M, int N, int G_, int c_) { nM = M / BM; nN = N / BM; nwg = nM * nN; G = G_; c = c_; }
    __host__ __device__ bool next(int i, Unit& u) const {
        const long L = (long)i * G + c; if (L >= nwg || c < 0) return false;
        int wgid = (int)L; { const int q = nwg / NXCD, r = nwg % NXCD, xcd = wgid % NXCD, off = wgid / NXCD; wgid = (xcd < r ? xcd * (q + 1) : r * (q + 1) + (xcd - r) * q) + off; }
        const int nig = WGM * nN, gid = wgid / nig, fm = gid * WGM, gsz = (nM - fm) < WGM ? (nM - fm) : WGM;
        u.pm = fm + ((wgid % nig) % gsz); u.pn = (wgid % nig) / gsz; return true;
    }
    __device__ __forceinline__ void a_ready(const Unit&) const {}
    __device__ __forceinline__ void done(const Unit&) const {}
};

__device__ __forceinline__ unsigned cvt_pk_bf16(float lo, float hi) { unsigned r; asm volatile("v_cvt_pk_bf16_f32 %0, %1, %2" : "=v"(r) : "v"(lo), "v"(hi)); return r; }
constexpr int NB = 4, SEQ = 4096, DMODEL = 2048, MTOK = NB * SEQ, NMEMTOK = 256, LDP = 7168;
constexpr float EPSN = 1e-6f;
__host__ __device__ constexpr int nc_of(int mid)   { return mid == 0 ? 4480 : (mid == 1 ? 7168 : 5632); }
__host__ __device__ constexpr int npad_of(int mid) { return mid == 0 ? 4608 : (mid == 1 ? 7168 : 5632); }
__host__ __device__ constexpr int nmix_of(int mid) { return mid == 0 ? 1920 : (mid == 1 ? 4608 : 3072); }

struct GDesc { int dst0, dst1, rope, rstr; float scale; };
__device__ __forceinline__ GDesc gdesc(int mid, int j0) {
    GDesc d; d.dst0 = j0; d.dst1 = j0 + 4; d.rope = -1; d.rstr = 0; d.scale = 1.f;
    const float L2E = 1.4426950408889634f, R128 = 0.08838834764831845f;
    if (mid == 0) {
        if (j0 >= 4480) { d.dst0 = -1; return d; }
        if (j0 < 1728) { const int hb = j0 & ~63, lg = (j0 & 63) >> 3;
            if (lg < 2) { d.dst0 = hb + 4 * lg; d.dst1 = hb + 8 + 4 * lg; d.rope = 4 * lg; d.rstr = 16; }
            if (j0 < 1536) d.scale = 0.125f * L2E; }
        else if (j0 >= 1920 && j0 < 2432) d.scale = R128 * L2E;
    } else if (mid == 1) {
        if (j0 < 3072) { const int hb = j0 & ~127, lg = (j0 & 127) >> 3;
            if (lg < 4) { d.dst0 = hb + 4 * lg; d.dst1 = hb + 16 + 4 * lg; d.rope = MTOK * 16 + 4 * lg; d.rstr = 32; }
            if (j0 < 1536) d.scale = R128 * L2E; }
        else if (j0 >= 4608 && j0 < 5120) d.scale = R128 * L2E;
    } else if (mid == 2) {
        if (j0 < 1536) { const int hb = j0 & ~127, lg = (j0 & 127) >> 3;
            d.dst0 = hb + 4 * lg; d.dst1 = hb + 64 + 4 * lg; d.rope = MTOK * 48 + 4 * lg; d.rstr = 128;
            if (j0 >= 768) d.scale = R128; }
        else if (j0 >= 3072 && j0 < 3584) d.scale = R128 * L2E;
    }
    return d;
}
__device__ __forceinline__ int src_col(int mid, int j) { const GDesc d = gdesc(mid, j & ~7); if (d.dst0 < 0) return -1; return (j & 4) ? d.dst1 + (j & 3) : d.dst0 + (j & 3); }

typedef unsigned u32x2 __attribute__((ext_vector_type(2)));
struct EpiIn {
    static constexpr bool PERM = true, AFTER_DRAIN = false;
    bf16_t* O; int ldc, mid; const float* rss; const float* rope0;
    __device__ __forceinline__ void operator()(const f32x4 (&acc)[2][2][4][2], const Unit& u, int wr, int wc, int fr, int fq) const {
        const int row0 = u.pm * BM + wr * 64 + fr;
        GDesc d[2];
#pragma unroll
        for (int bj = 0; bj < 2; ++bj) d[bj] = gdesc(mid, u.pn * BM + bj * HALF + wc * 32 + 8 * fq);
#pragma unroll
        for (int ai = 0; ai < 2; ++ai)
#pragma unroll
            for (int m = 0; m < 4; ++m) {
                const int r = row0 + ai * HALF + m * 16;
                const float s = __builtin_amdgcn_rsqf(rss[r] * (1.0f / DMODEL) + EPSN);
                bf16_t* rowp = O + (size_t)r * ldc;
#pragma unroll
                for (int bj = 0; bj < 2; ++bj) {
                    if (d[bj].dst0 < 0) continue;
                    const float sc = s * d[bj].scale;
                    f32x4 v0 = acc[ai][bj][m][0] * sc, v1 = acc[ai][bj][m][1] * sc;
                    if (d[bj].rope >= 0) {
                        const float* t = rope0 + d[bj].rope + (size_t)r * d[bj].rstr; const int F = d[bj].rstr >> 1;
                        const f32x4 c = *(const GAS f32x4*)t, sn = *(const GAS f32x4*)(t + F);
                        const f32x4 n0 = v0 * c - v1 * sn, n1 = v1 * c + v0 * sn; v0 = n0; v1 = n1;
                    }
                    u32x2 w0, w1; w0.x = cvt_pk_bf16(v0[0], v0[1]); w0.y = cvt_pk_bf16(v0[2], v0[3]); w1.x = cvt_pk_bf16(v1[0], v1[1]); w1.y = cvt_pk_bf16(v1[2], v1[3]);
                    if (d[bj].dst1 == d[bj].dst0 + 4) { u32x4 w; w.x = w0.x; w.y = w0.y; w.z = w1.x; w.w = w1.y; *(GAS u32x4*)(rowp + d[bj].dst0) = w; }
                    else { *(GAS u32x2*)(rowp + d[bj].dst0) = w0; *(GAS u32x2*)(rowp + d[bj].dst1) = w1; }
                }
            }
    }
};
struct EpiOut {
    static constexpr bool PERM = true, AFTER_DRAIN = false;
    const float* basef; float* out; bf16_t* hb; float* rssn; int mode;
    __device__ __forceinline__ void operator()(const f32x4 (&acc)[2][2][4][2], const Unit& u, int wr, int wc, int fr, int fq) const {
        const int row0 = u.pm * BM + wr * 64 + fr, col0 = u.pn * BM + wc * 32 + 8 * fq;
#pragma unroll
        for (int ai = 0; ai < 2; ++ai)
#pragma unroll
            for (int m = 0; m < 4; ++m) {
                const int r = row0 + ai * HALF + m * 16; float ss = 0.f;
#pragma unroll
                for (int bj = 0; bj < 2; ++bj) {
                    const size_t off = (size_t)r * DMODEL + col0 + bj * HALF;
                    f32x4 b0, b1;
                    if (mode == 0) { b0 = *(const GAS f32x4*)(basef + off); b1 = *(const GAS f32x4*)(basef + off + 4); }
                    else { const u32x4 hw = *(const GAS u32x4*)(hb + off);
                        b0 = (f32x4){__builtin_bit_cast(float, hw.x << 16), __builtin_bit_cast(float, hw.x & 0xffff0000u), __builtin_bit_cast(float, hw.y << 16), __builtin_bit_cast(float, hw.y & 0xffff0000u)};
                        b1 = (f32x4){__builtin_bit_cast(float, hw.z << 16), __builtin_bit_cast(float, hw.z & 0xffff0000u), __builtin_bit_cast(float, hw.w << 16), __builtin_bit_cast(float, hw.w & 0xffff0000u)}; }
                    const f32x4 v0 = acc[ai][bj][m][0] + b0, v1 = acc[ai][bj][m][1] + b1;
                    if (mode == 2) { *(GAS f32x4*)(out + off) = v0; *(GAS f32x4*)(out + off + 4) = v1; }
                    else { u32x4 w; w.x = cvt_pk_bf16(v0[0], v0[1]); w.y = cvt_pk_bf16(v0[2], v0[3]); w.z = cvt_pk_bf16(v1[0], v1[1]); w.w = cvt_pk_bf16(v1[2], v1[3]);
                        *(GAS u32x4*)(hb + off) = w; }
                    ss += (v0[0] * v0[0] + v0[1] * v0[1]) + (v0[2] * v0[2] + v0[3] * v0[3]) + (v1[0] * v1[0] + v1[1] * v1[1]) + (v1[2] * v1[2] + v1[3] * v1[3]);
                }
                ss += __shfl_xor(ss, 16); ss += __shfl_xor(ss, 32);
                if (fq == 0) (void)__hip_atomic_fetch_add((GAS float*)(rssn + r), ss, __ATOMIC_RELAXED, __HIP_MEMORY_SCOPE_AGENT);
                if (m & 1) asm volatile("" ::: "memory");
            }
    }
};

template <class Epi, class Sched, bool ALIGN_EPI = false, bool SP2 = false>
__device__ __forceinline__ void gemm_phase(PG8_LAS unsigned char* lds, const Gemm g, const Sched& S, const Epi& E) {
    int tid_ = threadIdx.x; asm volatile("" : "+v"(tid_));
    const int tid = tid_, wid = __builtin_amdgcn_readfirstlane(tid >> 6), lane = tid & 63, wr = wid >> 2, wc = wid & 3, fr = lane & 15, fq = lane >> 4;
    const int K = g.K, nt = K / BK;
    unsigned voffA[2], voffB[2];
#pragma unroll
    for (int i = 0; i < 2; ++i) { int R, C; stage_rc(tid * 16 + i * 8192, R, C); const int Rb = Epi::PERM ? ((R & ~31) + perm32(R & 31)) : R;
        voffA[i] = (unsigned)(R * g.lda + C) * 2u; voffB[i] = (unsigned)(Rb * K + C) * 2u; }
    const size_t kstep = (size_t)(BK * 2);
    const size_t hstepA = (size_t)HALF * g.lda * 2, hstepB = (size_t)HALF * K * 2;
    const size_t tstepA = 2 * hstepA, tstepB = 2 * hstepB;
    const unsigned ldsw = (unsigned)wid * 1024u;
    const int aoff = lds_byte(wr * 64 + fr, fq * 8), boff = lds_byte(wc * 32 + fr, fq * 8);
#define PG8_SA(b, h) (((b) * 2 + (h)) * HTB)
#define PG8_SB(b, h) ((4 + (b) * 2 + (h)) * HTB)
#define PG8_STAGE(bufoff, gbase, voff) do { _Pragma("unroll") for (int _i = 0; _i < 2; ++_i) \
        __builtin_amdgcn_global_load_lds((const unsigned*)((const char*)(gbase) + (voff)[_i]), (PG8_LAS unsigned*)(lds + (bufoff) + ldsw + _i * 8192), 16, 0, 0); } while (0)
#define PG8_LDA(dst, b, h) do { _Pragma("unroll") for (int m = 0; m < 4; ++m) _Pragma("unroll") for (int k = 0; k < 2; ++k) dst[m][k] = *(const PG8_LAS bf16x8*)(lds + PG8_SA(b, h) + aoff + m * 2048 + k * 1024); } while (0)
#define PG8_LDB(dst, b, h) do { _Pragma("unroll") for (int n = 0; n < 2; ++n) _Pragma("unroll") for (int k = 0; k < 2; ++k) dst[n][k] = *(const PG8_LAS bf16x8*)(lds + PG8_SB(b, h) + boff + n * 2048 + k * 1024); } while (0)
#define PG8_MMA(ai, bj, At, Bt) do { __builtin_amdgcn_s_setprio(1); _Pragma("unroll") for (int m = 0; m < 4; ++m) _Pragma("unroll") for (int n = 0; n < 2; ++n) _Pragma("unroll") for (int k = 0; k < 2; ++k) \
        acc[ai][bj][m][n] = __builtin_amdgcn_mfma_f32_16x16x32_bf16(Bt[n][k], At[m][k], acc[ai][bj][m][n], 0, 0, 0); __builtin_amdgcn_s_setprio(0); } while (0)
#define PG8_WAIT_V(n) asm volatile("s_waitcnt vmcnt(" #n ")" ::: "memory")
#define PG8_WAIT_L(n) asm volatile("s_waitcnt lgkmcnt(" #n ")" ::: "memory")
#define PG8_BAR __builtin_amdgcn_s_barrier()
#define PG8_SCHED __builtin_amdgcn_sched_barrier(0)
    Unit cur, nxt; int ui = 0;
    if (!S.next(0, cur)) return;
    f32x4 acc[2][2][4][2];
#pragma unroll
    for (int a = 0; a < 2; ++a)
#pragma unroll
        for (int b = 0; b < 2; ++b)
#pragma unroll
            for (int m = 0; m < 4; ++m)
#pragma unroll
                for (int n = 0; n < 2; ++n) acc[a][b][m][n] = (f32x4){0.f, 0.f, 0.f, 0.f};
    bf16x8 At[4][2], B0[2][2], B1[2][2];
    const char* cA = (const char*)g.A + (size_t)cur.pm * tstepA; const char* cB = (const char*)g.Bt + (size_t)cur.pn * tstepB;
    S.a_ready(cur);
    if constexpr (SP2) {
        PG8_STAGE(PG8_SB(0, 0), cB, voffB); PG8_STAGE(PG8_SB(0, 1), cB + hstepB, voffB); PG8_STAGE(PG8_SA(0, 0), cA, voffA); PG8_STAGE(PG8_SA(0, 1), cA + hstepA, voffA);
        if (wr == 1) PG8_BAR;
        PG8_WAIT_V(2); PG8_BAR;
        PG8_STAGE(PG8_SB(1, 0), cB + kstep, voffB); PG8_STAGE(PG8_SA(1, 0), cA + kstep, voffA); PG8_STAGE(PG8_SB(1, 1), cB + hstepB + kstep, voffB);
        PG8_WAIT_V(6); PG8_BAR;
    } else {
        PG8_STAGE(PG8_SB(0, 0), cB, voffB); PG8_STAGE(PG8_SA(0, 0), cA, voffA); PG8_STAGE(PG8_SB(0, 1), cB + hstepB, voffB); PG8_STAGE(PG8_SA(0, 1), cA + hstepA, voffA);
        if (wr == 1) PG8_BAR;
        PG8_WAIT_V(4); PG8_BAR;
        PG8_STAGE(PG8_SB(1, 0), cB + kstep, voffB); PG8_STAGE(PG8_SA(1, 0), cA + kstep, voffA); PG8_STAGE(PG8_SB(1, 1), cB + hstepB + kstep, voffB);
        PG8_WAIT_V(6); PG8_BAR;
    }
    for (;;) {
        const bool has_next = S.next(ui + 1, nxt);
        const char* nA = has_next ? (const char*)g.A + (size_t)nxt.pm * tstepA : cA; const char* nB = has_next ? (const char*)g.Bt + (size_t)nxt.pn * tstepB : cB;
        for (int t = 0; t < nt; t += 2) {
            const bool last = (t == nt - 2);
            const char* a1 = cA + (size_t)(t + 1) * kstep;
            const char* a2 = last ? nA : cA + (size_t)(t + 2) * kstep; const char* b2 = last ? nB : cB + (size_t)(t + 2) * kstep;
            const char* a3 = a2 + kstep; const char* b3 = b2 + kstep;
            if (last && has_next) S.a_ready(nxt);
            if constexpr (SP2) {
            PG8_LDB(B0, 0, 0); PG8_LDB(B1, 0, 1); PG8_SCHED; PG8_LDA(At, 0, 0); PG8_STAGE(PG8_SA(1, 1), a1 + hstepA, voffA);
            PG8_WAIT_V(8); PG8_WAIT_L(0); PG8_BAR; PG8_MMA(0, 0, At, B0); PG8_MMA(0, 1, At, B1); PG8_BAR; PG8_SCHED;
            PG8_LDA(At, 0, 1); PG8_STAGE(PG8_SB(0, 0), b2, voffB); PG8_STAGE(PG8_SB(0, 1), b2 + hstepB, voffB); PG8_STAGE(PG8_SA(0, 0), a2, voffA);
            PG8_WAIT_V(8); PG8_WAIT_L(0); PG8_BAR; PG8_MMA(1, 0, At, B0); PG8_MMA(1, 1, At, B1); PG8_BAR; PG8_SCHED;
            PG8_LDB(B0, 1, 0); PG8_LDB(B1, 1, 1); PG8_SCHED; PG8_LDA(At, 1, 0); PG8_STAGE(PG8_SA(0, 1), a2 + hstepA, voffA);
            PG8_WAIT_V(8); PG8_WAIT_L(0); PG8_BAR; PG8_MMA(0, 0, At, B0); PG8_MMA(0, 1, At, B1); PG8_BAR; PG8_SCHED;
            PG8_LDA(At, 1, 1); PG8_STAGE(PG8_SB(1, 0), b3, voffB); PG8_STAGE(PG8_SB(1, 1), b3 + hstepB, voffB); PG8_STAGE(PG8_SA(1, 0), a3, voffA);
            PG8_WAIT_V(8); PG8_WAIT_L(0); PG8_BAR; PG8_MMA(1, 0, At, B0); PG8_MMA(1, 1, At, B1); PG8_BAR; PG8_SCHED;
            } else {
            PG8_LDB(B0, 0, 0); PG8_SCHED; PG8_LDA(At, 0, 0); PG8_STAGE(PG8_SA(1, 1), a1 + hstepA, voffA);
            PG8_WAIT_L(8); PG8_BAR; PG8_WAIT_L(0); PG8_MMA(0, 0, At, B0); PG8_BAR; PG8_SCHED;
            PG8_LDB(B1, 0, 1); PG8_STAGE(PG8_SB(0, 0), b2, voffB);
            PG8_BAR; PG8_WAIT_L(0); PG8_MMA(0, 1, At, B1); PG8_BAR;
            PG8_LDA(At, 0, 1); PG8_STAGE(PG8_SA(0, 0), a2, voffA);
            PG8_BAR; PG8_WAIT_L(0); PG8_MMA(1, 0, At, B0); PG8_BAR; PG8_SCHED;
            PG8_STAGE(PG8_SB(0, 1), b2 + hstepB, voffB);
            PG8_WAIT_V(6); PG8_BAR; PG8_MMA(1, 1, At, B1); PG8_BAR;
            PG8_LDB(B0, 1, 0); PG8_SCHED; PG8_LDA(At, 1, 0); PG8_STAGE(PG8_SA(0, 1), a2 + hstepA, voffA);
            PG8_WAIT_L(8); PG8_BAR; PG8_WAIT_L(0); PG8_MMA(0, 0, At, B0); PG8_BAR; PG8_SCHED;
            PG8_LDB(B1, 1, 1); PG8_STAGE(PG8_SB(1, 0), b3, voffB);
            PG8_BAR; PG8_WAIT_L(0); PG8_MMA(0, 1, At, B1); PG8_BAR;
            PG8_LDA(At, 1, 1); PG8_STAGE(PG8_SA(1, 0), a3, voffA);
            PG8_BAR; PG8_WAIT_L(0); PG8_MMA(1, 0, At, B0); PG8_BAR; PG8_SCHED;
            PG8_STAGE(PG8_SB(1, 1), b3 + hstepB, voffB);
            PG8_WAIT_V(6); PG8_BAR; PG8_MMA(1, 1, At, B1); PG8_BAR;
            }
        }
        if constexpr (ALIGN_EPI) { if (wr == 0) PG8_BAR; }
        if constexpr (!Epi::AFTER_DRAIN) { E(acc, cur, wr, wc, fr, fq); S.done(cur); }
        if (!has_next) break;
#pragma unroll
        for (int a = 0; a < 2; ++a)
#pragma unroll
            for (int b = 0; b < 2; ++b)
#pragma unroll
                for (int m = 0; m < 4; ++m)
#pragma unroll
                    for (int n = 0; n < 2; ++n) acc[a][b][m][n] = (f32x4){0.f, 0.f, 0.f, 0.f};
        cur = nxt; cA = nA; cB = nB; ++ui;
        if constexpr (ALIGN_EPI) { if (wr == 1) PG8_BAR; }
    }
    PG8_WAIT_V(0);
    if constexpr (!ALIGN_EPI) { if (wr == 0) PG8_BAR; }
    PG8_BAR;
    if constexpr (Epi::AFTER_DRAIN) { E.fused(acc, cur, wr, wc, fr, fq, lds, wid, lane); S.done(cur); }
#undef PG8_SA
#undef PG8_SB
#undef PG8_STAGE
#undef PG8_LDA
#undef PG8_LDB
#undef PG8_MMA
#undef PG8_WAIT_V
#undef PG8_WAIT_L
#undef PG8_BAR
#undef PG8_SCHED
}
}

using pg8::bf16_t; using pg8::bf16x8; using pg8::f32x4; using pg8::u32x4; using pg8::u32x2; using pg8::cvt_pk_bf16;
using pg8::NB; using pg8::SEQ; using pg8::DMODEL; using pg8::MTOK; using pg8::NMEMTOK; using pg8::LDP; using pg8::EPSN;
#define LAS __attribute__((address_space(3)))
typedef short s16x4 __attribute__((ext_vector_type(4)));
typedef float f32x2 __attribute__((ext_vector_type(2)));

constexpr int NTHREADS = 512, NWAVES = 8;
constexpr int LDS_BYTES = 147456;
constexpr int LDS_MISC = 139264;

constexpr size_t al256(size_t x) { return (x + 255) & ~(size_t)255; }
constexpr size_t WS_CTL   = 0;
constexpr size_t WS_WIN0  = 1u << 20;
constexpr size_t WS_WIN1  = WS_WIN0 + (size_t)4608 * 2048 * 2;
constexpr size_t WS_WIN2  = WS_WIN1 + (size_t)7168 * 2048 * 2;
constexpr size_t WS_WIN3  = WS_WIN2 + (size_t)5632 * 2048 * 2;
constexpr size_t WS_WOUT  = WS_WIN3 + (size_t)4608 * 2048 * 2;
constexpr size_t WS_WMEM  = WS_WOUT + (size_t)4 * 2048 * 2048 * 2;
constexpr size_t WS_HB    = WS_WMEM + (size_t)1024 * 2048 * 2;
constexpr size_t WS_PROJ  = WS_HB + (size_t)MTOK * 2048 * 2;
constexpr size_t WS_MEMB  = WS_PROJ + (size_t)MTOK * LDP * 2;
constexpr size_t WS_MKV   = WS_MEMB + (size_t)1024 * 2048 * 2;
constexpr size_t WS_RSS   = WS_MKV + (size_t)1024 * 1024 * 2;
constexpr size_t WS_RSSM  = WS_RSS + (size_t)5 * MTOK * 4;
constexpr size_t WS_ROPEA = WS_RSSM + 4096;
constexpr size_t WS_ROPEB = WS_ROPEA + (size_t)MTOK * 16 * 4;
constexpr size_t WS_ROPEC = WS_ROPEB + (size_t)MTOK * 32 * 4;
constexpr size_t WS_KMEAN = WS_ROPEC + (size_t)MTOK * 128 * 4;
constexpr size_t WS_RPREV = WS_KMEAN + (size_t)4 * 12 * 16 * 128 * 4;
constexpr size_t WS_END   = WS_RPREV + (size_t)4 * 32 * 6 * 256 * 128 * 2;

__constant__ double INVF[88] = {
 1.0, 0.19392274474868576, 0.03760603093086393, 0.007292664737217109, 0.001414213562373095, 0.0002742481756762073, 5.318295896944988e-05, 1.031338537721246e-05,
 1.0, 0.44036660267178046, 0.19392274474868576, 0.08539710028576561, 0.03760603093086393, 0.016560440080994446, 0.007292664737217109, 0.003211445994752591, 0.001414213562373095, 0.000622772421914596, 0.0002742481756762073, 0.00012076973741146504, 5.318295896944988e-05, 2.341999896140934e-05, 1.031338537721246e-05, 4.5416704806078695e-06,
 1.0, 0.8659643233600653, 0.7498942093324559, 0.6493816315762113, 0.5623413251903491, 0.4869675251658631, 0.4216965034285822, 0.3651741272548377, 0.31622776601683794, 0.27384196342643613, 0.23713737056616552, 0.2053525026457146, 0.1778279410038923, 0.1539926526059492, 0.1333521432163324, 0.11547819846894582, 0.1, 0.08659643233600653, 0.07498942093324558, 0.06493816315762113, 0.05623413251903491, 0.04869675251658631, 0.042169650342858224, 0.03651741272548377, 0.03162277660168379, 0.027384196342643614, 0.023713737056616554, 0.02053525026457146, 0.01778279410038923, 0.01539926526059492, 0.01333521432163324, 0.011547819846894581, 0.01, 0.008659643233600654, 0.007498942093324558, 0.006493816315762113, 0.005623413251903491, 0.004869675251658631, 0.004216965034285823, 0.003651741272548377, 0.0031622776601683794, 0.0027384196342643613, 0.0023713737056616554, 0.002053525026457146, 0.0017782794100389228, 0.001539926526059492, 0.001333521432163324, 0.0011547819846894581, 0.001, 0.0008659643233600654, 0.0007498942093324559, 0.0006493816315762113, 0.0005623413251903491, 0.0004869675251658631, 0.00042169650342858224, 0.0003651741272548377, 0.00031622776601683794, 0.0002738419634264361, 0.00023713737056616554, 0.0002053525026457146, 0.00017782794100389227, 0.0001539926526059492, 0.0001333521432163324, 0.00011547819846894582 };
__device__ __forceinline__ float log2gamma(int h) {
    return h == 0 ? -0.04580368961312479f : h == 1 ? -0.02612928206836121f : h == 2 ? -0.014949433599796901f : h == 3 ? -0.008567249848519122f : h == 4 ? -0.004914372264518986f : -0.002820519062378663f;
}

#define LDS_WAIT() asm volatile("s_waitcnt lgkmcnt(0)" ::: "memory")
__device__ __forceinline__ unsigned f2bf(float f) { unsigned u = __builtin_bit_cast(unsigned, f); return (u + 0x7fffu + ((u >> 16) & 1u)) >> 16; }
__device__ __forceinline__ unsigned pk2(float lo, float hi) { return f2bf(lo) | (f2bf(hi) << 16); }
__device__ __forceinline__ float bflo(unsigned w) { return __builtin_bit_cast(float, w << 16); }
__device__ __forceinline__ float bfhi(unsigned w) { return __builtin_bit_cast(float, w & 0xffff0000u); }
__device__ __forceinline__ float wave_sum(float v) {
#pragma unroll
    for (int o = 1; o < 64; o <<= 1) v += __shfl_xor(v, o);
    return v;
}
__device__ __forceinline__ float fexp2(float x) { return __builtin_amdgcn_exp2f(x); }
__device__ __forceinline__ s16x4 vtr(const LAS unsigned char* p) { return __builtin_bit_cast(s16x4, __builtin_amdgcn_ds_read_tr16_b64_v4i16((LAS s16x4*)p)); }
__device__ __forceinline__ bf16x8 cat8(s16x4 a, s16x4 b) { bf16x8 r; r[0] = a[0]; r[1] = a[1]; r[2] = a[2]; r[3] = a[3]; r[4] = b[0]; r[5] = b[1]; r[6] = b[2]; r[7] = b[3]; return r; }
typedef float f32x2_t __attribute__((ext_vector_type(2)));
typedef __bf16 bf16x2_t __attribute__((ext_vector_type(2)));
__device__ __forceinline__ unsigned cvtpk(float lo, float hi) { f32x2_t v = {lo, hi}; bf16x2_t b = __builtin_convertvector(v, bf16x2_t); return __builtin_bit_cast(unsigned, b); }
__device__ __forceinline__ float xmax16(float x) { const auto r = __builtin_amdgcn_permlane16_swap(__builtin_bit_cast(unsigned, x), __builtin_bit_cast(unsigned, x), false, false); return fmaxf(__builtin_bit_cast(float, r[0]), __builtin_bit_cast(float, r[1])); }
__device__ __forceinline__ float xmax32(float x) { const auto r = __builtin_amdgcn_permlane32_swap(__builtin_bit_cast(unsigned, x), __builtin_bit_cast(unsigned, x), false, false); return fmaxf(__builtin_bit_cast(float, r[0]), __builtin_bit_cast(float, r[1])); }
__device__ __forceinline__ bf16x8 pack8s(f32x4 a, f32x4 b) { u32x4 w; w.x = cvtpk(a[0], a[1]); w.y = cvtpk(a[2], a[3]); w.z = cvtpk(b[0], b[1]); w.w = cvtpk(b[2], b[3]); return __builtin_bit_cast(bf16x8, w); }
__device__ __forceinline__ bf16x8 pack8(f32x4 a, f32x4 b) { u32x4 w; w.x = cvt_pk_bf16(a[0], a[1]); w.y = cvt_pk_bf16(a[2], a[3]); w.z = cvt_pk_bf16(b[0], b[1]); w.w = cvt_pk_bf16(b[2], b[3]); return __builtin_bit_cast(bf16x8, w); }
__device__ __forceinline__ float silu_mul(float o, float z) { return o * z * __builtin_amdgcn_rcpf(1.0f + fexp2(-1.4426950408889634f * z)); }

__device__ __forceinline__ void transpose_item(const float* W, int N, int mid, const float* gvec, bf16_t* WT, int nblk, int item, int lane, LAS float* scr) {
    const int kb = item / nblk, nb = item % nblk, k0 = 64 * kb, n0 = 64 * nb;
    const int c4 = lane & 15, r4 = lane >> 4, j = n0 + 4 * c4;
    const int sc = (mid < 0) ? j : pg8::src_col(mid, j);
    f32x4 v[16];
#pragma unroll
    for (int i = 0; i < 16; ++i) { v[i] = (f32x4){0.f, 0.f, 0.f, 0.f}; if (sc >= 0) v[i] = *(const GAS f32x4*)(W + (size_t)(k0 + 4 * i + r4) * N + sc); }
#pragma unroll
    for (int i = 0; i < 16; ++i) { const int kk = 4 * i + r4; const float gk = gvec ? gvec[k0 + kk] : 1.0f; LAS float* d = scr + kk * 65 + 4 * c4;
        d[0] = v[i][0] * gk; d[1] = v[i][1] * gk; d[2] = v[i][2] * gk; d[3] = v[i][3] * gk; }
    LDS_WAIT(); asm volatile("" ::: "memory");
    const int c = lane & 7;
#pragma unroll
    for (int jj = 0; jj < 8; ++jj) { const int n = (lane >> 3) + 8 * jj; const LAS float* sp = scr + (8 * c) * 65 + n;
        u32x4 o; o.x = pk2(sp[0 * 65], sp[1 * 65]); o.y = pk2(sp[2 * 65], sp[3 * 65]); o.z = pk2(sp[4 * 65], sp[5 * 65]); o.w = pk2(sp[6 * 65], sp[7 * 65]);
        *(GAS u32x4*)(WT + (size_t)(n0 + n) * 2048 + k0 + 8 * c) = o; }
    LDS_WAIT(); asm volatile("" ::: "memory");
}
__device__ __forceinline__ void row_to_bf16(const float* xrow, bf16_t* orow, float* rss, int lane) {
    const f32x4* xr = (const f32x4*)xrow + lane; float s = 0.f;
    u32x2* o8 = (u32x2*)orow + lane;
#pragma unroll
    for (int j = 0; j < 8; ++j) { const f32x4 v = xr[64 * j]; s += (v.x * v.x + v.y * v.y) + (v.z * v.z + v.w * v.w);
        u32x2 w; w.x = pk2(v.x, v.y); w.y = pk2(v.z, v.w); o8[64 * j] = w; }
    s = wave_sum(s);
    if (lane == 0) *rss = s;
}

enum { MODE_SWA = 0, MODE_MOBA = 1, MODE_MEM = 2 };
template <int DH, int MODE>
__device__ __forceinline__ void attn_unit(LAS unsigned char* lds, int tid, int wid, int lane,
        const bf16_t* Q,
        int qrow0,
        const bf16_t* Kb, const bf16_t* Vb, int ldkv,
        int nt, int krow_a, int krow_b,
        float m_init, float l_init, unsigned sel0, unsigned sel1,
        bf16_t* Zy,
        bool dry = false)
{
    asm volatile("" : "+v"(tid), "+v"(lane)); asm volatile("" : "+s"(wid));
    constexpr int KSTR = DH * 2 + 16, VSTR = DH * 2 + 32, KBYTES = 64 * KSTR, VBYTES = 64 * VSTR, STG = KBYTES + VBYTES;
    constexpr int CPR = DH / 8  , CPT = (64 * CPR) / NTHREADS  ;
    constexpr int NK = DH / 32, NDB = DH / 16;
    const int g = lane >> 4, l15 = lane & 15, q4 = l15 >> 2, p4 = l15 & 3;
    bf16x8 Qf[2][NK];
#pragma unroll
    for (int j = 0; j < 2; ++j)
#pragma unroll
        for (int k = 0; k < NK; ++k) Qf[j][k] = *(const GAS bf16x8*)(Q + (size_t)(qrow0 + j * 16 + l15) * LDP + k * 32 + g * 8);
    f32x4 O[NDB][2];
#pragma unroll
    for (int db = 0; db < NDB; ++db) { O[db][0] = (f32x4){0.f, 0.f, 0.f, 0.f}; O[db][1] = (f32x4){0.f, 0.f, 0.f, 0.f}; }
    const float m0 = (MODE == MODE_SWA) ? m_init : 0.f;
    float mrow[2] = {m0, m0}, lrow[2] = {g == 0 ? l_init : 0.f, g == 0 ? l_init : 0.f};
    bool first = (MODE != MODE_SWA);
    const unsigned sel[2] = {sel0, sel1};

    u32x4 kreg[2][CPT], vreg[2][CPT];
#define ATT_KROW(it) ((MODE == MODE_MOBA && (it) >= 4) ? (krow_b + 64 * ((it) - 4)) : (krow_a + 64 * (it)))
#define ATT_ISSUE(hf_, it) do { const int kr_ = ATT_KROW(it); _Pragma("unroll") for (int i_ = 0; i_ < CPT; ++i_) { const int c_ = tid + NTHREADS * i_, r_ = c_ / CPR, cc_ = c_ % CPR; \
        kreg[hf_][i_] = *(const GAS u32x4*)(Kb + (size_t)(kr_ + r_) * ldkv + cc_ * 8); vreg[hf_][i_] = *(const GAS u32x4*)(Vb + (size_t)(kr_ + r_) * ldkv + cc_ * 8); } } while (0)
    constexpr bool PF2 = false;
    ATT_ISSUE(0, 0);
    if (PF2 && nt > 1) ATT_ISSUE(1, 1);
    for (int it0 = 0; it0 < nt; it0 += 2) {
#pragma unroll
      for (int hf = 0; hf < 2; ++hf) {
        const int it = it0 + hf;
        if (it >= nt) break;
        LAS unsigned char* Kt = lds + hf * STG; LAS unsigned char* Vt = Kt + KBYTES;
#pragma unroll
        for (int i = 0; i < CPT; ++i) { const int c = tid + NTHREADS * i, r = c / CPR, cc = c % CPR;
            *(LAS u32x4*)(Kt + r * KSTR + cc * 16) = kreg[PF2 ? hf : 0][i]; *(LAS u32x4*)(Vt + r * VSTR + cc * 16) = vreg[PF2 ? hf : 0][i]; }
        if (PF2) { if (it + 2 < nt) ATT_ISSUE(hf, it + 2); } else { if (it + 1 < nt) ATT_ISSUE(0, it + 1); }
        __syncthreads();
        const int kp = ATT_KROW(it);
        bool active = true;
        if (MODE == MODE_SWA) active = !(kp > qrow0 + 31 || kp + 63 <= qrow0 - 128);
        if (MODE == MODE_MOBA) active = !(kp > qrow0 + 31);
        if (active) {
            f32x4 S[4][2];
            float sinit[2] = {-mrow[0], -mrow[1]};
            if (MODE == MODE_MOBA && it >= 4) {
                const int pb = (it - 4) >> 2;
                sinit[0] = ((sel[0] >> pb) & 1u) ? sinit[0] : -INFINITY; sinit[1] = ((sel[1] >> pb) & 1u) ? sinit[1] : -INFINITY;
            }
#pragma unroll
            for (int kb = 0; kb < 4; ++kb) { S[kb][0] = (f32x4){sinit[0], sinit[0], sinit[0], sinit[0]}; S[kb][1] = (f32x4){sinit[1], sinit[1], sinit[1], sinit[1]}; }
#pragma unroll
            for (int kb = 0; kb < 4; ++kb) {
#pragma unroll
                for (int k = 0; k < NK; ++k) {
                    const bf16x8 a = *(const LAS bf16x8*)(Kt + (kb * 16 + l15) * KSTR + (k * 32 + g * 8) * 2);
                    S[kb][0] = __builtin_amdgcn_mfma_f32_16x16x32_bf16(a, Qf[0][k], S[kb][0], 0, 0, 0);
                    S[kb][1] = __builtin_amdgcn_mfma_f32_16x16x32_bf16(a, Qf[1][k], S[kb][1], 0, 0, 0);
                }
                if (kb & 1) __builtin_amdgcn_sched_barrier(0);
            }
            bf16x8 Pb[2][2];
#pragma unroll
            for (int j = 0; j < 2; ++j) {
                const int qi = qrow0 + j * 16 + l15;
                if (MODE == MODE_SWA) {
                    if (!(kp + 63 <= qrow0 && kp > qrow0 + 31 - 128)) {
                        const unsigned dbase = (unsigned)(qi - kp - 4 * g);
#pragma unroll
                        for (int kb = 0; kb < 4; ++kb)
#pragma unroll
                            for (int i = 0; i < 4; ++i) S[kb][j][i] = ((dbase - (unsigned)(kb * 16 + i)) < 128u) ? S[kb][j][i] : -INFINITY;
                    }
                } else if (MODE == MODE_MOBA) {
                    if (kp + 63 > qrow0) {
#pragma unroll
                        for (int kb = 0; kb < 4; ++kb)
#pragma unroll
                            for (int i = 0; i < 4; ++i) S[kb][j][i] = ((qi - kp - 4 * g) >= (kb * 16 + i)) ? S[kb][j][i] : -INFINITY;
                    }
                }
                float mx = -INFINITY;
#pragma unroll
                for (int kb = 0; kb < 4; ++kb) mx = fmaxf(mx, fmaxf(fmaxf(S[kb][j][0], S[kb][j][1]), fmaxf(S[kb][j][2], S[kb][j][3])));
                mx = xmax16(mx); mx = xmax32(mx);
                const bool need = (first && mx > -INFINITY) || (mx > 8.0f);
                if (__builtin_amdgcn_ballot_w64(need) != 0ull) {
                    const float dlt = need ? mx : 0.f, alpha = fexp2(-dlt);
#pragma unroll
                    for (int kb = 0; kb < 4; ++kb) S[kb][j] = S[kb][j] - dlt;
                    mrow[j] += dlt; lrow[j] *= alpha;
#pragma unroll
                    for (int db = 0; db < NDB; ++db) O[db][j] = O[db][j] * alpha;
                }
                float ps = 0.f;
#pragma unroll
                for (int kb = 0; kb < 4; ++kb)
#pragma unroll
                    for (int i = 0; i < 4; ++i) { const float p = fexp2(S[kb][j][i]); S[kb][j][i] = p; ps += p; }
                lrow[j] += ps;
                Pb[j][0] = pack8s(S[0][j], S[1][j]); Pb[j][1] = pack8s(S[2][j], S[3][j]);
            }
#pragma unroll
            for (int s = 0; s < 2; ++s)
#pragma unroll
                for (int db = 0; db < NDB; ++db) {
                    const s16x4 lo = vtr(Vt + (32 * s + 4 * g + q4) * VSTR + (16 * db + 4 * p4) * 2);
                    const s16x4 hi = vtr(Vt + (32 * s + 16 + 4 * g + q4) * VSTR + (16 * db + 4 * p4) * 2);
                    const bf16x8 a = cat8(lo, hi);
                    O[db][0] = __builtin_amdgcn_mfma_f32_16x16x32_bf16(a, Pb[0][s], O[db][0], 0, 0, 0);
                    O[db][1] = __builtin_amdgcn_mfma_f32_16x16x32_bf16(a, Pb[1][s], O[db][1], 0, 0, 0);
                    if ((db & 3) == 3) __builtin_amdgcn_sched_barrier(0);
                }
            first = false;
        }
      }
    }
#undef ATT_ISSUE
#undef ATT_KROW
#pragma unroll
    for (int j = 0; j < 2; ++j) {
        float l = lrow[j]; l += __shfl_xor(l, 16); l += __shfl_xor(l, 32);
        const float inv = 1.0f / l;
        bf16_t* zp = Zy + (size_t)(qrow0 + j * 16 + l15) * LDP + 4 * g;
#pragma unroll
        for (int db = 0; db < NDB; ++db) {
            const u32x2 z = *(const GAS u32x2*)(zp + 16 * db);
            const f32x4 o = O[db][j] * inv;
            u32x2 w; w.x = cvt_pk_bf16(silu_mul(o[0], bflo(z.x)), silu_mul(o[1], bfhi(z.x))); w.y = cvt_pk_bf16(silu_mul(o[2], bflo(z.y)), silu_mul(o[3], bfhi(z.y)));
            if (!dry) *(GAS u32x2*)(zp + 16 * db) = w;
        }
    }
    __syncthreads();
}

__device__ __forceinline__ void moba_gate(LAS unsigned char* lds, int tid, const bf16_t* proj, const float* kmean, int b, int h, int qb) {
    asm volatile("" : "+v"(tid));
    LAS float* km = (LAS float*)lds;
    LAS unsigned* selm = (LAS unsigned*)(lds + LDS_MISC - 2048);
    for (int i = tid; i < 16 * 128; i += NTHREADS) km[i] = kmean[(size_t)((b * 12 + h) * 16) * 128 + i];
    __syncthreads();
    const int q = tid >> 1, half = tid & 1;
    const bf16_t* qp = proj + (size_t)(b * SEQ + qb * 256 + q) * LDP + h * 128 + half * 64;
    float gsc[15];
#pragma unroll
    for (int n = 0; n < 15; ++n) gsc[n] = 0.f;
#pragma unroll 1
    for (int c = 0; c < 8; ++c) {
        const u32x4 w = *(const GAS u32x4*)(qp + c * 8);
        float qv[8] = {bflo(w.x), bfhi(w.x), bflo(w.y), bfhi(w.y), bflo(w.z), bfhi(w.z), bflo(w.w), bfhi(w.w)};
#pragma unroll
        for (int n = 0; n < 15; ++n) if (n < qb) {
            const LAS float* kr = km + n * 128 + half * 64 + c * 8;
#pragma unroll
            for (int e = 0; e < 8; ++e) gsc[n] += qv[e] * kr[e];
        }
    }
    unsigned mask = 0u;
#pragma unroll
    for (int n = 0; n < 15; ++n) { gsc[n] += __shfl_xor(gsc[n], 1); if (n >= qb) gsc[n] = -INFINITY; }
#pragma unroll
    for (int r = 0; r < 3; ++r) {
        float best = -INFINITY; int bi = -1;
#pragma unroll
        for (int n = 0; n < 15; ++n) { const bool taken = (mask >> n) & 1u; if (!taken && gsc[n] > best) { best = gsc[n]; bi = n; } }
        if (bi >= 0) mask |= 1u << bi;
    }
    if (half == 0) selm[q] = mask;
    __syncthreads();
}

__device__ __forceinline__ void kmean_unit(LAS unsigned char* lds, int tid, const bf16_t* proj, float* kmean, int u) {
    asm volatile("" : "+v"(tid));
    const int blk = u & 15, bh = u >> 4, b = bh / 12, h = bh % 12;
    const int cc = tid & 15, kg = tid >> 4;
    float s[8] = {0.f, 0.f, 0.f, 0.f, 0.f, 0.f, 0.f, 0.f};
    const bf16_t* kp = proj + (size_t)(b * SEQ + blk * 256 + kg * 8) * LDP + 1536 + h * 128 + cc * 8;
#pragma unroll
    for (int r = 0; r < 8; ++r) { const u32x4 w = *(const GAS u32x4*)(kp + (size_t)r * LDP);
        s[0] += bflo(w.x); s[1] += bfhi(w.x); s[2] += bflo(w.y); s[3] += bfhi(w.y); s[4] += bflo(w.z); s[5] += bfhi(w.z); s[6] += bflo(w.w); s[7] += bfhi(w.w); }
    LAS float* red = (LAS float*)lds;
#pragma unroll
    for (int e = 0; e < 8; ++e) red[kg * 128 + cc * 8 + e] = s[e];
    __syncthreads();
    if (tid < 128) { float a = 0.f;
#pragma unroll 8
        for (int k = 0; k < 32; ++k) a += red[k * 128 + tid];
        kmean[(size_t)u * 128 + tid] = a * (1.0f / 256.0f); }
    __syncthreads();
}

__device__ __forceinline__ void ret_scan_item(LAS unsigned char* lds, int tid, int wid, int lane, const bf16_t* proj, bf16_t* rprev, int item) {
    asm volatile("" : "+v"(tid), "+v"(lane)); asm volatile("" : "+s"(wid));
    constexpr int KS = 288, VS = 96, KB = 128 * KS, STG = KB + 128 * VS;
    const int es = item & 7, bh = item >> 3, b = bh / 6, h = bh % 6;
    const float lg = log2gamma(h), gchunk = fexp2(128.f * lg);
    const int g = lane >> 4, l15 = lane & 15, q4 = l15 >> 2, p4 = l15 & 3;
    const bf16_t* kbase = proj + (size_t)(b * SEQ) * LDP + 768 + h * 128;
    const bf16_t* vbase = proj + (size_t)(b * SEQ) * LDP + 1536 + h * 256 + es * 32;
    f32x4 R[2] = {(f32x4){0.f, 0.f, 0.f, 0.f}, (f32x4){0.f, 0.f, 0.f, 0.f}};
    u32x4 kreg[4], vreg;
#define RS_ISSUE(n) do { _Pragma("unroll") for (int i_ = 0; i_ < 4; ++i_) { const int c_ = tid + NTHREADS * i_; kreg[i_] = *(const GAS u32x4*)(kbase + (size_t)((n) * 128 + (c_ >> 4)) * LDP + (c_ & 15) * 8); } \
        vreg = *(const GAS u32x4*)(vbase + (size_t)((n) * 128 + (tid >> 2)) * LDP + (tid & 3) * 8); } while (0)
    RS_ISSUE(0);
    for (int n = 0; n < 32; ++n) {
        bf16_t* rp = rprev + ((size_t)((b * 32 + n) * 6 + h) * 256 + es * 32 + l15) * 128 + wid * 16 + 4 * g;
#pragma unroll
        for (int eb = 0; eb < 2; ++eb) { u32x2 w; w.x = cvt_pk_bf16(R[eb][0], R[eb][1]); w.y = cvt_pk_bf16(R[eb][2], R[eb][3]); *(GAS u32x2*)(rp + (size_t)eb * 16 * 128) = w; }
        if (n == 31) break;
        LAS unsigned char* Kt = lds + (n & 1) * STG; LAS unsigned char* Vt = Kt + KB;
#pragma unroll
        for (int i = 0; i < 4; ++i) { const int c = tid + NTHREADS * i, t = c >> 4, cc = c & 15;
            const float zt = fexp2((float)(127 - t) * lg);
            const u32x4 w = kreg[i]; u32x4 o;
            o.x = cvt_pk_bf16(bflo(w.x) * zt, bfhi(w.x) * zt); o.y = cvt_pk_bf16(bflo(w.y) * zt, bfhi(w.y) * zt); o.z = cvt_pk_bf16(bflo(w.z) * zt, bfhi(w.z) * zt); o.w = cvt_pk_bf16(bflo(w.w) * zt, bfhi(w.w) * zt);
            *(LAS u32x4*)(Kt + t * KS + cc * 16) = o; }
        *(LAS u32x4*)(Vt + (tid >> 2) * VS + (tid & 3) * 16) = vreg;
        __syncthreads();
        if (n + 1 < 31) RS_ISSUE(n + 1);
        R[0] = R[0] * gchunk; R[1] = R[1] * gchunk;
#pragma unroll
        for (int s = 0; s < 4; ++s) {
            const bf16x8 a = cat8(vtr(Kt + (32 * s + 8 * g + q4) * KS + (16 * wid + 4 * p4) * 2), vtr(Kt + (32 * s + 8 * g + 4 + q4) * KS + (16 * wid + 4 * p4) * 2));
#pragma unroll
            for (int eb = 0; eb < 2; ++eb) {
                const bf16x8 bb = cat8(vtr(Vt + (32 * s + 8 * g + q4) * VS + (16 * eb + 4 * p4) * 2), vtr(Vt + (32 * s + 8 * g + 4 + q4) * VS + (16 * eb + 4 * p4) * 2));
                R[eb] = __builtin_amdgcn_mfma_f32_16x16x32_bf16(a, bb, R[eb], 0, 0, 0);
            }
        }
    }
#undef RS_ISSUE
    __syncthreads();
}

__device__ __forceinline__ void ret_out_unit(LAS unsigned char* lds, int tid, int wid, int lane, bf16_t* proj, const bf16_t* rprev, int u, bool dry = false) {
    asm volatile("" : "+v"(tid), "+v"(lane)); asm volatile("" : "+s"(wid));
    constexpr int KS = 272, VS = 544, KB = 128 * KS;
    const int h = u % 6, bn = u / 6, n = bn & 31, b = bn >> 5;
    const float lg = log2gamma(h);
    const int g = lane >> 4, l15 = lane & 15, q4 = l15 >> 2, p4 = l15 & 3;
    const int row0 = b * SEQ + n * 128;
    LAS unsigned char* Kt = lds; LAS unsigned char* Vt = lds + KB;
    const bf16_t* kbase = proj + (size_t)row0 * LDP + 768 + h * 128;
    const bf16_t* vbase = proj + (size_t)row0 * LDP + 1536 + h * 256;
#pragma unroll
    for (int i = 0; i < 4; ++i) { const int c = tid + NTHREADS * i, t = c >> 4, cc = c & 15; *(LAS u32x4*)(Kt + t * KS + cc * 16) = *(const GAS u32x4*)(kbase + (size_t)t * LDP + cc * 8); }
#pragma unroll
    for (int i = 0; i < 8; ++i) { const int c = tid + NTHREADS * i, t = c >> 5, cc = c & 31; *(LAS u32x4*)(Vt + t * VS + cc * 16) = *(const GAS u32x4*)(vbase + (size_t)t * LDP + cc * 8); }
    const int qrow = row0 + wid * 16 + l15;
    bf16x8 Qf[4];
#pragma unroll
    for (int k = 0; k < 4; ++k) Qf[k] = *(const GAS bf16x8*)(proj + (size_t)qrow * LDP + h * 128 + k * 32 + g * 8);
    u32x4 rreg[8];
    const bf16_t* rbase = rprev + (size_t)((b * 32 + n) * 6 + h) * 256 * 128;
#pragma unroll
    for (int i = 0; i < 8; ++i) { const int c = tid + NTHREADS * i; rreg[i] = *(const GAS u32x4*)(rbase + (size_t)c * 8); }
    __syncthreads();
    f32x4 S[8];
#pragma unroll
    for (int kb = 0; kb < 8; ++kb) S[kb] = (f32x4){0.f, 0.f, 0.f, 0.f};
#pragma unroll
    for (int kb = 0; kb < 8; ++kb) if (kb <= wid) {
#pragma unroll
        for (int k = 0; k < 4; ++k) {
            const bf16x8 a = *(const LAS bf16x8*)(Kt + (kb * 16 + l15) * KS + (k * 32 + g * 8) * 2);
            S[kb] = __builtin_amdgcn_mfma_f32_16x16x32_bf16(a, Qf[k], S[kb], 0, 0, 0);
        }
    }
    const int tq = wid * 16 + l15;
    bf16x8 Pb[4];
#pragma unroll
    for (int kb = 0; kb < 8; ++kb)
#pragma unroll
        for (int i = 0; i < 4; ++i) { const int tk = kb * 16 + 4 * g + i; S[kb][i] = (tk <= tq) ? S[kb][i] * fexp2(-(float)(tk + 1) * lg) : 0.f; }
#pragma unroll
    for (int s = 0; s < 4; ++s) Pb[s] = pack8(S[2 * s], S[2 * s + 1]);
    f32x4 O[16];
#pragma unroll
    for (int eb = 0; eb < 16; ++eb) O[eb] = (f32x4){0.f, 0.f, 0.f, 0.f};
#pragma unroll
    for (int s = 0; s < 4; ++s) if (2 * s <= wid) {
#pragma unroll
        for (int eb = 0; eb < 16; ++eb) {
            const bf16x8 a = cat8(vtr(Vt + (32 * s + 4 * g + q4) * VS + (16 * eb + 4 * p4) * 2), vtr(Vt + (32 * s + 16 + 4 * g + q4) * VS + (16 * eb + 4 * p4) * 2));
            O[eb] = __builtin_amdgcn_mfma_f32_16x16x32_bf16(a, Pb[s], O[eb], 0, 0, 0);
        }
    }
    __syncthreads();
#pragma unroll
    for (int i = 0; i < 8; ++i) { const int c = tid + NTHREADS * i; *(LAS u32x4*)(Vt + (c >> 4) * KS + (c & 15) * 16) = rreg[i]; }
    __syncthreads();
#pragma unroll
    for (int eb = 0; eb < 16; ++eb)
#pragma unroll
        for (int k = 0; k < 4; ++k) {
            const bf16x8 a = *(const LAS bf16x8*)(Vt + (eb * 16 + l15) * KS + (k * 32 + g * 8) * 2);
            O[eb] = __builtin_amdgcn_mfma_f32_16x16x32_bf16(a, Qf[k], O[eb], 0, 0, 0);
        }
    const float xi = fexp2((float)(tq + 1) * lg);
    float ss = 0.f;
#pragma unroll
    for (int eb = 0; eb < 16; ++eb) { O[eb] = O[eb] * xi; ss += (O[eb][0] * O[eb][0] + O[eb][1] * O[eb][1]) + (O[eb][2] * O[eb][2] + O[eb][3] * O[eb][3]); }
    ss += __shfl_xor(ss, 16); ss += __shfl_xor(ss, 32);
    const float rstd = __builtin_amdgcn_rsqf(ss * (1.0f / 256.0f) + EPSN);
    bf16_t* zp = proj + (size_t)qrow * LDP + 3584 + h * 256 + 4 * g;
#pragma unroll
    for (int eb = 0; eb < 16; ++eb) {
        const u32x2 z = *(const GAS u32x2*)(zp + 16 * eb);
        const f32x4 o = O[eb] * rstd;
        u32x2 w; w.x = cvt_pk_bf16(silu_mul(o[0], bflo(z.x)), silu_mul(o[1], bfhi(z.x))); w.y = cvt_pk_bf16(silu_mul(o[2], bflo(z.y)), silu_mul(o[3], bfhi(z.y)));
        if (!dry) *(GAS u32x2*)(zp + 16 * eb) = w;
    }
    __syncthreads();
}

#define XB_TMO      128
#define XB_XCNT(j)  (256  + 64 * (j))
#define XB_XSUB(j)  (1280 + 64 * (j))
#define XB_XGEN(j)  (2304 + 64 * (j))
#define XB_TOP      3328
#define XB_TOPGEN   3392
#define XCD_BAR_WORDS 3456
#define XB_SPIN_CAP (1u << 18)

__device__ __forceinline__ unsigned xb_ld(unsigned* p)              { return __hip_atomic_load(p, __ATOMIC_RELAXED, __HIP_MEMORY_SCOPE_AGENT); }
__device__ __forceinline__ unsigned xb_add(unsigned* p, unsigned v) { return __hip_atomic_fetch_add(p, v, __ATOMIC_RELAXED, __HIP_MEMORY_SCOPE_AGENT); }
__device__ __forceinline__ unsigned xb_xcc_id() { return (unsigned)__builtin_amdgcn_s_getreg((3 << 11) | 20) & 0xFu; }
#define XB_SPIN(cond, bar) do { unsigned _sp = 0; while (cond) { __builtin_amdgcn_s_sleep(1); \
    if ((++_sp & 255u) == 0u) { if (xb_ld(&(bar)[XB_TMO])) break; if (_sp > XB_SPIN_CAP) { atomicAdd(&(bar)[XB_TMO], 1u); break; } } } } while (0)

struct XcdBarrier {
    unsigned* bar; unsigned x;
    volatile LAS unsigned* st;
};

__device__ __forceinline__ XcdBarrier xcd_barrier_post(unsigned* bar, volatile LAS unsigned* st) {
    XcdBarrier b; b.bar = bar; b.x = xb_xcc_id(); b.st = st;
    if (threadIdx.x == 0) (void)xb_add(&bar[XB_XCNT(b.x)], 1u);
    return b;
}
__device__ __forceinline__ void xcd_barrier_complete(unsigned* bar, unsigned x, unsigned& nloc, unsigned& nx) {
    const unsigned G = gridDim.x * gridDim.y * gridDim.z;
    unsigned sum, cnt, mine, sp = 0u;
    for (;;) {
        sum = 0u; cnt = 0u; mine = 0u;
#pragma unroll
        for (unsigned j = 0; j < 16; ++j) { const unsigned c = xb_ld(&bar[XB_XCNT(j)]); sum += c; cnt += (c > 0u) ? 1u : 0u; mine = (j == x) ? c : mine; }
        if (sum == G) break;
        __builtin_amdgcn_s_sleep(1);
        if ((++sp & 255u) == 0u) { if (xb_ld(&bar[XB_TMO])) break; if (sp > XB_SPIN_CAP) { atomicAdd(&bar[XB_TMO], 1u); break; } }
    }
    nloc = mine > 0u ? mine : 1u; nx = cnt > 0u ? cnt : 1u;
}

__device__ __forceinline__ void xcd_barrier(const XcdBarrier& b) {
    asm volatile("s_waitcnt vmcnt(0)" ::: "memory");
    __syncthreads();
    if (threadIdx.x == 0) {
        unsigned* bar = b.bar;
        __builtin_amdgcn_s_waitcnt(0);
        unsigned nloc = b.st[0], nx = b.st[1];
        if (nloc == 0u) { xcd_barrier_complete(bar, b.x, nloc, nx); b.st[0] = nloc; b.st[1] = nx; }
        const unsigned old = xb_add(&bar[XB_XSUB(b.x)], 1u);
        const unsigned gen = old / nloc;
        if (old + 1u == (gen + 1u) * nloc) {
            __builtin_amdgcn_fence(__ATOMIC_RELEASE, "agent");
            asm volatile("s_waitcnt vmcnt(0)" ::: "memory");
            const unsigned og = xb_add(&bar[XB_TOP], 1u);
            const unsigned tg = og / nx;
            if (og + 1u == (tg + 1u) * nx) xb_add(&bar[XB_TOPGEN], 1u);
            else XB_SPIN(xb_ld(&bar[XB_TOPGEN]) == tg, bar);
            __builtin_amdgcn_fence(__ATOMIC_ACQUIRE, "agent");
            xb_add(&bar[XB_XGEN(b.x)], 1u);
            asm volatile("s_waitcnt vmcnt(0)" ::: "memory");
        } else {
            XB_SPIN(xb_ld(&bar[XB_XGEN(b.x)]) == gen, bar);
            __builtin_amdgcn_fence(__ATOMIC_ACQUIRE, "agent");
            asm volatile("s_waitcnt vmcnt(0)" ::: "memory");
        }
    }
    __syncthreads();
}


#define CONV_WEIGHTS(MASK, worker, nworkers) do { \
        int lane_ = lane, wid_ = wid; asm volatile("" : "+v"(lane_)); asm volatile("" : "+s"(wid_)); LAS float* scr_ = (LAS float*)(lds + wid_ * 16640); \
        int total_ = 0; \
        _Pragma("unroll 1") for (int mi_ = 0; mi_ < 9; ++mi_) if (((MASK) >> mi_) & 1u) total_ += 32 * (mi_ < 4 ? pg8::npad_of(mi_ == 3 ? 0 : mi_) / 64 : (mi_ < 8 ? 32 : 16)); \
        for (int it_ = (worker); it_ < total_; it_ += (nworkers)) { \
            int r_ = it_; \
            _Pragma("unroll 1") for (int mi = 0; mi < 9; ++mi) { \
                if (!(((MASK) >> mi) & 1u)) continue; \
                const float* W; int N, mid_, nblk; const float* gv; bf16_t* WT; \
                if (mi < 4) { const int l_ = mi; mid_ = l_ == 3 ? 0 : l_; N = pg8::nc_of(mid_); nblk = pg8::npad_of(mid_) / 64; \
                    W = args.in[l_ == 0 ? 6 : l_ == 1 ? 10 : l_ == 2 ? 13 : 16]; gv = args.in[l_ == 0 ? 5 : l_ == 1 ? 9 : l_ == 2 ? 12 : 15]; \
                    WT = (bf16_t*)(ws + (l_ == 0 ? WS_WIN0 : l_ == 1 ? WS_WIN1 : l_ == 2 ? WS_WIN2 : WS_WIN3)); } \
                else if (mi < 8) { const int l_ = mi - 4; mid_ = -1; N = 2048; nblk = 32; W = args.in[l_ == 0 ? 8 : l_ == 1 ? 11 : l_ == 2 ? 14 : 18]; gv = nullptr; WT = woutT + (size_t)l_ * 2048 * 2048; } \
                else { mid_ = -1; N = 1024; nblk = 16; W = args.in[4]; gv = args.in[3]; WT = wmemT; } \
                const int cnt_ = 32 * nblk; \
                if (r_ < cnt_) { transpose_item(W, N, mid_, gv, WT, nblk, r_, lane_, scr_); break; } \
                r_ -= cnt_; \
            } \
        } } while (0)

struct Args { const float* in[20]; float* out; unsigned char* ws; };

__device__ __forceinline__ int fetch_unit(unsigned* ctr, volatile LAS unsigned* slot, int tid) {
    if (tid == 0) *slot = atomicAdd(ctr, 1u);
    __syncthreads();
    const unsigned v = *slot;
    __syncthreads();
    return __builtin_amdgcn_readfirstlane((int)v);
}

__global__ void __launch_bounds__(NTHREADS, 2) trunk_fwd(Args args) {
    extern __shared__ __attribute__((aligned(16))) unsigned char lds_raw[];
    cg::grid_group grid = cg::this_grid();
    LAS unsigned char* lds = (LAS unsigned char*)lds_raw;
    volatile LAS unsigned* misc = (volatile LAS unsigned*)(lds + LDS_MISC);
    const int tid = threadIdx.x, lane = tid & 63, wid = __builtin_amdgcn_readfirstlane(tid >> 6);
    const int G = gridDim.x, bx = blockIdx.x;
#define WS_PTRS() unsigned char* ws = args.ws; asm volatile("" : "+s"(ws)); \
    unsigned* ctl = (unsigned*)(ws + WS_CTL); bf16_t* hb = (bf16_t*)(ws + WS_HB); bf16_t* proj = (bf16_t*)(ws + WS_PROJ); \
    bf16_t* memb = (bf16_t*)(ws + WS_MEMB); bf16_t* mkv = (bf16_t*)(ws + WS_MKV); float* rss = (float*)(ws + WS_RSS); float* rssm = (float*)(ws + WS_RSSM); \
    float* ropeA = (float*)(ws + WS_ROPEA); float* ropeB = (float*)(ws + WS_ROPEB); float* ropeC = (float*)(ws + WS_ROPEC); \
    float* kmean = (float*)(ws + WS_KMEAN); bf16_t* rprev = (bf16_t*)(ws + WS_RPREV); bf16_t* woutT = (bf16_t*)(ws + WS_WOUT); bf16_t* wmemT = (bf16_t*)(ws + WS_WMEM); \
    (void)ctl; (void)hb; (void)proj; (void)memb; (void)mkv; (void)rss; (void)rssm; (void)ropeA; (void)ropeB; (void)ropeC; (void)kmean; (void)rprev; (void)woutT; (void)wmemT
#ifndef REP_P0
#define REP_P0 1
#endif
    for (int rep0 = 0; rep0 < REP_P0; ++rep0) {
        if (rep0) grid.sync();
        WS_PTRS(); const float* x = args.in[0];
        const int gw = bx * NWAVES + wid, NGW = G * NWAVES;
        LAS float* scr = (LAS float*)(lds + wid * 16640);
        if (G == 256) CONV_WEIGHTS(0x111u, gw, NGW); else CONV_WEIGHTS(0x1FFu, gw, NGW);
        for (int m = gw; m < MTOK; m += NGW) row_to_bf16(x + (size_t)m * DMODEL, hb + (size_t)m * DMODEL, rss + m, lane);
        for (int m = gw; m < NB * NMEMTOK; m += NGW) row_to_bf16(args.in[1] + (size_t)m * DMODEL, memb + (size_t)m * DMODEL, rssm + m, lane);
        const int* positions = (const int*)args.in[2];
        const int gt = bx * NTHREADS + tid, NGT = G * NTHREADS;
        for (int i = gt; i < MTOK * 88; i += NGT) {
            const int tok = i / 88, f = i % 88;
            float* tb; int F, fl;
            if (f < 8) { tb = ropeA; F = 8; fl = f; } else if (f < 24) { tb = ropeB; F = 16; fl = f - 8; } else { tb = ropeC; F = 64; fl = f - 24; }
            const double rev = (double)positions[tok] * INVF[f] * 0.15915494309189535;
            const float fr = (float)(rev - __builtin_rint(rev));
            tb[(size_t)tok * 2 * F + fl] = __builtin_amdgcn_cosf(fr); tb[(size_t)tok * 2 * F + F + fl] = __builtin_amdgcn_sinf(fr);
        }
        for (int i = gt; i < 4 * MTOK; i += NGT) rss[MTOK + i] = 0.f;
        if (bx == 0) for (int i = tid; i < 1024 + XCD_BAR_WORDS; i += NTHREADS) ctl[i] = 0u;
    }
    grid.sync();
    if (tid < 2) misc[8 + tid] = 0u;
    __syncthreads();
    XcdBarrier xbar;
    { unsigned char* ws0 = args.ws; xbar = xcd_barrier_post((unsigned*)(ws0 + WS_CTL) + 1024, misc + 8); }
#define GRID_SYNC() xcd_barrier(xbar)

    const float L2E = 1.4426950408889634f;
#pragma unroll 1
    for (int l = 0; l < 4; ++l) {
        const int mid = (l == 3) ? 0 : l;
        const int nmix = pg8::nmix_of(mid), zoff = nmix + 512;
#pragma unroll 1
#ifndef REP_P1
#define REP_P1 1
#endif
        for (int rep1 = 0; rep1 < REP_P1; ++rep1)
        for (int pass = 0; pass < (l == 0 ? 2 : 1); ++pass) {
            WS_PTRS();
            pg8::Gemm g; pg8::StaticOrder S; pg8::EpiIn E;
            if (pass == 0) {
                g.A = hb; g.Bt = (const bf16_t*)(ws + (l == 0 ? WS_WIN0 : l == 1 ? WS_WIN1 : l == 2 ? WS_WIN2 : WS_WIN3)); g.lda = DMODEL; g.K = DMODEL;
                S.init(MTOK, pg8::npad_of(mid), G, bx);
                E.O = proj; E.ldc = LDP; E.mid = mid; E.rss = rss + (size_t)l * MTOK;
            } else {
                g.A = memb; g.Bt = wmemT; g.lda = DMODEL; g.K = DMODEL;
                S.init(NB * NMEMTOK, 1024, 1 << 20, bx - (G == 256 ? 240 : 0));
                E.O = mkv; E.ldc = 1024; E.mid = 3; E.rss = rssm;
            }
            E.rope0 = ropeA;

#ifndef SK_P1
pg8::gemm_phase<pg8::EpiIn, pg8::StaticOrder, true, true>(lds, g, S, E);
#endif

            __syncthreads();
        }
        if (l == 0 && G == 256 && bx >= 128 && bx < 240) {
            WS_PTRS();
            CONV_WEIGHTS(0x066u, (bx - 128) * NWAVES + wid, 112 * NWAVES);
        } else if (l == 2 && G == 256 && bx >= 128) {
            WS_PTRS();
            CONV_WEIGHTS(0x088u, (bx - 128) * NWAVES + wid, 128 * NWAVES);
        }
        GRID_SYNC();

        const int nsub = (mid == 0) ? 1 : 2;
#pragma unroll 1
        for (int sub = 0; sub < nsub; ++sub) {
            int nA, nMem;
            if (mid == 0) { nA = 1536; nMem = 256; } else if (sub == 0) { nA = (mid == 1) ? 768 : 192; nMem = 256; } else { nA = (mid == 1) ? 96 : 768; nMem = 0; }
#ifndef REP_P2
#define REP_P2 1
#endif
#ifndef REP_MID
#define REP_MID mid
#endif
            const int nrep = (mid == (REP_MID)) ? REP_P2 : 1;
            for (int rep = 0; rep < nrep; ++rep) {
            const bool dry = rep < nrep - 1;
            WS_PTRS();
            unsigned* ctr = ctl + (l * 2 + sub) + 16 * rep;
            if (mid == 1 && sub == 1) ctr = ctl + 128 + 64 * (bx & 7) + 16 * rep;
            int u = fetch_unit(ctr, misc, tid);
            if (mid == 0) {
                while (u < nA) {
                    const int hp = u & 3, n = (u >> 2) & 31, r = u >> 7, kvh = r % 3, b = r / 3;
                    const int head = kvh * 8 + hp * 2 + (wid >> 2);
                    const float sink = args.in[l == 0 ? 7 : 17][head] * L2E;
#ifndef SK_SWA
                    attn_unit<64, MODE_SWA>(lds, tid, wid, lane, proj + head * 64, b * SEQ + n * 128 + (wid & 3) * 32, proj + 1536 + kvh * 64, proj + 1728 + kvh * 64, LDP,
                                            n == 0 ? 2 : 4, b * SEQ + n * 128 - (n ? 128 : 0), 0, sink, 1.f, 0u, 0u, proj + zoff + head * 64, dry);
#endif
                    u = fetch_unit(ctr, misc, tid);
                }
            } else if (mid == 1 && sub == 0) {
                while (u < nA) {
#ifndef SK_KMEAN
                    kmean_unit(lds, tid, proj, kmean, u);
#endif
                    u = fetch_unit(ctr, misc, tid);
                }
            } else if (mid == 1) {
                while (u < nA) {
                    const int qb = 15 - u / 6, bh = (bx & 7) + 8 * (u % 6), b = bh / 12, h = bh % 12;
#ifndef SK_MOBA
                    moba_gate(lds, tid, proj, kmean, b, h, qb);
                    volatile LAS unsigned* selm = (volatile LAS unsigned*)(lds + LDS_MISC - 2048);
                    const unsigned s0 = selm[wid * 32 + (lane & 15)], s1 = selm[wid * 32 + 16 + (lane & 15)];
                    __syncthreads();
                    attn_unit<128, MODE_MOBA>(lds, tid, wid, lane, proj + h * 128, b * SEQ + qb * 256 + wid * 32, proj + 1536 + h * 128, proj + 3072 + h * 128, LDP,
                                              4 + 4 * qb, b * SEQ + qb * 256, b * SEQ, -1e30f, 0.f, s0, s1, proj + zoff + h * 128, dry);
#endif
                    u = fetch_unit(ctr, misc, tid);
                }
            } else if (sub == 0) {
                while (u < nA) {
#ifndef SK_SCAN
                    ret_scan_item(lds, tid, wid, lane, proj, rprev, u);
#endif
                    u = fetch_unit(ctr, misc, tid);
                }
            } else {
                while (u < nA) {
#ifndef SK_ROUT
                    ret_out_unit(lds, tid, wid, lane, proj, rprev, u, dry);
#endif
                    u = fetch_unit(ctr, misc, tid);
                }
            }
            while (u < nA + nMem) {
                const int v = u - nA, hm = v & 3, qt = (v >> 2) & 15, b = v >> 6;
#ifndef SK_MEM
                attn_unit<128, MODE_MEM>(lds, tid, wid, lane, proj + nmix + hm * 128, b * SEQ + qt * 256 + wid * 32, mkv + hm * 128, mkv + 512 + hm * 128, 1024,
                                         4, b * NMEMTOK, 0, -1e30f, 0.f, 0u, 0u, proj + zoff + 1536 + hm * 128, dry);
#endif
                u = fetch_unit(ctr, misc, tid);
            }
            GRID_SYNC();
            }
        }

        {
            WS_PTRS(); const float* x = args.in[0]; float* out = args.out;
            pg8::Gemm g; g.A = proj + zoff; g.Bt = woutT + (size_t)l * 2048 * 2048; g.lda = LDP; g.K = DMODEL;
            pg8::StaticOrder S; S.init(MTOK, DMODEL, G, bx);
            pg8::EpiOut E; E.basef = x; E.out = out; E.hb = hb; E.rssn = rss + (size_t)(l + 1) * MTOK; E.mode = (l == 0) ? 0 : (l == 3 ? 2 : 1);

#ifndef SK_P3
pg8::gemm_phase<pg8::EpiOut, pg8::StaticOrder, true, true>(lds, g, S, E);
#endif

            __syncthreads();
        }
        GRID_SYNC();
    }

#ifdef EXTRA_SYNCS
    for (int i = 0; i < EXTRA_SYNCS; ++i) GRID_SYNC();
#endif
    {
        const int gw = bx * NWAVES + wid, NGW = G * NWAVES;
        WS_PTRS(); float* out = args.out;
        int lane_f = lane; asm volatile("" : "+v"(lane_f));
        const float* gf = args.in[19];
        for (int m = gw; m < MTOK; m += NGW) {
            const float s = __builtin_amdgcn_rsqf(rss[4 * MTOK + m] * (1.0f / DMODEL) + EPSN);
            f32x4* xr = (f32x4*)(out + (size_t)m * DMODEL) + lane_f; const f32x4* gr = (const f32x4*)gf + lane_f;
#pragma unroll
            for (int j = 0; j < 8; ++j) { const f32x4 v = xr[64 * j]; xr[64 * j] = v * s * gr[64 * j]; }
        }
    }
}

extern "C" void kernel_launch(void* const* d_in, const int* in_sizes, int n_in, void* d_out, int out_size, void* d_ws, size_t ws_size, hipStream_t stream) {
    static int grid = 0;
    if (grid == 0) {
        if (n_in != 20 || out_size != MTOK * DMODEL || ws_size < WS_END) { fprintf(stderr, "kernel_launch: unexpected shapes (n_in %d, out %d, ws %zu, need %zu)\n", n_in, out_size, ws_size, (size_t)WS_END); grid = -1; return; }
        int dev = 0, cus = 0, per_cu = 0;
        hipGetDevice(&dev); hipDeviceGetAttribute(&cus, hipDeviceAttributeMultiprocessorCount, dev);
        hipFuncSetAttribute((const void*)trunk_fwd, hipFuncAttributeMaxDynamicSharedMemorySize, LDS_BYTES);
        if (hipOccupancyMaxActiveBlocksPerMultiprocessor(&per_cu, (const void*)trunk_fwd, NTHREADS, LDS_BYTES) != hipSuccess || per_cu < 1) { fprintf(stderr, "kernel_launch: occupancy query gave %d\n", per_cu); per_cu = 1; }
        (void)hipGetLastError();
        grid = cus;
        if (grid != 256) fprintf(stderr, "kernel_launch: note: %d CUs\n", grid);
    }
    if (grid < 0) return;
    Args a{};
    for (int i = 0; i < 20; ++i) a.in[i] = (const float*)d_in[i];
    a.out = (float*)d_out; a.ws = (unsigned char*)d_ws;
    void* kargs[] = {&a};
    hipError_t e = hipLaunchCooperativeKernel((const void*)trunk_fwd, dim3(grid), dim3(NTHREADS), kargs, LDS_BYTES, stream);
    if (e != hipSuccess) fprintf(stderr, "cooperative launch failed: %s (grid %d)\n", hipGetErrorString(e), grid);
}
```

```cpp
#include <hip/hip_runtime.h>
#include <hip/hip_cooperative_groups.h>
#include <cstdio>
#include <cstdint>
namespace cg = cooperative_groups;
#define GAS __attribute__((address_space(1)))
namespace pg8 {
#define PG8_LAS __attribute__((address_space(3)))
typedef unsigned short bf16_t;
typedef short bf16x8 __attribute__((ext_vector_type(8)));
typedef float f32x4 __attribute__((ext_vector_type(4)));
typedef unsigned u32x4 __attribute__((ext_vector_type(4)));
constexpr int BM = 256, BK = 64, HALF = 128, HTB = HALF * BK * 2  , STAGE_BYTES = 8 * HTB, NXCD = 8, WGM = 8;

__host__ __device__ __forceinline__ int lds_byte(int r, int c) { const int st = (r >> 4) * 2 + (c >> 5), rr = r & 15, cc = c & 31, ob = rr * 64 + cc * 2; return st * 1024 + (ob ^ (((ob >> 9) & 1) << 5)); }
__host__ __device__ __forceinline__ void stage_rc(int b, int& R, int& C) { const int st = b / 1024, sb = b % 1024, swz = sb ^ (((sb >> 9) & 1) << 5); R = (st >> 1) * 16 + swz / 64; C = (st & 1) * 32 + (swz % 64) / 2; }
__host__ __device__ __forceinline__ int perm32(int rho) { const int n = rho >> 4, i = rho & 15; return 8 * (i >> 2) + 4 * n + (i & 3); }

struct Unit { int pm, pn; };
struct Gemm { const bf16_t* A; const bf16_t* Bt; int lda, K; };

struct StaticOrder {
    int nM, nN, nwg, G, c;
    __host__ __device__ void init(int M, int N, int G_, int c_) { nM = M / BM; nN = N / BM; nwg = nM * nN; G = G_; c = c_; }
    __host__ __device__ bool next(int i, Unit& u) const {
        const long L = (long)i * G + c; if (L >= nwg || c < 0) return false;
        int wgid = (int)L; { const int q = nwg / NXCD, r = nwg % NXCD, xcd = wgid % NXCD, off = wgid / NXCD; wgid = (xcd < r ? xcd * (q + 1) : r * (q + 1) + (xcd - r) * q) + off; }
        const int nig = WGM * nN, gid = wgid / nig, fm = gid * WGM, gsz = (nM - fm) < WGM ? (nM - fm) : WGM;
        u.pm = fm + ((wgid % nig) % gsz); u.pn = (wgid % nig) / gsz; return true;
    }
    __device__ __forceinline__ void a_ready(const Unit&) const {}
    __device__ __forceinline__ void done(const Unit&) const {}
};

__device__ __forceinline__ unsigned cvt_pk_bf16(float lo, float hi) { unsigned r; asm volatile("v_cvt_pk_bf16_f32 %0, %1, %2" : "=v"(r) : "v"(lo), "v"(hi)); return r; }
constexpr int NB = 4, SEQ = 4096, DMODEL = 2048, MTOK = NB * SEQ, NMEMTOK = 256, LDP = 7168;
constexpr float EPSN = 1e-6f;
__host__ __device__ constexpr int nc_of(int mid)   { return mid == 0 ? 4480 : (mid == 1 ? 7168 : 5632); }
__host__ __device__ constexpr int npad_of(int mid) { return mid == 0 ? 4608 : (mid == 1 ? 7168 : 5632); }
__host__ __device__ constexpr int nmix_of(int mid) { return mid == 0 ? 1920 : (mid == 1 ? 4608 : 3072); }

struct GDesc { int dst0, dst1, rope, rstr; float scale; };
__device__ __forceinline__ GDesc gdesc(int mid, int j0) {
    GDesc d; d.dst0 = j0; d.dst1 = j0 + 4; d.rope = -1; d.rstr = 0; d.scale = 1.f;
    const float L2E = 1.4426950408889634f, R128 = 0.08838834764831845f;
    if (mid == 0) {
        if (j0 >= 4480) { d.dst0 = -1; return d; }
        if (j0 < 1728) { const int hb = j0 & ~63, lg = (j0 & 63) >> 3;
            if (lg < 2) { d.dst0 = hb + 4 * lg; d.dst1 = hb + 8 + 4 * lg; d.rope = 4 * lg; d.rstr = 16; }
            if (j0 < 1536) d.scale = 0.125f * L2E; }
        else if (j0 >= 1920 && j0 < 2432) d.scale = R128 * L2E;
    } else if (mid == 1) {
        if (j0 < 3072) { const int hb = j0 & ~127, lg = (j0 & 127) >> 3;
            if (lg < 4) { d.dst0 = hb + 4 * lg; d.dst1 = hb + 16 + 4 * lg; d.rope = MTOK * 16 + 4 * lg; d.rstr = 32; }
            if (j0 < 1536) d.scale = R128 * L2E; }
        else if (j0 >= 4608 && j0 < 5120) d.scale = R128 * L2E;
    } else if (mid == 2) {
        if (j0 < 1536) { const int hb = j0 & ~127, lg = (j0 & 127) >> 3;
            d.dst0 = hb + 4 * lg; d.dst1 = hb + 64 + 4 * lg; d.rope = MTOK * 48 + 4 * lg; d.rstr = 128;
            if (j0 >= 768) d.scale = R128; }
        else if (j0 >= 3072 && j0 < 3584) d.scale = R128 * L2E;
    }
    return d;
}
__device__ __forceinline__ int src_col(int mid, int j) { const GDesc d = gdesc(mid, j & ~7); if (d.dst0 < 0) return -1; return (j & 4) ? d.dst1 + (j & 3) : d.dst0 + (j & 3); }

typedef unsigned u32x2 __attribute__((ext_vector_type(2)));
struct EpiIn {
    static constexpr bool PERM = true, AFTER_DRAIN = false;
    bf16_t* O; int ldc, mid; const float* rss; const float* rope0;
    __device__ __forceinline__ void operator()(const f32x4 (&acc)[2][2][4][2], const Unit& u, int wr, int wc, int fr, int fq) const {
        const int row0 = u.pm * BM + wr * 64 + fr;
        GDesc d[2];
#pragma unroll
        for (int bj = 0; bj < 2; ++bj) d[bj] = gdesc(mid, u.pn * BM + bj * HALF + wc * 32 + 8 * fq);
#pragma unroll
        for (int ai = 0; ai < 2; ++ai)
#pragma unroll
            for (int m = 0; m < 4; ++m) {
                const int r = row0 + ai * HALF + m * 16;
                const float s = __builtin_amdgcn_rsqf(*((const GAS float*)rss + r) * (1.0f / DMODEL) + EPSN);
                bf16_t* rowp = O + (size_t)r * ldc;
#pragma unroll
                for (int bj = 0; bj < 2; ++bj) {
                    if (d[bj].dst0 < 0) continue;
                    const float sc = s * d[bj].scale;
                    f32x4 v0 = acc[ai][bj][m][0] * sc, v1 = acc[ai][bj][m][1] * sc;
                    if (d[bj].rope >= 0) {
                        const float* t = rope0 + d[bj].rope + (size_t)r * d[bj].rstr; const int F = d[bj].rstr >> 1;
                        const f32x4 c = *(const GAS f32x4*)t, sn = *(const GAS f32x4*)(t + F);
                        const f32x4 n0 = v0 * c - v1 * sn, n1 = v1 * c + v0 * sn; v0 = n0; v1 = n1;
                    }
                    u32x2 w0, w1; w0.x = cvt_pk_bf16(v0[0], v0[1]); w0.y = cvt_pk_bf16(v0[2], v0[3]); w1.x = cvt_pk_bf16(v1[0], v1[1]); w1.y = cvt_pk_bf16(v1[2], v1[3]);
                    if (d[bj].dst1 == d[bj].dst0 + 4) { u32x4 w; w.x = w0.x; w.y = w0.y; w.z = w1.x; w.w = w1.y; *(GAS u32x4*)(rowp + d[bj].dst0) = w; }
                    else { *(GAS u32x2*)(rowp + d[bj].dst0) = w0; *(GAS u32x2*)(rowp + d[bj].dst1) = w1; }
                }
            }
    }
};
struct EpiOut {
    static constexpr bool PERM = true, AFTER_DRAIN = false;
    const float* basef; float* out; bf16_t* hb; float* rssn; int mode;
    __device__ __forceinline__ void operator()(const f32x4 (&acc)[2][2][4][2], const Unit& u, int wr, int wc, int fr, int fq) const {
        const int row0 = u.pm * BM + wr * 64 + fr, col0 = u.pn * BM + wc * 32 + 8 * fq;
#pragma unroll
        for (int ai = 0; ai < 2; ++ai)
#pragma unroll
            for (int m = 0; m < 4; ++m) {
                const int r = row0 + ai * HALF + m * 16; float ss = 0.f;
#pragma unroll
                for (int bj = 0; bj < 2; ++bj) {
                    const size_t off = (size_t)r * DMODEL + col0 + bj * HALF;
                    f32x4 b0, b1;
                    if (mode == 0) { b0 = *(const GAS f32x4*)(basef + off); b1 = *(const GAS f32x4*)(basef + off + 4); }
                    else { const u32x4 hw = *(const GAS u32x4*)(hb + off);
                        b0 = (f32x4){__builtin_bit_cast(float, hw.x << 16), __builtin_bit_cast(float, hw.x & 0xffff0000u), __builtin_bit_cast(float, hw.y << 16), __builtin_bit_cast(float, hw.y & 0xffff0000u)};
                        b1 = (f32x4){__builtin_bit_cast(float, hw.z << 16), __builtin_bit_cast(float, hw.z & 0xffff0000u), __builtin_bit_cast(float, hw.w << 16), __builtin_bit_cast(float, hw.w & 0xffff0000u)}; }
                    const f32x4 v0 = acc[ai][bj][m][0] + b0, v1 = acc[ai][bj][m][1] + b1;
                    if (mode == 2) { *(GAS f32x4*)(out + off) = v0; *(GAS f32x4*)(out + off + 4) = v1; }
                    else { u32x4 w; w.x = cvt_pk_bf16(v0[0], v0[1]); w.y = cvt_pk_bf16(v0[2], v0[3]); w.z = cvt_pk_bf16(v1[0], v1[1]); w.w = cvt_pk_bf16(v1[2], v1[3]);
                        *(GAS u32x4*)(hb + off) = w; }
                    ss += (v0[0] * v0[0] + v0[1] * v0[1]) + (v0[2] * v0[2] + v0[3] * v0[3]) + (v1[0] * v1[0] + v1[1] * v1[1]) + (v1[2] * v1[2] + v1[3] * v1[3]);
                }
                ss += __shfl_xor(ss, 16); ss += __shfl_xor(ss, 32);
                if (fq == 0) (void)__hip_atomic_fetch_add((GAS float*)(rssn + r), ss, __ATOMIC_RELAXED, __HIP_MEMORY_SCOPE_AGENT);
                if (m & 1) asm volatile("" ::: "memory");
            }
    }
};

template <class Epi, class Sched, bool ALIGN_EPI = false, bool SP2 = false>
__device__ __forceinline__ void gemm_phase(PG8_LAS unsigned char* lds, const Gemm g, const Sched& S, const Epi& E) {
    int tid_ = threadIdx.x; asm volatile("" : "+v"(tid_));
    const int tid = tid_, wid = __builtin_amdgcn_readfirstlane(tid >> 6), lane = tid & 63, wr = wid >> 2, wc = wid & 3, fr = lane & 15, fq = lane >> 4;
    const int K = g.K, nt = K / BK;
    unsigned voffA[2], voffB[2];
#pragma unroll
    for (int i = 0; i < 2; ++i) { int R, C; stage_rc(tid * 16 + i * 8192, R, C); const int Rb = Epi::PERM ? ((R & ~31) + perm32(R & 31)) : R;
        voffA[i] = (unsigned)(R * g.lda + C) * 2u; voffB[i] = (unsigned)(Rb * K + C) * 2u; }
    const size_t kstep = (size_t)(BK * 2);
    const size_t hstepA = (size_t)HALF * g.lda * 2, hstepB = (size_t)HALF * K * 2;
    const size_t tstepA = 2 * hstepA, tstepB = 2 * hstepB;
    const unsigned ldsw = (unsigned)wid * 1024u;
    const int aoff = lds_byte(wr * 64 + fr, fq * 8), boff = lds_byte(wc * 32 + fr, fq * 8);
#define PG8_SA(b, h) (((b) * 2 + (h)) * HTB)
#define PG8_SB(b, h) ((4 + (b) * 2 + (h)) * HTB)
#define PG8_STAGE(bufoff, gbase, voff) do { _Pragma("unroll") for (int _i = 0; _i < 2; ++_i) \
        __builtin_amdgcn_global_load_lds((const unsigned*)((const char*)(gbase) + (voff)[_i]), (PG8_LAS unsigned*)(lds + (bufoff) + ldsw + _i * 8192), 16, 0, 0); } while (0)
#define PG8_LDA(dst, b, h) do { _Pragma("unroll") for (int m = 0; m < 4; ++m) _Pragma("unroll") for (int k = 0; k < 2; ++k) dst[m][k] = *(const PG8_LAS bf16x8*)(lds + PG8_SA(b, h) + aoff + m * 2048 + k * 1024); } while (0)
#define PG8_LDB(dst, b, h) do { _Pragma("unroll") for (int n = 0; n < 2; ++n) _Pragma("unroll") for (int k = 0; k < 2; ++k) dst[n][k] = *(const PG8_LAS bf16x8*)(lds + PG8_SB(b, h) + boff + n * 2048 + k * 1024); } while (0)
#define PG8_MMA(ai, bj, At, Bt) do { __builtin_amdgcn_s_setprio(1); _Pragma("unroll") for (int m = 0; m < 4; ++m) _Pragma("unroll") for (int n = 0; n < 2; ++n) _Pragma("unroll") for (int k = 0; k < 2; ++k) \
        acc[ai][bj][m][n] = __builtin_amdgcn_mfma_f32_16x16x32_bf16(Bt[n][k], At[m][k], acc[ai][bj][m][n], 0, 0, 0); __builtin_amdgcn_s_setprio(0); } while (0)
#define PG8_WAIT_V(n) asm volatile("s_waitcnt vmcnt(" #n ")" ::: "memory")
#define PG8_WAIT_L(n) asm volatile("s_waitcnt lgkmcnt(" #n ")" ::: "memory")
#define PG8_BAR __builtin_amdgcn_s_barrier()
#define PG8_SCHED __builtin_amdgcn_sched_barrier(0)
    Unit cur, nxt; int ui = 0;
    if (!S.next(0, cur)) return;
    f32x4 acc[2][2][4][2];
#pragma unroll
    for (int a = 0; a < 2; ++a)
#pragma unroll
        for (int b = 0; b < 2; ++b)
#pragma unroll
            for (int m = 0; m < 4; ++m)
#pragma unroll
                for (int n = 0; n < 2; ++n) acc[a][b][m][n] = (f32x4){0.f, 0.f, 0.f, 0.f};
    bf16x8 At[4][2], B0[2][2], B1[2][2];
    const char* cA = (const char*)g.A + (size_t)cur.pm * tstepA; const char* cB = (const char*)g.Bt + (size_t)cur.pn * tstepB;
    S.a_ready(cur);
    if constexpr (SP2) {
        PG8_STAGE(PG8_SB(0, 0), cB, voffB); PG8_STAGE(PG8_SB(0, 1), cB + hstepB, voffB); PG8_STAGE(PG8_SA(0, 0), cA, voffA); PG8_STAGE(PG8_SA(0, 1), cA + hstepA, voffA);
        if (wr == 1) PG8_BAR;
        PG8_WAIT_V(2); PG8_BAR;
        PG8_STAGE(PG8_SB(1, 0), cB + kstep, voffB); PG8_STAGE(PG8_SA(1, 0), cA + kstep, voffA); PG8_STAGE(PG8_SB(1, 1), cB + hstepB + kstep, voffB);
        PG8_WAIT_V(6); PG8_BAR;
    } else {
        PG8_STAGE(PG8_SB(0, 0), cB, voffB); PG8_STAGE(PG8_SA(0, 0), cA, voffA); PG8_STAGE(PG8_SB(0, 1), cB + hstepB, voffB); PG8_STAGE(PG8_SA(0, 1), cA + hstepA, voffA);
        if (wr == 1) PG8_BAR;
        PG8_WAIT_V(4); PG8_BAR;
        PG8_STAGE(PG8_SB(1, 0), cB + kstep, voffB); PG8_STAGE(PG8_SA(1, 0), cA + kstep, voffA); PG8_STAGE(PG8_SB(1, 1), cB + hstepB + kstep, voffB);
        PG8_WAIT_V(6); PG8_BAR;
    }
    for (;;) {
        const bool has_next = S.next(ui + 1, nxt);
        const char* nA = has_next ? (const char*)g.A + (size_t)nxt.pm * tstepA : cA; const char* nB = has_next ? (const char*)g.Bt + (size_t)nxt.pn * tstepB : cB;
        for (int t = 0; t < nt; t += 2) {
            const bool last = (t == nt - 2);
            const char* a1 = cA + (size_t)(t + 1) * kstep;
            const char* a2 = last ? nA : cA + (size_t)(t + 2) * kstep; const char* b2 = last ? nB : cB + (size_t)(t + 2) * kstep;
            const char* a3 = a2 + kstep; const char* b3 = b2 + kstep;
            if (last && has_next) S.a_ready(nxt);
            if constexpr (SP2) {
            PG8_LDB(B0, 0, 0); PG8_LDB(B1, 0, 1); PG8_SCHED; PG8_LDA(At, 0, 0); PG8_STAGE(PG8_SA(1, 1), a1 + hstepA, voffA);
            PG8_WAIT_V(8); PG8_WAIT_L(0); PG8_BAR; PG8_MMA(0, 0, At, B0); PG8_MMA(0, 1, At, B1); PG8_BAR; PG8_SCHED;
            PG8_LDA(At, 0, 1); PG8_STAGE(PG8_SB(0, 0), b2, voffB); PG8_STAGE(PG8_SB(0, 1), b2 + hstepB, voffB); PG8_STAGE(PG8_SA(0, 0), a2, voffA);
            PG8_WAIT_V(8); PG8_WAIT_L(0); PG8_BAR; PG8_MMA(1, 0, At, B0); PG8_MMA(1, 1, At, B1); PG8_BAR; PG8_SCHED;
            PG8_LDB(B0, 1, 0); PG8_LDB(B1, 1, 1); PG8_SCHED; PG8_LDA(At, 1, 0); PG8_STAGE(PG8_SA(0, 1), a2 + hstepA, voffA);
            PG8_WAIT_V(8); PG8_WAIT_L(0); PG8_BAR; PG8_MMA(0, 0, At, B0); PG8_MMA(0, 1, At, B1); PG8_BAR; PG8_SCHED;
            PG8_LDA(At, 1, 1); PG8_STAGE(PG8_SB(1, 0), b3, voffB); PG8_STAGE(PG8_SB(1, 1), b3 + hstepB, voffB); PG8_STAGE(PG8_SA(1, 0), a3, voffA);
            PG8_WAIT_V(8); PG8_WAIT_L(0); PG8_BAR; PG8_MMA(1, 0, At, B0); PG8_MMA(1, 1, At, B1); PG8_BAR; PG8_SCHED;
            } else {
            PG8_LDB(B0, 0, 0); PG8_SCHED; PG8_LDA(At, 0, 0); PG8_STAGE(PG8_SA(1, 1), a1 + hstepA, voffA);
            PG8_WAIT_L(8); PG8_BAR; PG8_WAIT_L(0); PG8_MMA(0, 0, At, B0); PG8_BAR; PG8_SCHED;
            PG8_LDB(B1, 0, 1); PG8_STAGE(PG8_SB(0, 0), b2, voffB);
            PG8_BAR; PG8_WAIT_L(0); PG8_MMA(0, 1, At, B1); PG8_BAR;
            PG8_LDA(At, 0, 1); PG8_STAGE(PG8_SA(0, 0), a2, voffA);
            PG8_BAR; PG8_WAIT_L(0); PG8_MMA(1, 0, At, B0); PG8_BAR; PG8_SCHED;
            PG8_STAGE(PG8_SB(0, 1), b2 + hstepB, voffB);
            PG8_WAIT_V(6); PG8_BAR; PG8_MMA(1, 1, At, B1); PG8_BAR;
            PG8_LDB(B0, 1, 0); PG8_SCHED; PG8_LDA(At, 1, 0); PG8_STAGE(PG8_SA(0, 1), a2 + hstepA, voffA);
            PG8_WAIT_L(8); PG8_BAR; PG8_WAIT_L(0); PG8_MMA(0, 0, At, B0); PG8_BAR; PG8_SCHED;
            PG8_LDB(B1, 1, 1); PG8_STAGE(PG8_SB(1, 0), b3, voffB);
            PG8_BAR; PG8_WAIT_L(0); PG8_MMA(0, 1, At, B1); PG8_BAR;
            PG8_LDA(At, 1, 1); PG8_STAGE(PG8_SA(1, 0), a3, voffA);
            PG8_BAR; PG8_WAIT_L(0); PG8_MMA(1, 0, At, B0); PG8_BAR; PG8_SCHED;
            PG8_STAGE(PG8_SB(1, 1), b3 + hstepB, voffB);
            PG8_WAIT_V(6); PG8_BAR; PG8_MMA(1, 1, At, B1); PG8_BAR;
            }
        }
        if constexpr (ALIGN_EPI) { if (wr == 0) PG8_BAR; }
        if constexpr (!Epi::AFTER_DRAIN) { E(acc, cur, wr, wc, fr, fq); S.done(cur); }
        if (!has_next) break;
#pragma unroll
        for (int a = 0; a < 2; ++a)
#pragma unroll
            for (int b = 0; b < 2; ++b)
#pragma unroll
                for (int m = 0; m < 4; ++m)
#pragma unroll
                    for (int n = 0; n < 2; ++n) acc[a][b][m][n] = (f32x4){0.f, 0.f, 0.f, 0.f};
        cur = nxt; cA = nA; cB = nB; ++ui;
        if constexpr (ALIGN_EPI) { if (wr == 1) PG8_BAR; }
    }
    PG8_WAIT_V(0);
    if constexpr (!ALIGN_EPI) { if (wr == 0) PG8_BAR; }
    PG8_BAR;
    if constexpr (Epi::AFTER_DRAIN) { E.fused(acc, cur, wr, wc, fr, fq, lds, wid, lane); S.done(cur); }
#undef PG8_SA
#undef PG8_SB
#undef PG8_STAGE
#undef PG8_LDA
#undef PG8_LDB
#undef PG8_MMA
#undef PG8_WAIT_V
#undef PG8_WAIT_L
#undef PG8_BAR
#undef PG8_SCHED
}
}

using pg8::bf16_t; using pg8::bf16x8; using pg8::f32x4; using pg8::u32x4; using pg8::u32x2; using pg8::cvt_pk_bf16;
using pg8::NB; using pg8::SEQ; using pg8::DMODEL; using pg8::MTOK; using pg8::NMEMTOK; using pg8::LDP; using pg8::EPSN;
#define LAS __attribute__((address_space(3)))
typedef short s16x4 __attribute__((ext_vector_type(4)));
typedef float f32x2 __attribute__((ext_vector_type(2)));

constexpr int NTHREADS = 512, NWAVES = 8;
constexpr int LDS_BYTES = 147456;
constexpr int LDS_MISC = 139264;

constexpr size_t al256(size_t x) { return (x + 255) & ~(size_t)255; }
constexpr size_t WS_CTL   = 0;
constexpr size_t WS_WIN0  = 1u << 20;
constexpr size_t WS_WIN1  = WS_WIN0 + (size_t)4608 * 2048 * 2;
constexpr size_t WS_WIN2  = WS_WIN1 + (size_t)7168 * 2048 * 2;
constexpr size_t WS_WIN3  = WS_WIN2 + (size_t)5632 * 2048 * 2;
constexpr size_t WS_WOUT  = WS_WIN3 + (size_t)4608 * 2048 * 2;
constexpr size_t WS_WMEM  = WS_WOUT + (size_t)4 * 2048 * 2048 * 2;
constexpr size_t WS_HB    = WS_WMEM + (size_t)1024 * 2048 * 2;
constexpr size_t WS_PROJ  = WS_HB + (size_t)MTOK * 2048 * 2;
constexpr size_t WS_MEMB  = WS_PROJ + (size_t)MTOK * LDP * 2;
constexpr size_t WS_MKV   = WS_MEMB + (size_t)1024 * 2048 * 2;
constexpr size_t WS_RSS   = WS_MKV + (size_t)1024 * 1024 * 2;
constexpr size_t WS_RSSM  = WS_RSS + (size_t)5 * MTOK * 4;
constexpr size_t WS_ROPEA = WS_RSSM + 4096;
constexpr size_t WS_ROPEB = WS_ROPEA + (size_t)MTOK * 16 * 4;
constexpr size_t WS_ROPEC = WS_ROPEB + (size_t)MTOK * 32 * 4;
constexpr size_t WS_KMEAN = WS_ROPEC + (size_t)MTOK * 128 * 4;
constexpr size_t WS_RPREV = WS_KMEAN + (size_t)4 * 12 * 16 * 128 * 4;
constexpr size_t WS_END   = WS_RPREV + (size_t)4 * 32 * 6 * 256 * 128 * 2;

__constant__ double INVF[88] = {
 1.0, 0.19392274474868576, 0.03760603093086393, 0.007292664737217109, 0.001414213562373095, 0.0002742481756762073, 5.318295896944988e-05, 1.031338537721246e-05,
 1.0, 0.44036660267178046, 0.19392274474868576, 0.08539710028576561, 0.03760603093086393, 0.016560440080994446, 0.007292664737217109, 0.003211445994752591, 0.001414213562373095, 0.000622772421914596, 0.0002742481756762073, 0.00012076973741146504, 5.318295896944988e-05, 2.341999896140934e-05, 1.031338537721246e-05, 4.5416704806078695e-06,
 1.0, 0.8659643233600653, 0.7498942093324559, 0.6493816315762113, 0.5623413251903491, 0.4869675251658631, 0.4216965034285822, 0.3651741272548377, 0.31622776601683794, 0.27384196342643613, 0.23713737056616552, 0.2053525026457146, 0.1778279410038923, 0.1539926526059492, 0.1333521432163324, 0.11547819846894582, 0.1, 0.08659643233600653, 0.07498942093324558, 0.06493816315762113, 0.05623413251903491, 0.04869675251658631, 0.042169650342858224, 0.03651741272548377, 0.03162277660168379, 0.027384196342643614, 0.023713737056616554, 0.02053525026457146, 0.01778279410038923, 0.01539926526059492, 0.01333521432163324, 0.011547819846894581, 0.01, 0.008659643233600654, 0.007498942093324558, 0.006493816315762113, 0.005623413251903491, 0.004869675251658631, 0.004216965034285823, 0.003651741272548377, 0.0031622776601683794, 0.0027384196342643613, 0.0023713737056616554, 0.002053525026457146, 0.0017782794100389228, 0.001539926526059492, 0.001333521432163324, 0.0011547819846894581, 0.001, 0.0008659643233600654, 0.0007498942093324559, 0.0006493816315762113, 0.0005623413251903491, 0.0004869675251658631, 0.00042169650342858224, 0.0003651741272548377, 0.00031622776601683794, 0.0002738419634264361, 0.00023713737056616554, 0.0002053525026457146, 0.00017782794100389227, 0.0001539926526059492, 0.0001333521432163324, 0.00011547819846894582 };
__device__ __forceinline__ float log2gamma(int h) {
    return h == 0 ? -0.04580368961312479f : h == 1 ? -0.02612928206836121f : h == 2 ? -0.014949433599796901f : h == 3 ? -0.008567249848519122f : h == 4 ? -0.004914372264518986f : -0.002820519062378663f;
}

#define LDS_WAIT() asm volatile("s_waitcnt lgkmcnt(0)" ::: "memory")
__device__ __forceinline__ unsigned f2bf(float f) { unsigned u = __builtin_bit_cast(unsigned, f); return (u + 0x7fffu + ((u >> 16) & 1u)) >> 16; }
__device__ __forceinline__ unsigned pk2(float lo, float hi) { return f2bf(lo) | (f2bf(hi) << 16); }
__device__ __forceinline__ float bflo(unsigned w) { return __builtin_bit_cast(float, w << 16); }
__device__ __forceinline__ float bfhi(unsigned w) { return __builtin_bit_cast(float, w & 0xffff0000u); }
__device__ __forceinline__ float wave_sum(float v) {
#pragma unroll
    for (int o = 1; o < 64; o <<= 1) v += __shfl_xor(v, o);
    return v;
}
__device__ __forceinline__ float fexp2(float x) { return __builtin_amdgcn_exp2f(x); }
__device__ __forceinline__ s16x4 vtr(const LAS unsigned char* p) { return __builtin_bit_cast(s16x4, __builtin_amdgcn_ds_read_tr16_b64_v4i16((LAS s16x4*)p)); }
__device__ __forceinline__ bf16x8 cat8(s16x4 a, s16x4 b) { bf16x8 r; r[0] = a[0]; r[1] = a[1]; r[2] = a[2]; r[3] = a[3]; r[4] = b[0]; r[5] = b[1]; r[6] = b[2]; r[7] = b[3]; return r; }
typedef float f32x2_t __attribute__((ext_vector_type(2)));
typedef __bf16 bf16x2_t __attribute__((ext_vector_type(2)));
__device__ __forceinline__ unsigned cvtpk(float lo, float hi) { f32x2_t v = {lo, hi}; bf16x2_t b = __builtin_convertvector(v, bf16x2_t); return __builtin_bit_cast(unsigned, b); }
__device__ __forceinline__ float xmax16(float x) { const auto r = __builtin_amdgcn_permlane16_swap(__builtin_bit_cast(unsigned, x), __builtin_bit_cast(unsigned, x), false, false); return fmaxf(__builtin_bit_cast(float, r[0]), __builtin_bit_cast(float, r[1])); }
__device__ __forceinline__ float xmax32(float x) { const auto r = __builtin_amdgcn_permlane32_swap(__builtin_bit_cast(unsigned, x), __builtin_bit_cast(unsigned, x), false, false); return fmaxf(__builtin_bit_cast(float, r[0]), __builtin_bit_cast(float, r[1])); }
__device__ __forceinline__ bf16x8 pack8s(f32x4 a, f32x4 b) { u32x4 w; w.x = cvtpk(a[0], a[1]); w.y = cvtpk(a[2], a[3]); w.z = cvtpk(b[0], b[1]); w.w = cvtpk(b[2], b[3]); return __builtin_bit_cast(bf16x8, w); }
__device__ __forceinline__ bf16x8 pack8(f32x4 a, f32x4 b) { u32x4 w; w.x = cvt_pk_bf16(a[0], a[1]); w.y = cvt_pk_bf16(a[2], a[3]); w.z = cvt_pk_bf16(b[0], b[1]); w.w = cvt_pk_bf16(b[2], b[3]); return __builtin_bit_cast(bf16x8, w); }
__device__ __forceinline__ float silu_mul(float o, float z) { return o * z * __builtin_amdgcn_rcpf(1.0f + fexp2(-1.4426950408889634f * z)); }

__device__ __forceinline__ void transpose_item(const float* W, int N, int mid, const float* gvec, bf16_t* WT, int nblk, int item, int lane, LAS float* scr) {
    const int kb = item / nblk, nb = item % nblk, k0 = 64 * kb, n0 = 64 * nb;
    const int c4 = lane & 15, r4 = lane >> 4, j = n0 + 4 * c4;
    const int sc = (mid < 0) ? j : pg8::src_col(mid, j);
    f32x4 v[16];
#pragma unroll
    for (int i = 0; i < 16; ++i) { v[i] = (f32x4){0.f, 0.f, 0.f, 0.f}; if (sc >= 0) v[i] = *(const GAS f32x4*)(W + (size_t)(k0 + 4 * i + r4) * N + sc); }
#pragma unroll
    for (int i = 0; i < 16; ++i) { const int kk = 4 * i + r4; const float gk = gvec ? gvec[k0 + kk] : 1.0f; LAS float* d = scr + kk * 65 + 4 * c4;
        d[0] = v[i][0] * gk; d[1] = v[i][1] * gk; d[2] = v[i][2] * gk; d[3] = v[i][3] * gk; }
    LDS_WAIT(); asm volatile("" ::: "memory");
    const int c = lane & 7;
#pragma unroll
    for (int jj = 0; jj < 8; ++jj) { const int n = (lane >> 3) + 8 * jj; const LAS float* sp = scr + (8 * c) * 65 + n;
        u32x4 o; o.x = pk2(sp[0 * 65], sp[1 * 65]); o.y = pk2(sp[2 * 65], sp[3 * 65]); o.z = pk2(sp[4 * 65], sp[5 * 65]); o.w = pk2(sp[6 * 65], sp[7 * 65]);
        *(GAS u32x4*)(WT + (size_t)(n0 + n) * 2048 + k0 + 8 * c) = o; }
    LDS_WAIT(); asm volatile("" ::: "memory");
}
__device__ __forceinline__ void row_to_bf16(const float* xrow, bf16_t* orow, float* rss, int lane) {
    const f32x4* xr = (const f32x4*)xrow + lane; float s = 0.f;
    GAS u32x2* o8 = (GAS u32x2*)orow + lane;
#pragma unroll
    for (int j = 0; j < 8; ++j) { const f32x4 v = xr[64 * j]; s += (v.x * v.x + v.y * v.y) + (v.z * v.z + v.w * v.w);
        u32x2 w; w.x = pk2(v.x, v.y); w.y = pk2(v.z, v.w); o8[64 * j] = w; }
    s = wave_sum(s);
    if (lane == 0) *(GAS float*)rss = s;
}

enum { MODE_SWA = 0, MODE_MOBA = 1, MODE_MEM = 2 };
template <int DH, int MODE>
__device__ __forceinline__ void attn_unit(LAS unsigned char* lds, int tid, int wid, int lane,
        const bf16_t* Q,
        int qrow0,
        const bf16_t* Kb, const bf16_t* Vb, int ldkv,
        int nt, int krow_a, int krow_b,
        float m_init, float l_init, unsigned sel0, unsigned sel1,
        bf16_t* Zy,
        bool dry = false)
{
    asm volatile("" : "+v"(tid), "+v"(lane)); asm volatile("" : "+s"(wid));
    constexpr int KSTR = DH * 2 + 16, VSTR = DH * 2 + 32, KBYTES = 64 * KSTR, VBYTES = 64 * VSTR, STG = KBYTES + VBYTES;
    constexpr int CPR = DH / 8  , CPT = (64 * CPR) / NTHREADS  ;
    constexpr int NK = DH / 32, NDB = DH / 16;
    const int g = lane >> 4, l15 = lane & 15, q4 = l15 >> 2, p4 = l15 & 3;
    bf16x8 Qf[2][NK];
#pragma unroll
    for (int j = 0; j < 2; ++j)
#pragma unroll
        for (int k = 0; k < NK; ++k) Qf[j][k] = *(const GAS bf16x8*)(Q + (size_t)(qrow0 + j * 16 + l15) * LDP + k * 32 + g * 8);
    f32x4 O[NDB][2];
#pragma unroll
    for (int db = 0; db < NDB; ++db) { O[db][0] = (f32x4){0.f, 0.f, 0.f, 0.f}; O[db][1] = (f32x4){0.f, 0.f, 0.f, 0.f}; }
    const float m0 = (MODE == MODE_SWA) ? m_init : 0.f;
    float mrow[2] = {m0, m0}, lrow[2] = {g == 0 ? l_init : 0.f, g == 0 ? l_init : 0.f};
    bool first = (MODE != MODE_SWA);
    const unsigned sel[2] = {sel0, sel1};

    u32x4 kreg[2][CPT], vreg[2][CPT];
#define ATT_KROW(it) ((MODE == MODE_MOBA && (it) >= 4) ? (krow_b + 64 * ((it) - 4)) : (krow_a + 64 * (it)))
#define ATT_ISSUE(hf_, it) do { const int kr_ = ATT_KROW(it); _Pragma("unroll") for (int i_ = 0; i_ < CPT; ++i_) { const int c_ = tid + NTHREADS * i_, r_ = c_ / CPR, cc_ = c_ % CPR; \
        kreg[hf_][i_] = *(const GAS u32x4*)(Kb + (size_t)(kr_ + r_) * ldkv + cc_ * 8); vreg[hf_][i_] = *(const GAS u32x4*)(Vb + (size_t)(kr_ + r_) * ldkv + cc_ * 8); } } while (0)
    constexpr bool PF2 = false;
    ATT_ISSUE(0, 0);
    if (PF2 && nt > 1) ATT_ISSUE(1, 1);
    for (int it0 = 0; it0 < nt; it0 += 2) {
#pragma unroll
      for (int hf = 0; hf < 2; ++hf) {
        const int it = it0 + hf;
        if (it >= nt) break;
        LAS unsigned char* Kt = lds + hf * STG; LAS unsigned char* Vt = Kt + KBYTES;
#pragma unroll
        for (int i = 0; i < CPT; ++i) { const int c = tid + NTHREADS * i, r = c / CPR, cc = c % CPR;
            *(LAS u32x4*)(Kt + r * KSTR + cc * 16) = kreg[PF2 ? hf : 0][i]; *(LAS u32x4*)(Vt + r * VSTR + cc * 16) = vreg[PF2 ? hf : 0][i]; }
        if (PF2) { if (it + 2 < nt) ATT_ISSUE(hf, it + 2); } else { if (it + 1 < nt) ATT_ISSUE(0, it + 1); }
        __syncthreads();
        const int kp = ATT_KROW(it);
        bool active = true;
        if (MODE == MODE_SWA) active = !(kp > qrow0 + 31 || kp + 63 <= qrow0 - 128);
        if (MODE == MODE_MOBA) active = !(kp > qrow0 + 31);
        if (active) {
            f32x4 S[4][2];
            float sinit[2] = {-mrow[0], -mrow[1]};
            if (MODE == MODE_MOBA && it >= 4) {
                const int pb = (it - 4) >> 2;
                sinit[0] = ((sel[0] >> pb) & 1u) ? sinit[0] : -INFINITY; sinit[1] = ((sel[1] >> pb) & 1u) ? sinit[1] : -INFINITY;
            }
#pragma unroll
            for (int kb = 0; kb < 4; ++kb) { S[kb][0] = (f32x4){sinit[0], sinit[0], sinit[0], sinit[0]}; S[kb][1] = (f32x4){sinit[1], sinit[1], sinit[1], sinit[1]}; }
#pragma unroll
            for (int kb = 0; kb < 4; ++kb) {
#pragma unroll
                for (int k = 0; k < NK; ++k) {
                    const bf16x8 a = *(const LAS bf16x8*)(Kt + (kb * 16 + l15) * KSTR + (k * 32 + g * 8) * 2);
                    S[kb][0] = __builtin_amdgcn_mfma_f32_16x16x32_bf16(a, Qf[0][k], S[kb][0], 0, 0, 0);
                    S[kb][1] = __builtin_amdgcn_mfma_f32_16x16x32_bf16(a, Qf[1][k], S[kb][1], 0, 0, 0);
                }
                if (kb & 1) __builtin_amdgcn_sched_barrier(0);
            }
            bf16x8 Pb[2][2];
#pragma unroll
            for (int j = 0; j < 2; ++j) {
                const int qi = qrow0 + j * 16 + l15;
                if (MODE == MODE_SWA) {
                    if (!(kp + 63 <= qrow0 && kp > qrow0 + 31 - 128)) {
                        const unsigned dbase = (unsigned)(qi - kp - 4 * g);
#pragma unroll
                        for (int kb = 0; kb < 4; ++kb)
#pragma unroll
                            for (int i = 0; i < 4; ++i) S[kb][j][i] = ((dbase - (unsigned)(kb * 16 + i)) < 128u) ? S[kb][j][i] : -INFINITY;
                    }
                } else if (MODE == MODE_MOBA) {
                    if (kp + 63 > qrow0) {
#pragma unroll
                        for (int kb = 0; kb < 4; ++kb)
#pragma unroll
                            for (int i = 0; i < 4; ++i) S[kb][j][i] = ((qi - kp - 4 * g) >= (kb * 16 + i)) ? S[kb][j][i] : -INFINITY;
                    }
                }
                float mx = -INFINITY;
#pragma unroll
                for (int kb = 0; kb < 4; ++kb) mx = fmaxf(mx, fmaxf(fmaxf(S[kb][j][0], S[kb][j][1]), fmaxf(S[kb][j][2], S[kb][j][3])));
                mx = xmax16(mx); mx = xmax32(mx);
                const bool need = (first && mx > -INFINITY) || (mx > 8.0f);
                if (__builtin_amdgcn_ballot_w64(need) != 0ull) {
                    const float dlt = need ? mx : 0.f, alpha = fexp2(-dlt);
#pragma unroll
                    for (int kb = 0; kb < 4; ++kb) S[kb][j] = S[kb][j] - dlt;
                    mrow[j] += dlt; lrow[j] *= alpha;
#pragma unroll
                    for (int db = 0; db < NDB; ++db) O[db][j] = O[db][j] * alpha;
                }
                float ps = 0.f;
#pragma unroll
                for (int kb = 0; kb < 4; ++kb)
#pragma unroll
                    for (int i = 0; i < 4; ++i) { const float p = fexp2(S[kb][j][i]); S[kb][j][i] = p; ps += p; }
                lrow[j] += ps;
                Pb[j][0] = pack8s(S[0][j], S[1][j]); Pb[j][1] = pack8s(S[2][j], S[3][j]);
            }
#pragma unroll
            for (int s = 0; s < 2; ++s)
#pragma unroll
                for (int db = 0; db < NDB; ++db) {
                    const s16x4 lo = vtr(Vt + (32 * s + 4 * g + q4) * VSTR + (16 * db + 4 * p4) * 2);
                    const s16x4 hi = vtr(Vt + (32 * s + 16 + 4 * g + q4) * VSTR + (16 * db + 4 * p4) * 2);
                    const bf16x8 a = cat8(lo, hi);
                    O[db][0] = __builtin_amdgcn_mfma_f32_16x16x32_bf16(a, Pb[0][s], O[db][0], 0, 0, 0);
                    O[db][1] = __builtin_amdgcn_mfma_f32_16x16x32_bf16(a, Pb[1][s], O[db][1], 0, 0, 0);
                    if ((db & 3) == 3) __builtin_amdgcn_sched_barrier(0);
                }
            first = false;
        }
      }
    }
#undef ATT_ISSUE
#undef ATT_KROW
#pragma unroll
    for (int j = 0; j < 2; ++j) {
        float l = lrow[j]; l += __shfl_xor(l, 16); l += __shfl_xor(l, 32);
        const float inv = 1.0f / l;
        bf16_t* zp = Zy + (size_t)(qrow0 + j * 16 + l15) * LDP + 4 * g;
#pragma unroll
        for (int db = 0; db < NDB; ++db) {
            const u32x2 z = *(const GAS u32x2*)(zp + 16 * db);
            const f32x4 o = O[db][j] * inv;
            u32x2 w; w.x = cvt_pk_bf16(silu_mul(o[0], bflo(z.x)), silu_mul(o[1], bfhi(z.x))); w.y = cvt_pk_bf16(silu_mul(o[2], bflo(z.y)), silu_mul(o[3], bfhi(z.y)));
            if (!dry) *(GAS u32x2*)(zp + 16 * db) = w;
        }
    }
    __syncthreads();
}

__device__ __forceinline__ void moba_gate(LAS unsigned char* lds, int tid, const bf16_t* proj, const float* kmean, int b, int h, int qb) {
    asm volatile("" : "+v"(tid));
    LAS float* km = (LAS float*)lds;
    LAS unsigned* selm = (LAS unsigned*)(lds + LDS_MISC - 2048);
    for (int i = tid; i < 16 * 128; i += NTHREADS) km[i] = *((const GAS float*)kmean + (size_t)((b * 12 + h) * 16) * 128 + i);
    __syncthreads();
    const int q = tid >> 1, half = tid & 1;
    const bf16_t* qp = proj + (size_t)(b * SEQ + qb * 256 + q) * LDP + h * 128 + half * 64;
    float gsc[15];
#pragma unroll
    for (int n = 0; n < 15; ++n) gsc[n] = 0.f;
#pragma unroll 1
    for (int c = 0; c < 8; ++c) {
        const u32x4 w = *(const GAS u32x4*)(qp + c * 8);
        float qv[8] = {bflo(w.x), bfhi(w.x), bflo(w.y), bfhi(w.y), bflo(w.z), bfhi(w.z), bflo(w.w), bfhi(w.w)};
#pragma unroll
        for (int n = 0; n < 15; ++n) if (n < qb) {
            const LAS float* kr = km + n * 128 + half * 64 + c * 8;
#pragma unroll
            for (int e = 0; e < 8; ++e) gsc[n] += qv[e] * kr[e];
        }
    }
    unsigned mask = 0u;
#pragma unroll
    for (int n = 0; n < 15; ++n) { gsc[n] += __shfl_xor(gsc[n], 1); if (n >= qb) gsc[n] = -INFINITY; }
#pragma unroll
    for (int r = 0; r < 3; ++r) {
        float best = -INFINITY; int bi = -1;
#pragma unroll
        for (int n = 0; n < 15; ++n) { const bool taken = (mask >> n) & 1u; if (!taken && gsc[n] > best) { best = gsc[n]; bi = n; } }
        if (bi >= 0) mask |= 1u << bi;
    }
    if (half == 0) selm[q] = mask;
    __syncthreads();
}

__device__ __forceinline__ void kmean_unit(LAS unsigned char* lds, int tid, const bf16_t* proj, float* kmean, int u) {
    asm volatile("" : "+v"(tid));
    const int blk = u & 15, bh = u >> 4, b = bh / 12, h = bh % 12;
    const int cc = tid & 15, kg = tid >> 4;
    float s[8] = {0.f, 0.f, 0.f, 0.f, 0.f, 0.f, 0.f, 0.f};
    const bf16_t* kp = proj + (size_t)(b * SEQ + blk * 256 + kg * 8) * LDP + 1536 + h * 128 + cc * 8;
#pragma unroll
    for (int r = 0; r < 8; ++r) { const u32x4 w = *(const GAS u32x4*)(kp + (size_t)r * LDP);
        s[0] += bflo(w.x); s[1] += bfhi(w.x); s[2] += bflo(w.y); s[3] += bfhi(w.y); s[4] += bflo(w.z); s[5] += bfhi(w.z); s[6] += bflo(w.w); s[7] += bfhi(w.w); }
    LAS float* red = (LAS float*)lds;
#pragma unroll
    for (int e = 0; e < 8; ++e) red[kg * 128 + cc * 8 + e] = s[e];
    __syncthreads();
    if (tid < 128) { float a = 0.f;
#pragma unroll 8
        for (int k = 0; k < 32; ++k) a += red[k * 128 + tid];
        *((GAS float*)kmean + (size_t)u * 128 + tid) = a * (1.0f / 256.0f); }
    __syncthreads();
}

__device__ __forceinline__ void ret_scan_item(LAS unsigned char* lds, int tid, int wid, int lane, const bf16_t* proj, bf16_t* rprev, int item) {
    asm volatile("" : "+v"(tid), "+v"(lane)); asm volatile("" : "+s"(wid));
    constexpr int KS = 288, VS = 96, KB = 128 * KS, STG = KB + 128 * VS;
    const int es = item & 7, bh = item >> 3, b = bh / 6, h = bh % 6;
    const float lg = log2gamma(h), gchunk = fexp2(128.f * lg);
    const int g = lane >> 4, l15 = lane & 15, q4 = l15 >> 2, p4 = l15 & 3;
    const bf16_t* kbase = proj + (size_t)(b * SEQ) * LDP + 768 + h * 128;
    const bf16_t* vbase = proj + (size_t)(b * SEQ) * LDP + 1536 + h * 256 + es * 32;
    f32x4 R[2] = {(f32x4){0.f, 0.f, 0.f, 0.f}, (f32x4){0.f, 0.f, 0.f, 0.f}};
    u32x4 kreg[4], vreg;
#define RS_ISSUE(n) do { _Pragma("unroll") for (int i_ = 0; i_ < 4; ++i_) { const int c_ = tid + NTHREADS * i_; kreg[i_] = *(const GAS u32x4*)(kbase + (size_t)((n) * 128 + (c_ >> 4)) * LDP + (c_ & 15) * 8); } \
        vreg = *(const GAS u32x4*)(vbase + (size_t)((n) * 128 + (tid >> 2)) * LDP + (tid & 3) * 8); } while (0)
    RS_ISSUE(0);
    for (int n = 0; n < 32; ++n) {
        bf16_t* rp = rprev + ((size_t)((b * 32 + n) * 6 + h) * 256 + es * 32 + l15) * 128 + wid * 16 + 4 * g;
#pragma unroll
        for (int eb = 0; eb < 2; ++eb) { u32x2 w; w.x = cvt_pk_bf16(R[eb][0], R[eb][1]); w.y = cvt_pk_bf16(R[eb][2], R[eb][3]); *(GAS u32x2*)(rp + (size_t)eb * 16 * 128) = w; }
        if (n == 31) break;
        LAS unsigned char* Kt = lds + (n & 1) * STG; LAS unsigned char* Vt = Kt + KB;
#pragma unroll
        for (int i = 0; i < 4; ++i) { const int c = tid + NTHREADS * i, t = c >> 4, cc = c & 15;
            const float zt = fexp2((float)(127 - t) * lg);
            const u32x4 w = kreg[i]; u32x4 o;
            o.x = cvt_pk_bf16(bflo(w.x) * zt, bfhi(w.x) * zt); o.y = cvt_pk_bf16(bflo(w.y) * zt, bfhi(w.y) * zt); o.z = cvt_pk_bf16(bflo(w.z) * zt, bfhi(w.z) * zt); o.w = cvt_pk_bf16(bflo(w.w) * zt, bfhi(w.w) * zt);
            *(LAS u32x4*)(Kt + t * KS + cc * 16) = o; }
        *(LAS u32x4*)(Vt + (tid >> 2) * VS + (tid & 3) * 16) = vreg;
        __syncthreads();
        if (n + 1 < 31) RS_ISSUE(n + 1);
        R[0] = R[0] * gchunk; R[1] = R[1] * gchunk;
#pragma unroll
        for (int s = 0; s < 4; ++s) {
            const bf16x8 a = cat8(vtr(Kt + (32 * s + 8 * g + q4) * KS + (16 * wid + 4 * p4) * 2), vtr(Kt + (32 * s + 8 * g + 4 + q4) * KS + (16 * wid + 4 * p4) * 2));
#pragma unroll
            for (int eb = 0; eb < 2; ++eb) {
                const bf16x8 bb = cat8(vtr(Vt + (32 * s + 8 * g + q4) * VS + (16 * eb + 4 * p4) * 2), vtr(Vt + (32 * s + 8 * g + 4 + q4) * VS + (16 * eb + 4 * p4) * 2));
                R[eb] = __builtin_amdgcn_mfma_f32_16x16x32_bf16(a, bb, R[eb], 0, 0, 0);
            }
        }
    }
#undef RS_ISSUE
    __syncthreads();
}

__device__ __forceinline__ void ret_out_unit(LAS unsigned char* lds, int tid, int wid, int lane, bf16_t* proj, const bf16_t* rprev, int u, bool dry = false) {
    asm volatile("" : "+v"(tid), "+v"(lane)); asm volatile("" : "+s"(wid));
    constexpr int KS = 272, VS = 544, KB = 128 * KS;
    const int h = u % 6, bn = u / 6, n = bn & 31, b = bn >> 5;
    const float lg = log2gamma(h);
    const int g = lane >> 4, l15 = lane & 15, q4 = l15 >> 2, p4 = l15 & 3;
    const int row0 = b * SEQ + n * 128;
    LAS unsigned char* Kt = lds; LAS unsigned char* Vt = lds + KB;
    const bf16_t* kbase = proj + (size_t)row0 * LDP + 768 + h * 128;
    const bf16_t* vbase = proj + (size_t)row0 * LDP + 1536 + h * 256;
#pragma unroll
    for (int i = 0; i < 4; ++i) { const int c = tid + NTHREADS * i, t = c >> 4, cc = c & 15; *(LAS u32x4*)(Kt + t * KS + cc * 16) = *(const GAS u32x4*)(kbase + (size_t)t * LDP + cc * 8); }
#pragma unroll
    for (int i = 0; i < 8; ++i) { const int c = tid + NTHREADS * i, t = c >> 5, cc = c & 31; *(LAS u32x4*)(Vt + t * VS + cc * 16) = *(const GAS u32x4*)(vbase + (size_t)t * LDP + cc * 8); }
    const int qrow = row0 + wid * 16 + l15;
    bf16x8 Qf[4];
#pragma unroll
    for (int k = 0; k < 4; ++k) Qf[k] = *(const GAS bf16x8*)(proj + (size_t)qrow * LDP + h * 128 + k * 32 + g * 8);
    u32x4 rreg[8];
    const bf16_t* rbase = rprev + (size_t)((b * 32 + n) * 6 + h) * 256 * 128;
#pragma unroll
    for (int i = 0; i < 8; ++i) { const int c = tid + NTHREADS * i; rreg[i] = *(const GAS u32x4*)(rbase + (size_t)c * 8); }
    __syncthreads();
    f32x4 S[8];
#pragma unroll
    for (int kb = 0; kb < 8; ++kb) S[kb] = (f32x4){0.f, 0.f, 0.f, 0.f};
#pragma unroll
    for (int kb = 0; kb < 8; ++kb) if (kb <= wid) {
#pragma unroll
        for (int k = 0; k < 4; ++k) {
            const bf16x8 a = *(const LAS bf16x8*)(Kt + (kb * 16 + l15) * KS + (k * 32 + g * 8) * 2);
            S[kb] = __builtin_amdgcn_mfma_f32_16x16x32_bf16(a, Qf[k], S[kb], 0, 0, 0);
        }
    }
    const int tq = wid * 16 + l15;
    bf16x8 Pb[4];
#pragma unroll
    for (int kb = 0; kb < 8; ++kb)
#pragma unroll
        for (int i = 0; i < 4; ++i) { const int tk = kb * 16 + 4 * g + i; S[kb][i] = (tk <= tq) ? S[kb][i] * fexp2(-(float)(tk + 1) * lg) : 0.f; }
#pragma unroll
    for (int s = 0; s < 4; ++s) Pb[s] = pack8(S[2 * s], S[2 * s + 1]);
    f32x4 O[16];
#pragma unroll
    for (int eb = 0; eb < 16; ++eb) O[eb] = (f32x4){0.f, 0.f, 0.f, 0.f};
#pragma unroll
    for (int s = 0; s < 4; ++s) if (2 * s <= wid) {
#pragma unroll
        for (int eb = 0; eb < 16; ++eb) {
            const bf16x8 a = cat8(vtr(Vt + (32 * s + 4 * g + q4) * VS + (16 * eb + 4 * p4) * 2), vtr(Vt + (32 * s + 16 + 4 * g + q4) * VS + (16 * eb + 4 * p4) * 2));
            O[eb] = __builtin_amdgcn_mfma_f32_16x16x32_bf16(a, Pb[s], O[eb], 0, 0, 0);
        }
    }
    __syncthreads();
#pragma unroll
    for (int i = 0; i < 8; ++i) { const int c = tid + NTHREADS * i; *(LAS u32x4*)(Vt + (c >> 4) * KS + (c & 15) * 16) = rreg[i]; }
    __syncthreads();
#pragma unroll
    for (int eb = 0; eb < 16; ++eb)
#pragma unroll
        for (int k = 0; k < 4; ++k) {
            const bf16x8 a = *(const LAS bf16x8*)(Vt + (eb * 16 + l15) * KS + (k * 32 + g * 8) * 2);
            O[eb] = __builtin_amdgcn_mfma_f32_16x16x32_bf16(a, Qf[k], O[eb], 0, 0, 0);
        }
    const float xi = fexp2((float)(tq + 1) * lg);
    float ss = 0.f;
#pragma unroll
    for (int eb = 0; eb < 16; ++eb) { O[eb] = O[eb] * xi; ss += (O[eb][0] * O[eb][0] + O[eb][1] * O[eb][1]) + (O[eb][2] * O[eb][2] + O[eb][3] * O[eb][3]); }
    ss += __shfl_xor(ss, 16); ss += __shfl_xor(ss, 32);
    const float rstd = __builtin_amdgcn_rsqf(ss * (1.0f / 256.0f) + EPSN);
    bf16_t* zp = proj + (size_t)qrow * LDP + 3584 + h * 256 + 4 * g;
#pragma unroll
    for (int eb = 0; eb < 16; ++eb) {
        const u32x2 z = *(const GAS u32x2*)(zp + 16 * eb);
        const f32x4 o = O[eb] * rstd;
        u32x2 w; w.x = cvt_pk_bf16(silu_mul(o[0], bflo(z.x)), silu_mul(o[1], bfhi(z.x))); w.y = cvt_pk_bf16(silu_mul(o[2], bflo(z.y)), silu_mul(o[3], bfhi(z.y)));
        if (!dry) *(GAS u32x2*)(zp + 16 * eb) = w;
    }
    __syncthreads();
}

#define XB_TMO      128
#define XB_XCNT(j)  (256  + 64 * (j))
#define XB_XSUB(j)  (1280 + 64 * (j))
#define XB_XGEN(j)  (2304 + 64 * (j))
#define XB_TOP      3328
#define XB_TOPGEN   3392
#define XCD_BAR_WORDS 3456
#define XB_SPIN_CAP (1u << 18)

__device__ __forceinline__ unsigned xb_ld(unsigned* p)              { return __hip_atomic_load(p, __ATOMIC_RELAXED, __HIP_MEMORY_SCOPE_AGENT); }
__device__ __forceinline__ unsigned xb_add(unsigned* p, unsigned v) { return __hip_atomic_fetch_add(p, v, __ATOMIC_RELAXED, __HIP_MEMORY_SCOPE_AGENT); }
__device__ __forceinline__ unsigned xb_xcc_id() { return (unsigned)__builtin_amdgcn_s_getreg((3 << 11) | 20) & 0xFu; }
#define XB_SPIN(cond, bar) do { unsigned _sp = 0; while (cond) { __builtin_amdgcn_s_sleep(1); \
    if ((++_sp & 255u) == 0u) { if (xb_ld(&(bar)[XB_TMO])) break; if (_sp > XB_SPIN_CAP) { atomicAdd(&(bar)[XB_TMO], 1u); break; } } } } while (0)

struct XcdBarrier {
    unsigned* bar; unsigned x;
    volatile LAS unsigned* st;
};

__device__ __forceinline__ XcdBarrier xcd_barrier_post(unsigned* bar, volatile LAS unsigned* st) {
    XcdBarrier b; b.bar = bar; b.x = xb_xcc_id(); b.st = st;
    if (threadIdx.x == 0) (void)xb_add(&bar[XB_XCNT(b.x)], 1u);
    return b;
}
__device__ __forceinline__ void xcd_barrier_complete(unsigned* bar, unsigned x, unsigned& nloc, unsigned& nx) {
    const unsigned G = gridDim.x * gridDim.y * gridDim.z;
    unsigned sum, cnt, mine, sp = 0u;
    for (;;) {
        sum = 0u; cnt = 0u; mine = 0u;
#pragma unroll
        for (unsigned j = 0; j < 16; ++j) { const unsigned c = xb_ld(&bar[XB_XCNT(j)]); sum += c; cnt += (c > 0u) ? 1u : 0u; mine = (j == x) ? c : mine; }
        if (sum == G) break;
        __builtin_amdgcn_s_sleep(1);
        if ((++sp & 255u) == 0u) { if (xb_ld(&bar[XB_TMO])) break; if (sp > XB_SPIN_CAP) { atomicAdd(&bar[XB_TMO], 1u); break; } }
    }
    nloc = mine > 0u ? mine : 1u; nx = cnt > 0u ? cnt : 1u;
}

__device__ __forceinline__ void xcd_barrier(const XcdBarrier& b) {
    asm volatile("s_waitcnt vmcnt(0)" ::: "memory");
    __syncthreads();
    if (threadIdx.x == 0) {
        unsigned* bar = b.bar;
        __builtin_amdgcn_s_waitcnt(0);
        unsigned nloc = b.st[0], nx = b.st[1];
        if (nloc == 0u) { xcd_barrier_complete(bar, b.x, nloc, nx); b.st[0] = nloc; b.st[1] = nx; }
        const unsigned old = xb_add(&bar[XB_XSUB(b.x)], 1u);
        const unsigned gen = old / nloc;
        if (old + 1u == (gen + 1u) * nloc) {
            __builtin_amdgcn_fence(__ATOMIC_RELEASE, "agent");
            asm volatile("s_waitcnt vmcnt(0)" ::: "memory");
            const unsigned og = xb_add(&bar[XB_TOP], 1u);
            const unsigned tg = og / nx;
            if (og + 1u == (tg + 1u) * nx) xb_add(&bar[XB_TOPGEN], 1u);
            else XB_SPIN(xb_ld(&bar[XB_TOPGEN]) == tg, bar);
            __builtin_amdgcn_fence(__ATOMIC_ACQUIRE, "agent");
            xb_add(&bar[XB_XGEN(b.x)], 1u);
            asm volatile("s_waitcnt vmcnt(0)" ::: "memory");
        } else {
            XB_SPIN(xb_ld(&bar[XB_XGEN(b.x)]) == gen, bar);
            __builtin_amdgcn_fence(__ATOMIC_ACQUIRE, "agent");
            asm volatile("s_waitcnt vmcnt(0)" ::: "memory");
        }
    }
    __syncthreads();
}


#define CONV_WEIGHTS(MASK, worker, nworkers) do { \
        int lane_ = lane, wid_ = wid; asm volatile("" : "+v"(lane_)); asm volatile("" : "+s"(wid_)); LAS float* scr_ = (LAS float*)(lds + wid_ * 16640); \
        int total_ = 0; \
        _Pragma("unroll 1") for (int mi_ = 0; mi_ < 9; ++mi_) if (((MASK) >> mi_) & 1u) total_ += 32 * (mi_ < 4 ? pg8::npad_of(mi_ == 3 ? 0 : mi_) / 64 : (mi_ < 8 ? 32 : 16)); \
        for (int it_ = (worker); it_ < total_; it_ += (nworkers)) { \
            int r_ = it_; \
            _Pragma("unroll 1") for (int mi = 0; mi < 9; ++mi) { \
                if (!(((MASK) >> mi) & 1u)) continue; \
                const float* W; int N, mid_, nblk; const float* gv; bf16_t* WT; \
                if (mi < 4) { const int l_ = mi; mid_ = l_ == 3 ? 0 : l_; N = pg8::nc_of(mid_); nblk = pg8::npad_of(mid_) / 64; \
                    W = args.in[l_ == 0 ? 6 : l_ == 1 ? 10 : l_ == 2 ? 13 : 16]; gv = args.in[l_ == 0 ? 5 : l_ == 1 ? 9 : l_ == 2 ? 12 : 15]; \
                    WT = (bf16_t*)(ws + (l_ == 0 ? WS_WIN0 : l_ == 1 ? WS_WIN1 : l_ == 2 ? WS_WIN2 : WS_WIN3)); } \
                else if (mi < 8) { const int l_ = mi - 4; mid_ = -1; N = 2048; nblk = 32; W = args.in[l_ == 0 ? 8 : l_ == 1 ? 11 : l_ == 2 ? 14 : 18]; gv = nullptr; WT = woutT + (size_t)l_ * 2048 * 2048; } \
                else { mid_ = -1; N = 1024; nblk = 16; W = args.in[4]; gv = args.in[3]; WT = wmemT; } \
                const int cnt_ = 32 * nblk; \
                if (r_ < cnt_) { transpose_item(W, N, mid_, gv, WT, nblk, r_, lane_, scr_); break; } \
                r_ -= cnt_; \
            } \
        } } while (0)

struct Args { const float* in[20]; float* out; unsigned char* ws; };

__device__ __forceinline__ int fetch_unit(unsigned* ctr, volatile LAS unsigned* slot, int tid) {
    if (tid == 0) *slot = atomicAdd(ctr, 1u);
    __syncthreads();
    const unsigned v = *slot;
    __syncthreads();
    return __builtin_amdgcn_readfirstlane((int)v);
}

__global__ void __launch_bounds__(NTHREADS, 2) trunk_fwd(Args args) {
    extern __shared__ __attribute__((aligned(16))) unsigned char lds_raw[];
    cg::grid_group grid = cg::this_grid();
    LAS unsigned char* lds = (LAS unsigned char*)lds_raw;
    volatile LAS unsigned* misc = (volatile LAS unsigned*)(lds + LDS_MISC);
    const int tid = threadIdx.x, lane = tid & 63, wid = __builtin_amdgcn_readfirstlane(tid >> 6);
    const int G = gridDim.x, bx = blockIdx.x;
#define WS_PTRS() unsigned char* ws = args.ws; asm volatile("" : "+s"(ws)); \
    unsigned* ctl = (unsigned*)(ws + WS_CTL); bf16_t* hb = (bf16_t*)(ws + WS_HB); bf16_t* proj = (bf16_t*)(ws + WS_PROJ); \
    bf16_t* memb = (bf16_t*)(ws + WS_MEMB); bf16_t* mkv = (bf16_t*)(ws + WS_MKV); float* rss = (float*)(ws + WS_RSS); float* rssm = (float*)(ws + WS_RSSM); \
    float* ropeA = (float*)(ws + WS_ROPEA); float* ropeB = (float*)(ws + WS_ROPEB); float* ropeC = (float*)(ws + WS_ROPEC); \
    float* kmean = (float*)(ws + WS_KMEAN); bf16_t* rprev = (bf16_t*)(ws + WS_RPREV); bf16_t* woutT = (bf16_t*)(ws + WS_WOUT); bf16_t* wmemT = (bf16_t*)(ws + WS_WMEM); \
    (void)ctl; (void)hb; (void)proj; (void)memb; (void)mkv; (void)rss; (void)rssm; (void)ropeA; (void)ropeB; (void)ropeC; (void)kmean; (void)rprev; (void)woutT; (void)wmemT
#ifndef REP_P0
#define REP_P0 1
#endif
    for (int rep0 = 0; rep0 < REP_P0; ++rep0) {
        if (rep0) grid.sync();
        WS_PTRS(); const float* x = args.in[0];
        const int gw = bx * NWAVES + wid, NGW = G * NWAVES;
        LAS float* scr = (LAS float*)(lds + wid * 16640);
        if (G == 256) CONV_WEIGHTS(0x111u, gw, NGW); else CONV_WEIGHTS(0x1FFu, gw, NGW);
        for (int m = gw; m < MTOK; m += NGW) row_to_bf16(x + (size_t)m * DMODEL, hb + (size_t)m * DMODEL, rss + m, lane);
        for (int m = gw; m < NB * NMEMTOK; m += NGW) row_to_bf16(args.in[1] + (size_t)m * DMODEL, memb + (size_t)m * DMODEL, rssm + m, lane);
        const int* positions = (const int*)args.in[2];
        const int gt = bx * NTHREADS + tid, NGT = G * NTHREADS;
        for (int i = gt; i < MTOK * 88; i += NGT) {
            const int tok = i / 88, f = i % 88;
            float* tb; int F, fl;
            if (f < 8) { tb = ropeA; F = 8; fl = f; } else if (f < 24) { tb = ropeB; F = 16; fl = f - 8; } else { tb = ropeC; F = 64; fl = f - 24; }
            const double rev = (double)positions[tok] * INVF[f] * 0.15915494309189535;
            const float fr = (float)(rev - __builtin_rint(rev));
            *((GAS float*)tb + (size_t)tok * 2 * F + fl) = __builtin_amdgcn_cosf(fr); *((GAS float*)tb + (size_t)tok * 2 * F + F + fl) = __builtin_amdgcn_sinf(fr);
        }
        for (int i = gt; i < 4 * MTOK; i += NGT) *((GAS float*)rss + MTOK + i) = 0.f;
        if (bx == 0) for (int i = tid; i < 1024 + XCD_BAR_WORDS; i += NTHREADS) ctl[i] = 0u;
    }
    grid.sync();
    if (tid < 2) misc[8 + tid] = 0u;
    __syncthreads();
    XcdBarrier xbar;
    { unsigned char* ws0 = args.ws; xbar = xcd_barrier_post((unsigned*)(ws0 + WS_CTL) + 1024, misc + 8); }
#define GRID_SYNC() xcd_barrier(xbar)

    const float L2E = 1.4426950408889634f;
#pragma unroll 1
    for (int l = 0; l < 4; ++l) {
        const int mid = (l == 3) ? 0 : l;
        const int nmix = pg8::nmix_of(mid), zoff = nmix + 512;
#pragma unroll 1
#ifndef REP_P1
#define REP_P1 1
#endif
        for (int rep1 = 0; rep1 < REP_P1; ++rep1)
        for (int pass = 0; pass < (l == 0 ? 2 : 1); ++pass) {
            WS_PTRS();
            pg8::Gemm g; pg8::StaticOrder S; pg8::EpiIn E;
            if (pass == 0) {
                g.A = hb; g.Bt = (const bf16_t*)(ws + (l == 0 ? WS_WIN0 : l == 1 ? WS_WIN1 : l == 2 ? WS_WIN2 : WS_WIN3)); g.lda = DMODEL; g.K = DMODEL;
                S.init(MTOK, pg8::npad_of(mid), G, bx);
                E.O = proj; E.ldc = LDP; E.mid = mid; E.rss = rss + (size_t)l * MTOK;
            } else {
                g.A = memb; g.Bt = wmemT; g.lda = DMODEL; g.K = DMODEL;
                S.init(NB * NMEMTOK, 1024, 1 << 20, bx - (G == 256 ? 240 : 0));
                E.O = mkv; E.ldc = 1024; E.mid = 3; E.rss = rssm;
            }
            E.rope0 = ropeA;

#ifndef SK_P1
pg8::gemm_phase<pg8::EpiIn, pg8::StaticOrder, true, true>(lds, g, S, E);
#endif

            __syncthreads();
        }
        if (l == 0 && G == 256 && bx >= 128 && bx < 240) {
            WS_PTRS();
            CONV_WEIGHTS(0x066u, (bx - 128) * NWAVES + wid, 112 * NWAVES);
        } else if (l == 2 && G == 256 && bx >= 128) {
            WS_PTRS();
            CONV_WEIGHTS(0x088u, (bx - 128) * NWAVES + wid, 128 * NWAVES);
        }
        GRID_SYNC();

        const int nsub = (mid == 0) ? 1 : 2;
#pragma unroll 1
        for (int sub = 0; sub < nsub; ++sub) {
            int nA, nMem;
            if (mid == 0) { nA = 1536; nMem = 256; } else if (sub == 0) { nA = (mid == 1) ? 768 : 192; nMem = 256; } else { nA = (mid == 1) ? 96 : 768; nMem = 0; }
#ifndef REP_P2
#define REP_P2 1
#endif
#ifndef REP_MID
#define REP_MID mid
#endif
            const int nrep = (mid == (REP_MID)) ? REP_P2 : 1;
            for (int rep = 0; rep < nrep; ++rep) {
            const bool dry = rep < nrep - 1;
            WS_PTRS();
            unsigned* ctr = ctl + (l * 2 + sub) + 16 * rep;
            if (mid == 1 && sub == 1) ctr = ctl + 128 + 64 * (bx & 7) + 16 * rep;
            int u = fetch_unit(ctr, misc, tid);
            if (mid == 0) {
                while (u < nA) {
                    const int hp = u & 3, n = (u >> 2) & 31, r = u >> 7, kvh = r % 3, b = r / 3;
                    const int head = kvh * 8 + hp * 2 + (wid >> 2);
                    const float sink = args.in[l == 0 ? 7 : 17][head] * L2E;
#ifndef SK_SWA
                    attn_unit<64, MODE_SWA>(lds, tid, wid, lane, proj + head * 64, b * SEQ + n * 128 + (wid & 3) * 32, proj + 1536 + kvh * 64, proj + 1728 + kvh * 64, LDP,
                                            n == 0 ? 2 : 4, b * SEQ + n * 128 - (n ? 128 : 0), 0, sink, 1.f, 0u, 0u, proj + zoff + head * 64, dry);
#endif
                    u = fetch_unit(ctr, misc, tid);
                }
            } else if (mid == 1 && sub == 0) {
                while (u < nA) {
#ifndef SK_KMEAN
                    kmean_unit(lds, tid, proj, kmean, u);
#endif
                    u = fetch_unit(ctr, misc, tid);
                }
            } else if (mid == 1) {
                while (u < nA) {
                    const int qb = 15 - u / 6, bh = (bx & 7) + 8 * (u % 6), b = bh / 12, h = bh % 12;
#ifndef SK_MOBA
                    moba_gate(lds, tid, proj, kmean, b, h, qb);
                    volatile LAS unsigned* selm = (volatile LAS unsigned*)(lds + LDS_MISC - 2048);
                    const unsigned s0 = selm[wid * 32 + (lane & 15)], s1 = selm[wid * 32 + 16 + (lane & 15)];
                    __syncthreads();
                    attn_unit<128, MODE_MOBA>(lds, tid, wid, lane, proj + h * 128, b * SEQ + qb * 256 + wid * 32, proj + 1536 + h * 128, proj + 3072 + h * 128, LDP,
                                              4 + 4 * qb, b * SEQ + qb * 256, b * SEQ, -1e30f, 0.f, s0, s1, proj + zoff + h * 128, dry);
#endif
                    u = fetch_unit(ctr, misc, tid);
                }
            } else if (sub == 0) {
                while (u < nA) {
#ifndef SK_SCAN
                    ret_scan_item(lds, tid, wid, lane, proj, rprev, u);
#endif
                    u = fetch_unit(ctr, misc, tid);
                }
            } else {
                while (u < nA) {
#ifndef SK_ROUT
                    ret_out_unit(lds, tid, wid, lane, proj, rprev, u, dry);
#endif
                    u = fetch_unit(ctr, misc, tid);
                }
            }
            while (u < nA + nMem) {
                const int v = u - nA, hm = v & 3, qt = (v >> 2) & 15, b = v >> 6;
#ifndef SK_MEM
                attn_unit<128, MODE_MEM>(lds, tid, wid, lane, proj + nmix + hm * 128, b * SEQ + qt * 256 + wid * 32, mkv + hm * 128, mkv + 512 + hm * 128, 1024,
                                         4, b * NMEMTOK, 0, -1e30f, 0.f, 0u, 0u, proj + zoff + 1536 + hm * 128, dry);
#endif
                u = fetch_unit(ctr, misc, tid);
            }
            GRID_SYNC();
            }
        }

        {
            WS_PTRS(); const float* x = args.in[0]; float* out = args.out;
            pg8::Gemm g; g.A = proj + zoff; g.Bt = woutT + (size_t)l * 2048 * 2048; g.lda = LDP; g.K = DMODEL;
            pg8::StaticOrder S; S.init(MTOK, DMODEL, G, bx);
            pg8::EpiOut E; E.basef = x; E.out = out; E.hb = hb; E.rssn = rss + (size_t)(l + 1) * MTOK; E.mode = (l == 0) ? 0 : (l == 3 ? 2 : 1);

#ifndef SK_P3
pg8::gemm_phase<pg8::EpiOut, pg8::StaticOrder, true, true>(lds, g, S, E);
#endif

            __syncthreads();
        }
        GRID_SYNC();
    }

#ifdef EXTRA_SYNCS
    for (int i = 0; i < EXTRA_SYNCS; ++i) GRID_SYNC();
#endif
    {
        const int gw = bx * NWAVES + wid, NGW = G * NWAVES;
        WS_PTRS(); float* out = args.out;
        int lane_f = lane; asm volatile("" : "+v"(lane_f));
        const float* gf = args.in[19];
        for (int m = gw; m < MTOK; m += NGW) {
            const float s = __builtin_amdgcn_rsqf(*((const GAS float*)rss + 4 * MTOK + m) * (1.0f / DMODEL) + EPSN);
            f32x4* xr = (f32x4*)(out + (size_t)m * DMODEL) + lane_f; const f32x4* gr = (const f32x4*)gf + lane_f;
#pragma unroll
            for (int j = 0; j < 8; ++j) { const f32x4 v = xr[64 * j]; xr[64 * j] = v * s * gr[64 * j]; }
        }
    }
}

extern "C" void kernel_launch(void* const* d_in, const int* in_sizes, int n_in, void* d_out, int out_size, void* d_ws, size_t ws_size, hipStream_t stream) {
    static int grid = 0;
    if (grid == 0) {
        if (n_in != 20 || out_size != MTOK * DMODEL || ws_size < WS_END) { fprintf(stderr, "kernel_launch: unexpected shapes (n_in %d, out %d, ws %zu, need %zu)\n", n_in, out_size, ws_size, (size_t)WS_END); grid = -1; return; }
        int dev = 0, cus = 0, per_cu = 0;
        hipGetDevice(&dev); hipDeviceGetAttribute(&cus, hipDeviceAttributeMultiprocessorCount, dev);
        hipFuncSetAttribute((const void*)trunk_fwd, hipFuncAttributeMaxDynamicSharedMemorySize, LDS_BYTES);
        if (hipOccupancyMaxActiveBlocksPerMultiprocessor(&per_cu, (const void*)trunk_fwd, NTHREADS, LDS_BYTES) != hipSuccess || per_cu < 1) { fprintf(stderr, "kernel_launch: occupancy query gave %d\n", per_cu); per_cu = 1; }
        (void)hipGetLastError();
        grid = cus;
        if (grid != 256) fprintf(stderr, "kernel_launch: note: %d CUs\n", grid);
    }
    if (grid < 0) return;
    Args a{};
    for (int i = 0; i < 20; ++i) a.in[i] = (const float*)d_in[i];
    a.out = (float*)d_out; a.ws = (unsigned char*)d_ws;
    void* kargs[] = {&a};
    hipError_t e = hipLaunchCooperativeKernel((const void*)trunk_fwd, dim3(grid), dim3(NTHREADS), kargs, LDS_BYTES, stream);
    if (e != hipSuccess) fprintf(stderr, "cooperative launch failed: %s (grid %d)\n", hipGetErrorString(e), grid);
}
```

```cpp
#include <hip/hip_runtime.h>
#include <hip/hip_cooperative_groups.h>
#include <cstdio>
#include <cstdint>
namespace cg = cooperative_groups;
#define GAS __attribute__((address_space(1)))
namespace pg8 {
#define PG8_LAS __attribute__((address_space(3)))
typedef unsigned short bf16_t;
typedef short bf16x8 __attribute__((ext_vector_type(8)));
typedef float f32x4 __attribute__((ext_vector_type(4)));
typedef unsigned u32x4 __attribute__((ext_vector_type(4)));
constexpr int BM = 256, BK = 64, HALF = 128, HTB = HALF * BK * 2  , STAGE_BYTES = 8 * HTB, NXCD = 8, WGM = 8;

__host__ __device__ __forceinline__ int lds_byte(int r, int c) { const int st = (r >> 4) * 2 + (c >> 5), rr = r & 15, cc = c & 31, ob = rr * 64 + cc * 2; return st * 1024 + (ob ^ (((ob >> 9) & 1) << 5)); }
__host__ __device__ __forceinline__ void stage_rc(int b, int& R, int& C) { const int st = b / 1024, sb = b % 1024, swz = sb ^ (((sb >> 9) & 1) << 5); R = (st >> 1) * 16 + swz / 64; C = (st & 1) * 32 + (swz % 64) / 2; }
__host__ __device__ __forceinline__ int perm32(int rho) { const int n = rho >> 4, i = rho & 15; return 8 * (i >> 2) + 4 * n + (i & 3); }

struct Unit { int pm, pn; };
struct Gemm { const bf16_t* A; const bf16_t* Bt; int lda, K; };

struct StaticOrder {
    int nM, nN, nwg, G, c;
    __host__ __device__ void init(int M, int N, int G_, int c_) { nM = M / BM; nN = N / BM; nwg = nM * nN; G = G_; c = c_; }
    __host__ __device__ bool next(int i, Unit& u) const {
        const long L = (long)i * G + c; if (L >= nwg || c < 0) return false;
        int wgid = (int)L; { const int q = nwg / NXCD, r = nwg % NXCD, xcd = wgid % NXCD, off = wgid / NXCD; wgid = (xcd < r ? xcd * (q + 1) : r * (q + 1) + (xcd - r) * q) + off; }
        const int nig = WGM * nN, gid = wgid / nig, fm = gid * WGM, gsz = (nM - fm) < WGM ? (nM - fm) : WGM;
        u.pm = fm + ((wgid % nig) % gsz); u.pn = (wgid % nig) / gsz; return true;
    }
    __device__ __forceinline__ void a_ready(const Unit&) const {}
    __device__ __forceinline__ void done(const Unit&) const {}
};

__device__ __forceinline__ unsigned cvt_pk_bf16(float lo, float hi) { unsigned r; asm volatile("v_cvt_pk_bf16_f32 %0, %1, %2" : "=v"(r) : "v"(lo), "v"(hi)); return r; }
constexpr int NB = 4, SEQ = 4096, DMODEL = 2048, MTOK = NB * SEQ, NMEMTOK = 256, LDP = 7168;
constexpr float EPSN = 1e-6f;
__host__ __device__ constexpr int nc_of(int mid)   { return mid == 0 ? 4480 : (mid == 1 ? 7168 : 5632); }
__host__ __device__ constexpr int npad_of(int mid) { return mid == 0 ? 4608 : (mid == 1 ? 7168 : 5632); }
__host__ __device__ constexpr int nmix_of(int mid) { return mid == 0 ? 1920 : (mid == 1 ? 4608 : 3072); }

struct GDesc { int dst0, dst1, rope, rstr; float scale; };
__device__ __forceinline__ GDesc gdesc(int mid, int j0) {
    GDesc d; d.dst0 = j0; d.dst1 = j0 + 4; d.rope = -1; d.rstr = 0; d.scale = 1.f;
    const float L2E = 1.4426950408889634f, R128 = 0.08838834764831845f;
    if (mid == 0) {
        if (j0 >= 4480) { d.dst0 = -1; return d; }
        if (j0 < 1728) { const int hb = j0 & ~63, lg = (j0 & 63) >> 3;
            if (lg < 2) { d.dst0 = hb + 4 * lg; d.dst1 = hb + 8 + 4 * lg; d.rope = 4 * lg; d.rstr = 16; }
            if (j0 < 1536) d.scale = 0.125f * L2E; }
        else if (j0 >= 1920 && j0 < 2432) d.scale = R128 * L2E;
    } else if (mid == 1) {
        if (j0 < 3072) { const int hb = j0 & ~127, lg = (j0 & 127) >> 3;
            if (lg < 4) { d.dst0 = hb + 4 * lg; d.dst1 = hb + 16 + 4 * lg; d.rope = MTOK * 16 + 4 * lg; d.rstr = 32; }
            if (j0 < 1536) d.scale = R128 * L2E; }
        else if (j0 >= 4608 && j0 < 5120) d.scale = R128 * L2E;
    } else if (mid == 2) {
        if (j0 < 1536) { const int hb = j0 & ~127, lg = (j0 & 127) >> 3;
            d.dst0 = hb + 4 * lg; d.dst1 = hb + 64 + 4 * lg; d.rope = MTOK * 48 + 4 * lg; d.rstr = 128;
            if (j0 >= 768) d.scale = R128; }
        else if (j0 >= 3072 && j0 < 3584) d.scale = R128 * L2E;
    }
    return d;
}
__device__ __forceinline__ int src_col(int mid, int j) { const GDesc d = gdesc(mid, j & ~7); if (d.dst0 < 0) return -1; return (j & 4) ? d.dst1 + (j & 3) : d.dst0 + (j & 3); }

typedef unsigned u32x2 __attribute__((ext_vector_type(2)));
struct EpiIn {
    static constexpr bool PERM = true, AFTER_DRAIN = false;
    bf16_t* O; int ldc, mid; const float* rss; const float* rope0; float* kmean;
    __device__ __forceinline__ void operator()(const f32x4 (&acc)[2][2][4][2], const Unit& u, int wr, int wc, int fr, int fq) const {
        const int row0 = u.pm * BM + wr * 64 + fr;
        const bool ksum = (mid == 1) && (u.pn >= 6) && (u.pn < 12);
        float cs[2][8];
#pragma unroll
        for (int bj = 0; bj < 2; ++bj)
#pragma unroll
            for (int e = 0; e < 8; ++e) cs[bj][e] = 0.f;
        GDesc d[2];
#pragma unroll
        for (int bj = 0; bj < 2; ++bj) d[bj] = gdesc(mid, u.pn * BM + bj * HALF + wc * 32 + 8 * fq);
#pragma unroll
        for (int ai = 0; ai < 2; ++ai)
#pragma unroll
            for (int m = 0; m < 4; ++m) {
                const int r = row0 + ai * HALF + m * 16;
                const float s = __builtin_amdgcn_rsqf(*((const GAS float*)rss + r) * (1.0f / DMODEL) + EPSN);
                bf16_t* rowp = O + (size_t)r * ldc;
#pragma unroll
                for (int bj = 0; bj < 2; ++bj) {
                    if (d[bj].dst0 < 0) continue;
                    const float sc = s * d[bj].scale;
                    f32x4 v0 = acc[ai][bj][m][0] * sc, v1 = acc[ai][bj][m][1] * sc;
                    if (d[bj].rope >= 0) {
                        const float* t = rope0 + d[bj].rope + (size_t)r * d[bj].rstr; const int F = d[bj].rstr >> 1;
                        const f32x4 c = *(const GAS f32x4*)t, sn = *(const GAS f32x4*)(t + F);
                        const f32x4 n0 = v0 * c - v1 * sn, n1 = v1 * c + v0 * sn; v0 = n0; v1 = n1;
                    }
                    if (ksum) {
#pragma unroll
                        for (int e = 0; e < 4; ++e) { cs[bj][e] += v0[e]; cs[bj][4 + e] += v1[e]; }
                    }
                    u32x2 w0, w1; w0.x = cvt_pk_bf16(v0[0], v0[1]); w0.y = cvt_pk_bf16(v0[2], v0[3]); w1.x = cvt_pk_bf16(v1[0], v1[1]); w1.y = cvt_pk_bf16(v1[2], v1[3]);
                    if (d[bj].dst1 == d[bj].dst0 + 4) { u32x4 w; w.x = w0.x; w.y = w0.y; w.z = w1.x; w.w = w1.y; *(GAS u32x4*)(rowp + d[bj].dst0) = w; }
                    else { *(GAS u32x2*)(rowp + d[bj].dst0) = w0; *(GAS u32x2*)(rowp + d[bj].dst1) = w1; }
                }
            }
        if (ksum) {
            float* kb = kmean + (size_t)((u.pm >> 4) * 12 * 16 + (u.pm & 15)) * 128;
#pragma unroll
            for (int bj = 0; bj < 2; ++bj)
#pragma unroll
                for (int e = 0; e < 8; ++e) {
                    float v = cs[bj][e];
                    v += __shfl_xor(v, 1); v += __shfl_xor(v, 2); v += __shfl_xor(v, 4); v += __shfl_xor(v, 8);
                    const int col = ((e < 4) ? d[bj].dst0 + e : d[bj].dst1 + e - 4) - 1536, h = col >> 7, dd = col & 127;
                    if (fr == 0) (void)__hip_atomic_fetch_add((GAS float*)(kb + (size_t)h * 16 * 128 + dd), v * (1.0f / 256.0f), __ATOMIC_RELAXED, __HIP_MEMORY_SCOPE_AGENT);
                }
        }
    }
};
struct EpiOut {
    static constexpr bool PERM = true, AFTER_DRAIN = false;
    const float* basef; float* out; bf16_t* hb; float* rssn; int mode;
    __device__ __forceinline__ void operator()(const f32x4 (&acc)[2][2][4][2], const Unit& u, int wr, int wc, int fr, int fq) const {
        const int row0 = u.pm * BM + wr * 64 + fr, col0 = u.pn * BM + wc * 32 + 8 * fq;
#pragma unroll
        for (int ai = 0; ai < 2; ++ai)
#pragma unroll
            for (int m = 0; m < 4; ++m) {
                const int r = row0 + ai * HALF + m * 16; float ss = 0.f;
#pragma unroll
                for (int bj = 0; bj < 2; ++bj) {
                    const size_t off = (size_t)r * DMODEL + col0 + bj * HALF;
                    f32x4 b0, b1;
                    if (mode == 0) { b0 = *(const GAS f32x4*)(basef + off); b1 = *(const GAS f32x4*)(basef + off + 4); }
                    else { const u32x4 hw = *(const GAS u32x4*)(hb + off);
                        b0 = (f32x4){__builtin_bit_cast(float, hw.x << 16), __builtin_bit_cast(float, hw.x & 0xffff0000u), __builtin_bit_cast(float, hw.y << 16), __builtin_bit_cast(float, hw.y & 0xffff0000u)};
                        b1 = (f32x4){__builtin_bit_cast(float, hw.z << 16), __builtin_bit_cast(float, hw.z & 0xffff0000u), __builtin_bit_cast(float, hw.w << 16), __builtin_bit_cast(float, hw.w & 0xffff0000u)}; }
                    const f32x4 v0 = acc[ai][bj][m][0] + b0, v1 = acc[ai][bj][m][1] + b1;
                    if (mode == 2) { *(GAS f32x4*)(out + off) = v0; *(GAS f32x4*)(out + off + 4) = v1; }
                    else { u32x4 w; w.x = cvt_pk_bf16(v0[0], v0[1]); w.y = cvt_pk_bf16(v0[2], v0[3]); w.z = cvt_pk_bf16(v1[0], v1[1]); w.w = cvt_pk_bf16(v1[2], v1[3]);
                        *(GAS u32x4*)(hb + off) = w; }
                    ss += (v0[0] * v0[0] + v0[1] * v0[1]) + (v0[2] * v0[2] + v0[3] * v0[3]) + (v1[0] * v1[0] + v1[1] * v1[1]) + (v1[2] * v1[2] + v1[3] * v1[3]);
                }
                ss += __shfl_xor(ss, 16); ss += __shfl_xor(ss, 32);
                if (fq == 0) (void)__hip_atomic_fetch_add((GAS float*)(rssn + r), ss, __ATOMIC_RELAXED, __HIP_MEMORY_SCOPE_AGENT);
                if (m & 1) asm volatile("" ::: "memory");
            }
    }
};

template <class Epi, class Sched, bool ALIGN_EPI = false, bool SP2 = false>
__device__ __forceinline__ void gemm_phase(PG8_LAS unsigned char* lds, const Gemm g, const Sched& S, const Epi& E) {
    int tid_ = threadIdx.x; asm volatile("" : "+v"(tid_));
    const int tid = tid_, wid = __builtin_amdgcn_readfirstlane(tid >> 6), lane = tid & 63, wr = wid >> 2, wc = wid & 3, fr = lane & 15, fq = lane >> 4;
    const int K = g.K, nt = K / BK;
    unsigned voffA[2], voffB[2];
#pragma unroll
    for (int i = 0; i < 2; ++i) { int R, C; stage_rc(tid * 16 + i * 8192, R, C); const int Rb = Epi::PERM ? ((R & ~31) + perm32(R & 31)) : R;
        voffA[i] = (unsigned)(R * g.lda + C) * 2u; voffB[i] = (unsigned)(Rb * K + C) * 2u; }
    const size_t kstep = (size_t)(BK * 2);
    const size_t hstepA = (size_t)HALF * g.lda * 2, hstepB = (size_t)HALF * K * 2;
    const size_t tstepA = 2 * hstepA, tstepB = 2 * hstepB;
    const unsigned ldsw = (unsigned)wid * 1024u;
    const int aoff = lds_byte(wr * 64 + fr, fq * 8), boff = lds_byte(wc * 32 + fr, fq * 8);
#define PG8_SA(b, h) (((b) * 2 + (h)) * HTB)
#define PG8_SB(b, h) ((4 + (b) * 2 + (h)) * HTB)
#define PG8_STAGE(bufoff, gbase, voff) do { _Pragma("unroll") for (int _i = 0; _i < 2; ++_i) \
        __builtin_amdgcn_global_load_lds((const unsigned*)((const char*)(gbase) + (voff)[_i]), (PG8_LAS unsigned*)(lds + (bufoff) + ldsw + _i * 8192), 16, 0, 0); } while (0)
#define PG8_LDA(dst, b, h) do { _Pragma("unroll") for (int m = 0; m < 4; ++m) _Pragma("unroll") for (int k = 0; k < 2; ++k) dst[m][k] = *(const PG8_LAS bf16x8*)(lds + PG8_SA(b, h) + aoff + m * 2048 + k * 1024); } while (0)
#define PG8_LDB(dst, b, h) do { _Pragma("unroll") for (int n = 0; n < 2; ++n) _Pragma("unroll") for (int k = 0; k < 2; ++k) dst[n][k] = *(const PG8_LAS bf16x8*)(lds + PG8_SB(b, h) + boff + n * 2048 + k * 1024); } while (0)
#define PG8_MMA(ai, bj, At, Bt) do { __builtin_amdgcn_s_setprio(1); _Pragma("unroll") for (int m = 0; m < 4; ++m) _Pragma("unroll") for (int n = 0; n < 2; ++n) _Pragma("unroll") for (int k = 0; k < 2; ++k) \
        acc[ai][bj][m][n] = __builtin_amdgcn_mfma_f32_16x16x32_bf16(Bt[n][k], At[m][k], acc[ai][bj][m][n], 0, 0, 0); __builtin_amdgcn_s_setprio(0); } while (0)
#define PG8_WAIT_V(n) asm volatile("s_waitcnt vmcnt(" #n ")" ::: "memory")
#define PG8_WAIT_L(n) asm volatile("s_waitcnt lgkmcnt(" #n ")" ::: "memory")
#define PG8_BAR __builtin_amdgcn_s_barrier()
#define PG8_SCHED __builtin_amdgcn_sched_barrier(0)
    Unit cur, nxt; int ui = 0;
    if (!S.next(0, cur)) return;
    f32x4 acc[2][2][4][2];
#pragma unroll
    for (int a = 0; a < 2; ++a)
#pragma unroll
        for (int b = 0; b < 2; ++b)
#pragma unroll
            for (int m = 0; m < 4; ++m)
#pragma unroll
                for (int n = 0; n < 2; ++n) acc[a][b][m][n] = (f32x4){0.f, 0.f, 0.f, 0.f};
    bf16x8 At[4][2], B0[2][2], B1[2][2];
    const char* cA = (const char*)g.A + (size_t)cur.pm * tstepA; const char* cB = (const char*)g.Bt + (size_t)cur.pn * tstepB;
    S.a_ready(cur);
    if constexpr (SP2) {
        PG8_STAGE(PG8_SB(0, 0), cB, voffB); PG8_STAGE(PG8_SB(0, 1), cB + hstepB, voffB); PG8_STAGE(PG8_SA(0, 0), cA, voffA); PG8_STAGE(PG8_SA(0, 1), cA + hstepA, voffA);
        if (wr == 1) PG8_BAR;
        PG8_WAIT_V(2); PG8_BAR;
        PG8_STAGE(PG8_SB(1, 0), cB + kstep, voffB); PG8_STAGE(PG8_SA(1, 0), cA + kstep, voffA); PG8_STAGE(PG8_SB(1, 1), cB + hstepB + kstep, voffB);
        PG8_WAIT_V(6); PG8_BAR;
    } else {
        PG8_STAGE(PG8_SB(0, 0), cB, voffB); PG8_STAGE(PG8_SA(0, 0), cA, voffA); PG8_STAGE(PG8_SB(0, 1), cB + hstepB, voffB); PG8_STAGE(PG8_SA(0, 1), cA + hstepA, voffA);
        if (wr == 1) PG8_BAR;
        PG8_WAIT_V(4); PG8_BAR;
        PG8_STAGE(PG8_SB(1, 0), cB + kstep, voffB); PG8_STAGE(PG8_SA(1, 0), cA + kstep, voffA); PG8_STAGE(PG8_SB(1, 1), cB + hstepB + kstep, voffB);
        PG8_WAIT_V(6); PG8_BAR;
    }
    for (;;) {
        const bool has_next = S.next(ui + 1, nxt);
        const char* nA = has_next ? (const char*)g.A + (size_t)nxt.pm * tstepA : cA; const char* nB = has_next ? (const char*)g.Bt + (size_t)nxt.pn * tstepB : cB;
        for (int t = 0; t < nt; t += 2) {
            const bool last = (t == nt - 2);
            const char* a1 = cA + (size_t)(t + 1) * kstep;
            const char* a2 = last ? nA : cA + (size_t)(t + 2) * kstep; const char* b2 = last ? nB : cB + (size_t)(t + 2) * kstep;
            const char* a3 = a2 + kstep; const char* b3 = b2 + kstep;
            if (last && has_next) S.a_ready(nxt);
            if constexpr (SP2) {
            PG8_LDB(B0, 0, 0); PG8_LDB(B1, 0, 1); PG8_SCHED; PG8_LDA(At, 0, 0); PG8_STAGE(PG8_SA(1, 1), a1 + hstepA, voffA);
            PG8_WAIT_V(8); PG8_WAIT_L(0); PG8_BAR; PG8_MMA(0, 0, At, B0); PG8_MMA(0, 1, At, B1); PG8_BAR; PG8_SCHED;
            PG8_LDA(At, 0, 1); PG8_STAGE(PG8_SB(0, 0), b2, voffB); PG8_STAGE(PG8_SB(0, 1), b2 + hstepB, voffB); PG8_STAGE(PG8_SA(0, 0), a2, voffA);
            PG8_WAIT_V(8); PG8_WAIT_L(0); PG8_BAR; PG8_MMA(1, 0, At, B0); PG8_MMA(1, 1, At, B1); PG8_BAR; PG8_SCHED;
            PG8_LDB(B0, 1, 0); PG8_LDB(B1, 1, 1); PG8_SCHED; PG8_LDA(At, 1, 0); PG8_STAGE(PG8_SA(0, 1), a2 + hstepA, voffA);
            PG8_WAIT_V(8); PG8_WAIT_L(0); PG8_BAR; PG8_MMA(0, 0, At, B0); PG8_MMA(0, 1, At, B1); PG8_BAR; PG8_SCHED;
            PG8_LDA(At, 1, 1); PG8_STAGE(PG8_SB(1, 0), b3, voffB); PG8_STAGE(PG8_SB(1, 1), b3 + hstepB, voffB); PG8_STAGE(PG8_SA(1, 0), a3, voffA);
            PG8_WAIT_V(8); PG8_WAIT_L(0); PG8_BAR; PG8_MMA(1, 0, At, B0); PG8_MMA(1, 1, At, B1); PG8_BAR; PG8_SCHED;
            } else {
            PG8_LDB(B0, 0, 0); PG8_SCHED; PG8_LDA(At, 0, 0); PG8_STAGE(PG8_SA(1, 1), a1 + hstepA, voffA);
            PG8_WAIT_L(8); PG8_BAR; PG8_WAIT_L(0); PG8_MMA(0, 0, At, B0); PG8_BAR; PG8_SCHED;
            PG8_LDB(B1, 0, 1); PG8_STAGE(PG8_SB(0, 0), b2, voffB);
            PG8_BAR; PG8_WAIT_L(0); PG8_MMA(0, 1, At, B1); PG8_BAR;
            PG8_LDA(At, 0, 1); PG8_STAGE(PG8_SA(0, 0), a2, voffA);
            PG8_BAR; PG8_WAIT_L(0); PG8_MMA(1, 0, At, B0); PG8_BAR; PG8_SCHED;
            PG8_STAGE(PG8_SB(0, 1), b2 + hstepB, voffB);
            PG8_WAIT_V(6); PG8_BAR; PG8_MMA(1, 1, At, B1); PG8_BAR;
            PG8_LDB(B0, 1, 0); PG8_SCHED; PG8_LDA(At, 1, 0); PG8_STAGE(PG8_SA(0, 1), a2 + hstepA, voffA);
            PG8_WAIT_L(8); PG8_BAR; PG8_WAIT_L(0); PG8_MMA(0, 0, At, B0); PG8_BAR; PG8_SCHED;
            PG8_LDB(B1, 1, 1); PG8_STAGE(PG8_SB(1, 0), b3, voffB);
            PG8_BAR; PG8_WAIT_L(0); PG8_MMA(0, 1, At, B1); PG8_BAR;
            PG8_LDA(At, 1, 1); PG8_STAGE(PG8_SA(1, 0), a3, voffA);
            PG8_BAR; PG8_WAIT_L(0); PG8_MMA(1, 0, At, B0); PG8_BAR; PG8_SCHED;
            PG8_STAGE(PG8_SB(1, 1), b3 + hstepB, voffB);
            PG8_WAIT_V(6); PG8_BAR; PG8_MMA(1, 1, At, B1); PG8_BAR;
            }
        }
        if constexpr (ALIGN_EPI) { if (wr == 0) PG8_BAR; }
        if constexpr (!Epi::AFTER_DRAIN) { E(acc, cur, wr, wc, fr, fq); S.done(cur); }
        if (!has_next) break;
#pragma unroll
        for (int a = 0; a < 2; ++a)
#pragma unroll
            for (int b = 0; b < 2; ++b)
#pragma unroll
                for (int m = 0; m < 4; ++m)
#pragma unroll
                    for (int n = 0; n < 2; ++n) acc[a][b][m][n] = (f32x4){0.f, 0.f, 0.f, 0.f};
        cur = nxt; cA = nA; cB = nB; ++ui;
        if constexpr (ALIGN_EPI) { if (wr == 1) PG8_BAR; }
    }
    PG8_WAIT_V(0);
    if constexpr (!ALIGN_EPI) { if (wr == 0) PG8_BAR; }
    PG8_BAR;
    if constexpr (Epi::AFTER_DRAIN) { E.fused(acc, cur, wr, wc, fr, fq, lds, wid, lane); S.done(cur); }
#undef PG8_SA
#undef PG8_SB
#undef PG8_STAGE
#undef PG8_LDA
#undef PG8_LDB
#undef PG8_MMA
#undef PG8_WAIT_V
#undef PG8_WAIT_L
#undef PG8_BAR
#undef PG8_SCHED
}
}

using pg8::bf16_t; using pg8::bf16x8; using pg8::f32x4; using pg8::u32x4; using pg8::u32x2; using pg8::cvt_pk_bf16;
using pg8::NB; using pg8::SEQ; using pg8::DMODEL; using pg8::MTOK; using pg8::NMEMTOK; using pg8::LDP; using pg8::EPSN;
#define LAS __attribute__((address_space(3)))
typedef short s16x4 __attribute__((ext_vector_type(4)));
typedef float f32x2 __attribute__((ext_vector_type(2)));

constexpr int NTHREADS = 512, NWAVES = 8;
constexpr int LDS_BYTES = 147456;
constexpr int LDS_MISC = 139264;

constexpr size_t al256(size_t x) { return (x + 255) & ~(size_t)255; }
constexpr size_t WS_CTL   = 0;
constexpr size_t WS_WIN0  = 1u << 20;
constexpr size_t WS_WIN1  = WS_WIN0 + (size_t)4608 * 2048 * 2;
constexpr size_t WS_WIN2  = WS_WIN1 + (size_t)7168 * 2048 * 2;
constexpr size_t WS_WIN3  = WS_WIN2 + (size_t)5632 * 2048 * 2;
constexpr size_t WS_WOUT  = WS_WIN3 + (size_t)4608 * 2048 * 2;
constexpr size_t WS_WMEM  = WS_WOUT + (size_t)4 * 2048 * 2048 * 2;
constexpr size_t WS_HB    = WS_WMEM + (size_t)1024 * 2048 * 2;
constexpr size_t WS_PROJ  = WS_HB + (size_t)MTOK * 2048 * 2;
constexpr size_t WS_MEMB  = WS_PROJ + (size_t)MTOK * LDP * 2;
constexpr size_t WS_MKV   = WS_MEMB + (size_t)1024 * 2048 * 2;
constexpr size_t WS_RSS   = WS_MKV + (size_t)1024 * 1024 * 2;
constexpr size_t WS_RSSM  = WS_RSS + (size_t)5 * MTOK * 4;
constexpr size_t WS_ROPEA = WS_RSSM + 4096;
constexpr size_t WS_ROPEB = WS_ROPEA + (size_t)MTOK * 16 * 4;
constexpr size_t WS_ROPEC = WS_ROPEB + (size_t)MTOK * 32 * 4;
constexpr size_t WS_KMEAN = WS_ROPEC + (size_t)MTOK * 128 * 4;
constexpr size_t WS_RPREV = WS_KMEAN + (size_t)4 * 12 * 16 * 128 * 4;
constexpr size_t WS_END   = WS_RPREV + (size_t)4 * 32 * 6 * 256 * 128 * 2;

__constant__ double INVF[88] = {
 1.0, 0.19392274474868576, 0.03760603093086393, 0.007292664737217109, 0.001414213562373095, 0.0002742481756762073, 5.318295896944988e-05, 1.031338537721246e-05,
 1.0, 0.44036660267178046, 0.19392274474868576, 0.08539710028576561, 0.03760603093086393, 0.016560440080994446, 0.007292664737217109, 0.003211445994752591, 0.001414213562373095, 0.000622772421914596, 0.0002742481756762073, 0.00012076973741146504, 5.318295896944988e-05, 2.341999896140934e-05, 1.031338537721246e-05, 4.5416704806078695e-06,
 1.0, 0.8659643233600653, 0.7498942093324559, 0.6493816315762113, 0.5623413251903491, 0.4869675251658631, 0.4216965034285822, 0.3651741272548377, 0.31622776601683794, 0.27384196342643613, 0.23713737056616552, 0.2053525026457146, 0.1778279410038923, 0.1539926526059492, 0.1333521432163324, 0.11547819846894582, 0.1, 0.08659643233600653, 0.07498942093324558, 0.06493816315762113, 0.05623413251903491, 0.04869675251658631, 0.042169650342858224, 0.03651741272548377, 0.03162277660168379, 0.027384196342643614, 0.023713737056616554, 0.02053525026457146, 0.01778279410038923, 0.01539926526059492, 0.01333521432163324, 0.011547819846894581, 0.01, 0.008659643233600654, 0.007498942093324558, 0.006493816315762113, 0.005623413251903491, 0.004869675251658631, 0.004216965034285823, 0.003651741272548377, 0.0031622776601683794, 0.0027384196342643613, 0.0023713737056616554, 0.002053525026457146, 0.0017782794100389228, 0.001539926526059492, 0.001333521432163324, 0.0011547819846894581, 0.001, 0.0008659643233600654, 0.0007498942093324559, 0.0006493816315762113, 0.0005623413251903491, 0.0004869675251658631, 0.00042169650342858224, 0.0003651741272548377, 0.00031622776601683794, 0.0002738419634264361, 0.00023713737056616554, 0.0002053525026457146, 0.00017782794100389227, 0.0001539926526059492, 0.0001333521432163324, 0.00011547819846894582 };
__device__ __forceinline__ float log2gamma(int h) {
    return h == 0 ? -0.04580368961312479f : h == 1 ? -0.02612928206836121f : h == 2 ? -0.014949433599796901f : h == 3 ? -0.008567249848519122f : h == 4 ? -0.004914372264518986f : -0.002820519062378663f;
}

#define LDS_WAIT() asm volatile("s_waitcnt lgkmcnt(0)" ::: "memory")
__device__ __forceinline__ unsigned f2bf(float f) { unsigned u = __builtin_bit_cast(unsigned, f); return (u + 0x7fffu + ((u >> 16) & 1u)) >> 16; }
__device__ __forceinline__ unsigned pk2(float lo, float hi) { return f2bf(lo) | (f2bf(hi) << 16); }
__device__ __forceinline__ float bflo(unsigned w) { return __builtin_bit_cast(float, w << 16); }
__device__ __forceinline__ float bfhi(unsigned w) { return __builtin_bit_cast(float, w & 0xffff0000u); }
__device__ __forceinline__ float wave_sum(float v) {
#pragma unroll
    for (int o = 1; o < 64; o <<= 1) v += __shfl_xor(v, o);
    return v;
}
__device__ __forceinline__ float fexp2(float x) { return __builtin_amdgcn_exp2f(x); }
__device__ __forceinline__ s16x4 vtr(const LAS unsigned char* p) { return __builtin_bit_cast(s16x4, __builtin_amdgcn_ds_read_tr16_b64_v4i16((LAS s16x4*)p)); }
__device__ __forceinline__ bf16x8 cat8(s16x4 a, s16x4 b) { bf16x8 r; r[0] = a[0]; r[1] = a[1]; r[2] = a[2]; r[3] = a[3]; r[4] = b[0]; r[5] = b[1]; r[6] = b[2]; r[7] = b[3]; return r; }
typedef float f32x2_t __attribute__((ext_vector_type(2)));
typedef __bf16 bf16x2_t __attribute__((ext_vector_type(2)));
__device__ __forceinline__ unsigned cvtpk(float lo, float hi) { f32x2_t v = {lo, hi}; bf16x2_t b = __builtin_convertvector(v, bf16x2_t); return __builtin_bit_cast(unsigned, b); }
__device__ __forceinline__ float xmax16(float x) { const auto r = __builtin_amdgcn_permlane16_swap(__builtin_bit_cast(unsigned, x), __builtin_bit_cast(unsigned, x), false, false); return fmaxf(__builtin_bit_cast(float, r[0]), __builtin_bit_cast(float, r[1])); }
__device__ __forceinline__ float xmax32(float x) { const auto r = __builtin_amdgcn_permlane32_swap(__builtin_bit_cast(unsigned, x), __builtin_bit_cast(unsigned, x), false, false); return fmaxf(__builtin_bit_cast(float, r[0]), __builtin_bit_cast(float, r[1])); }
__device__ __forceinline__ bf16x8 pack8s(f32x4 a, f32x4 b) { u32x4 w; w.x = cvtpk(a[0], a[1]); w.y = cvtpk(a[2], a[3]); w.z = cvtpk(b[0], b[1]); w.w = cvtpk(b[2], b[3]); return __builtin_bit_cast(bf16x8, w); }
__device__ __forceinline__ bf16x8 pack8(f32x4 a, f32x4 b) { u32x4 w; w.x = cvt_pk_bf16(a[0], a[1]); w.y = cvt_pk_bf16(a[2], a[3]); w.z = cvt_pk_bf16(b[0], b[1]); w.w = cvt_pk_bf16(b[2], b[3]); return __builtin_bit_cast(bf16x8, w); }
__device__ __forceinline__ float silu_mul(float o, float z) { return o * z * __builtin_amdgcn_rcpf(1.0f + fexp2(-1.4426950408889634f * z)); }

__device__ __forceinline__ void transpose_item(const float* W, int N, int mid, const float* gvec, bf16_t* WT, int nblk, int item, int lane, LAS float* scr) {
    const int kb = item / nblk, nb = item % nblk, k0 = 64 * kb, n0 = 64 * nb;
    const int c4 = lane & 15, r4 = lane >> 4, j = n0 + 4 * c4;
    const int sc = (mid < 0) ? j : pg8::src_col(mid, j);
    f32x4 v[16];
#pragma unroll
    for (int i = 0; i < 16; ++i) { v[i] = (f32x4){0.f, 0.f, 0.f, 0.f}; if (sc >= 0) v[i] = *(const GAS f32x4*)(W + (size_t)(k0 + 4 * i + r4) * N + sc); }
#pragma unroll
    for (int i = 0; i < 16; ++i) { const int kk = 4 * i + r4; const float gk = gvec ? gvec[k0 + kk] : 1.0f; LAS float* d = scr + kk * 65 + 4 * c4;
        d[0] = v[i][0] * gk; d[1] = v[i][1] * gk; d[2] = v[i][2] * gk; d[3] = v[i][3] * gk; }
    LDS_WAIT(); asm volatile("" ::: "memory");
    const int c = lane & 7;
#pragma unroll
    for (int jj = 0; jj < 8; ++jj) { const int n = (lane >> 3) + 8 * jj; const LAS float* sp = scr + (8 * c) * 65 + n;
        u32x4 o; o.x = pk2(sp[0 * 65], sp[1 * 65]); o.y = pk2(sp[2 * 65], sp[3 * 65]); o.z = pk2(sp[4 * 65], sp[5 * 65]); o.w = pk2(sp[6 * 65], sp[7 * 65]);
        *(GAS u32x4*)(WT + (size_t)(n0 + n) * 2048 + k0 + 8 * c) = o; }
    LDS_WAIT(); asm volatile("" ::: "memory");
}
__device__ __forceinline__ void row_to_bf16(const float* xrow, bf16_t* orow, float* rss, int lane) {
    const f32x4* xr = (const f32x4*)xrow + lane; float s = 0.f;
    GAS u32x2* o8 = (GAS u32x2*)orow + lane;
#pragma unroll
    for (int j = 0; j < 8; ++j) { const f32x4 v = xr[64 * j]; s += (v.x * v.x + v.y * v.y) + (v.z * v.z + v.w * v.w);
        u32x2 w; w.x = pk2(v.x, v.y); w.y = pk2(v.z, v.w); o8[64 * j] = w; }
    s = wave_sum(s);
    if (lane == 0) *(GAS float*)rss = s;
}

enum { MODE_SWA = 0, MODE_MOBA = 1, MODE_MEM = 2 };
template <int DH, int MODE>
__device__ __forceinline__ void attn_unit(LAS unsigned char* lds, int tid, int wid, int lane,
        const bf16_t* Q,
        int qrow0,
        const bf16_t* Kb, const bf16_t* Vb, int ldkv,
        int nt, int krow_a, int krow_b,
        float m_init, float l_init, unsigned sel0, unsigned sel1,
        bf16_t* Zy,
        bool dry = false)
{
    asm volatile("" : "+v"(tid), "+v"(lane)); asm volatile("" : "+s"(wid));
    constexpr int KSTR = DH * 2 + 16, VSTR = DH * 2 + 32, KBYTES = 64 * KSTR, VBYTES = 64 * VSTR, STG = KBYTES + VBYTES;
    constexpr int CPR = DH / 8  , CPT = (64 * CPR) / NTHREADS  ;
    constexpr int NK = DH / 32, NDB = DH / 16;
    const int g = lane >> 4, l15 = lane & 15, q4 = l15 >> 2, p4 = l15 & 3;
    bf16x8 Qf[2][NK];
#pragma unroll
    for (int j = 0; j < 2; ++j)
#pragma unroll
        for (int k = 0; k < NK; ++k) Qf[j][k] = *(const GAS bf16x8*)(Q + (size_t)(qrow0 + j * 16 + l15) * LDP + k * 32 + g * 8);
    f32x4 O[NDB][2];
#pragma unroll
    for (int db = 0; db < NDB; ++db) { O[db][0] = (f32x4){0.f, 0.f, 0.f, 0.f}; O[db][1] = (f32x4){0.f, 0.f, 0.f, 0.f}; }
    const float m0 = (MODE == MODE_SWA) ? m_init : 0.f;
    float mrow[2] = {m0, m0}, lrow[2] = {g == 0 ? l_init : 0.f, g == 0 ? l_init : 0.f};
    bool first = (MODE != MODE_SWA);
    const unsigned sel[2] = {sel0, sel1};

    u32x4 kreg[2][CPT], vreg[2][CPT];
#define ATT_KROW(it) ((MODE == MODE_MOBA && (it) >= 4) ? (krow_b + 64 * ((it) - 4)) : (krow_a + 64 * (it)))
#define ATT_ISSUE(hf_, it) do { const int kr_ = ATT_KROW(it); _Pragma("unroll") for (int i_ = 0; i_ < CPT; ++i_) { const int c_ = tid + NTHREADS * i_, r_ = c_ / CPR, cc_ = c_ % CPR; \
        kreg[hf_][i_] = *(const GAS u32x4*)(Kb + (size_t)(kr_ + r_) * ldkv + cc_ * 8); vreg[hf_][i_] = *(const GAS u32x4*)(Vb + (size_t)(kr_ + r_) * ldkv + cc_ * 8); } } while (0)
    constexpr bool PF2 = false;
    ATT_ISSUE(0, 0);
    if (PF2 && nt > 1) ATT_ISSUE(1, 1);
    for (int it0 = 0; it0 < nt; it0 += 2) {
#pragma unroll
      for (int hf = 0; hf < 2; ++hf) {
        const int it = it0 + hf;
        if (it >= nt) break;
        LAS unsigned char* Kt = lds + hf * STG; LAS unsigned char* Vt = Kt + KBYTES;
#pragma unroll
        for (int i = 0; i < CPT; ++i) { const int c = tid + NTHREADS * i, r = c / CPR, cc = c % CPR;
            *(LAS u32x4*)(Kt + r * KSTR + cc * 16) = kreg[PF2 ? hf : 0][i]; *(LAS u32x4*)(Vt + r * VSTR + cc * 16) = vreg[PF2 ? hf : 0][i]; }
        if (PF2) { if (it + 2 < nt) ATT_ISSUE(hf, it + 2); } else { if (it + 1 < nt) ATT_ISSUE(0, it + 1); }
        __syncthreads();
        const int kp = ATT_KROW(it);
        bool active = true;
        if (MODE == MODE_SWA) active = !(kp > qrow0 + 31 || kp + 63 <= qrow0 - 128);
        if (MODE == MODE_MOBA) active = !(kp > qrow0 + 31);
        if (active) {
            f32x4 S[4][2];
            float sinit[2] = {-mrow[0], -mrow[1]};
            if (MODE == MODE_MOBA && it >= 4) {
                const int pb = (it - 4) >> 2;
                sinit[0] = ((sel[0] >> pb) & 1u) ? sinit[0] : -INFINITY; sinit[1] = ((sel[1] >> pb) & 1u) ? sinit[1] : -INFINITY;
            }
#pragma unroll
            for (int kb = 0; kb < 4; ++kb) { S[kb][0] = (f32x4){sinit[0], sinit[0], sinit[0], sinit[0]}; S[kb][1] = (f32x4){sinit[1], sinit[1], sinit[1], sinit[1]}; }
#pragma unroll
            for (int kb = 0; kb < 4; ++kb) {
#pragma unroll
                for (int k = 0; k < NK; ++k) {
                    const bf16x8 a = *(const LAS bf16x8*)(Kt + (kb * 16 + l15) * KSTR + (k * 32 + g * 8) * 2);
                    S[kb][0] = __builtin_amdgcn_mfma_f32_16x16x32_bf16(a, Qf[0][k], S[kb][0], 0, 0, 0);
                    S[kb][1] = __builtin_amdgcn_mfma_f32_16x16x32_bf16(a, Qf[1][k], S[kb][1], 0, 0, 0);
                }
                if (kb & 1) __builtin_amdgcn_sched_barrier(0);
            }
            bf16x8 Pb[2][2];
#pragma unroll
            for (int j = 0; j < 2; ++j) {
                const int qi = qrow0 + j * 16 + l15;
                if (MODE == MODE_SWA) {
                    if (!(kp + 63 <= qrow0 && kp > qrow0 + 31 - 128)) {
                        const unsigned dbase = (unsigned)(qi - kp - 4 * g);
#pragma unroll
                        for (int kb = 0; kb < 4; ++kb)
#pragma unroll
                            for (int i = 0; i < 4; ++i) S[kb][j][i] = ((dbase - (unsigned)(kb * 16 + i)) < 128u) ? S[kb][j][i] : -INFINITY;
                    }
                } else if (MODE == MODE_MOBA) {
                    if (kp + 63 > qrow0) {
#pragma unroll
                        for (int kb = 0; kb < 4; ++kb)
#pragma unroll
                            for (int i = 0; i < 4; ++i) S[kb][j][i] = ((qi - kp - 4 * g) >= (kb * 16 + i)) ? S[kb][j][i] : -INFINITY;
                    }
                }
                float mx = -INFINITY;
#pragma unroll
                for (int kb = 0; kb < 4; ++kb) mx = fmaxf(mx, fmaxf(fmaxf(S[kb][j][0], S[kb][j][1]), fmaxf(S[kb][j][2], S[kb][j][3])));
                mx = xmax16(mx); mx = xmax32(mx);
                const bool need = (first && mx > -INFINITY) || (mx > 8.0f);
                if (__builtin_amdgcn_ballot_w64(need) != 0ull) {
                    const float dlt = need ? mx : 0.f, alpha = fexp2(-dlt);
#pragma unroll
                    for (int kb = 0; kb < 4; ++kb) S[kb][j] = S[kb][j] - dlt;
                    mrow[j] += dlt; lrow[j] *= alpha;
#pragma unroll
                    for (int db = 0; db < NDB; ++db) O[db][j] = O[db][j] * alpha;
                }
                float ps = 0.f;
#pragma unroll
                for (int kb = 0; kb < 4; ++kb)
#pragma unroll
                    for (int i = 0; i < 4; ++i) { const float p = fexp2(S[kb][j][i]); S[kb][j][i] = p; ps += p; }
                lrow[j] += ps;
                Pb[j][0] = pack8s(S[0][j], S[1][j]); Pb[j][1] = pack8s(S[2][j], S[3][j]);
            }
#pragma unroll
            for (int s = 0; s < 2; ++s)
#pragma unroll
                for (int db = 0; db < NDB; ++db) {
                    const s16x4 lo = vtr(Vt + (32 * s + 4 * g + q4) * VSTR + (16 * db + 4 * p4) * 2);
                    const s16x4 hi = vtr(Vt + (32 * s + 16 + 4 * g + q4) * VSTR + (16 * db + 4 * p4) * 2);
                    const bf16x8 a = cat8(lo, hi);
                    O[db][0] = __builtin_amdgcn_mfma_f32_16x16x32_bf16(a, Pb[0][s], O[db][0], 0, 0, 0);
                    O[db][1] = __builtin_amdgcn_mfma_f32_16x16x32_bf16(a, Pb[1][s], O[db][1], 0, 0, 0);
                    if ((db & 3) == 3) __builtin_amdgcn_sched_barrier(0);
                }
            first = false;
        }
      }
    }
#undef ATT_ISSUE
#undef ATT_KROW
#pragma unroll
    for (int j = 0; j < 2; ++j) {
        float l = lrow[j]; l += __shfl_xor(l, 16); l += __shfl_xor(l, 32);
        const float inv = 1.0f / l;
        bf16_t* zp = Zy + (size_t)(qrow0 + j * 16 + l15) * LDP + 4 * g;
#pragma unroll
        for (int db = 0; db < NDB; ++db) {
            const u32x2 z = *(const GAS u32x2*)(zp + 16 * db);
            const f32x4 o = O[db][j] * inv;
            u32x2 w; w.x = cvt_pk_bf16(silu_mul(o[0], bflo(z.x)), silu_mul(o[1], bfhi(z.x))); w.y = cvt_pk_bf16(silu_mul(o[2], bflo(z.y)), silu_mul(o[3], bfhi(z.y)));
            if (!dry) *(GAS u32x2*)(zp + 16 * db) = w;
        }
    }
    __syncthreads();
}

__device__ __forceinline__ void moba_gate(LAS unsigned char* lds, int tid, const bf16_t* proj, const float* kmean, int b, int h, int qb) {
    asm volatile("" : "+v"(tid));
    LAS float* km = (LAS float*)lds;
    LAS unsigned* selm = (LAS unsigned*)(lds + LDS_MISC - 2048);
    for (int i = tid; i < 16 * 128; i += NTHREADS) km[i] = *((const GAS float*)kmean + (size_t)((b * 12 + h) * 16) * 128 + i);
    __syncthreads();
    const int q = tid >> 1, half = tid & 1;
    const bf16_t* qp = proj + (size_t)(b * SEQ + qb * 256 + q) * LDP + h * 128 + half * 64;
    float gsc[15];
#pragma unroll
    for (int n = 0; n < 15; ++n) gsc[n] = 0.f;
#pragma unroll 1
    for (int c = 0; c < 8; ++c) {
        const u32x4 w = *(const GAS u32x4*)(qp + c * 8);
        float qv[8] = {bflo(w.x), bfhi(w.x), bflo(w.y), bfhi(w.y), bflo(w.z), bfhi(w.z), bflo(w.w), bfhi(w.w)};
#pragma unroll
        for (int n = 0; n < 15; ++n) if (n < qb) {
            const LAS float* kr = km + n * 128 + half * 64 + c * 8;
#pragma unroll
            for (int e = 0; e < 8; ++e) gsc[n] += qv[e] * kr[e];
        }
    }
    unsigned mask = 0u;
#pragma unroll
    for (int n = 0; n < 15; ++n) { gsc[n] += __shfl_xor(gsc[n], 1); if (n >= qb) gsc[n] = -INFINITY; }
#pragma unroll
    for (int r = 0; r < 3; ++r) {
        float best = -INFINITY; int bi = -1;
#pragma unroll
        for (int n = 0; n < 15; ++n) { const bool taken = (mask >> n) & 1u; if (!taken && gsc[n] > best) { best = gsc[n]; bi = n; } }
        if (bi >= 0) mask |= 1u << bi;
    }
    if (half == 0) selm[q] = mask;
    __syncthreads();
}

__device__ __forceinline__ void kmean_unit(LAS unsigned char* lds, int tid, const bf16_t* proj, float* kmean, int u) {
    asm volatile("" : "+v"(tid));
    const int blk = u & 15, bh = u >> 4, b = bh / 12, h = bh % 12;
    const int cc = tid & 15, kg = tid >> 4;
    float s[8] = {0.f, 0.f, 0.f, 0.f, 0.f, 0.f, 0.f, 0.f};
    const bf16_t* kp = proj + (size_t)(b * SEQ + blk * 256 + kg * 8) * LDP + 1536 + h * 128 + cc * 8;
#pragma unroll
    for (int r = 0; r < 8; ++r) { const u32x4 w = *(const GAS u32x4*)(kp + (size_t)r * LDP);
        s[0] += bflo(w.x); s[1] += bfhi(w.x); s[2] += bflo(w.y); s[3] += bfhi(w.y); s[4] += bflo(w.z); s[5] += bfhi(w.z); s[6] += bflo(w.w); s[7] += bfhi(w.w); }
    LAS float* red = (LAS float*)lds;
#pragma unroll
    for (int e = 0; e < 8; ++e) red[kg * 128 + cc * 8 + e] = s[e];
    __syncthreads();
    if (tid < 128) { float a = 0.f;
#pragma unroll 8
        for (int k = 0; k < 32; ++k) a += red[k * 128 + tid];
        *((GAS float*)kmean + (size_t)u * 128 + tid) = a * (1.0f / 256.0f); }
    __syncthreads();
}

__device__ __forceinline__ void ret_scan_item(LAS unsigned char* lds, int tid, int wid, int lane, const bf16_t* proj, bf16_t* rprev, int item) {
    asm volatile("" : "+v"(tid), "+v"(lane)); asm volatile("" : "+s"(wid));
    constexpr int KS = 288, VS = 96, KB = 128 * KS, STG = KB + 128 * VS;
    const int es = item & 7, bh = item >> 3, b = bh / 6, h = bh % 6;
    const float lg = log2gamma(h), gchunk = fexp2(128.f * lg);
    const int g = lane >> 4, l15 = lane & 15, q4 = l15 >> 2, p4 = l15 & 3;
    const bf16_t* kbase = proj + (size_t)(b * SEQ) * LDP + 768 + h * 128;
    const bf16_t* vbase = proj + (size_t)(b * SEQ) * LDP + 1536 + h * 256 + es * 32;
    f32x4 R[2] = {(f32x4){0.f, 0.f, 0.f, 0.f}, (f32x4){0.f, 0.f, 0.f, 0.f}};
    u32x4 kreg[4], vreg;
#define RS_ISSUE(n) do { _Pragma("unroll") for (int i_ = 0; i_ < 4; ++i_) { const int c_ = tid + NTHREADS * i_; kreg[i_] = *(const GAS u32x4*)(kbase + (size_t)((n) * 128 + (c_ >> 4)) * LDP + (c_ & 15) * 8); } \
        vreg = *(const GAS u32x4*)(vbase + (size_t)((n) * 128 + (tid >> 2)) * LDP + (tid & 3) * 8); } while (0)
    RS_ISSUE(0);
    for (int n = 0; n < 32; ++n) {
        bf16_t* rp = rprev + ((size_t)((b * 32 + n) * 6 + h) * 256 + es * 32 + l15) * 128 + wid * 16 + 4 * g;
#pragma unroll
        for (int eb = 0; eb < 2; ++eb) { u32x2 w; w.x = cvt_pk_bf16(R[eb][0], R[eb][1]); w.y = cvt_pk_bf16(R[eb][2], R[eb][3]); *(GAS u32x2*)(rp + (size_t)eb * 16 * 128) = w; }
        if (n == 31) break;
        LAS unsigned char* Kt = lds + (n & 1) * STG; LAS unsigned char* Vt = Kt + KB;
#pragma unroll
        for (int i = 0; i < 4; ++i) { const int c = tid + NTHREADS * i, t = c >> 4, cc = c & 15;
            const float zt = fexp2((float)(127 - t) * lg);
            const u32x4 w = kreg[i]; u32x4 o;
            o.x = cvt_pk_bf16(bflo(w.x) * zt, bfhi(w.x) * zt); o.y = cvt_pk_bf16(bflo(w.y) * zt, bfhi(w.y) * zt); o.z = cvt_pk_bf16(bflo(w.z) * zt, bfhi(w.z) * zt); o.w = cvt_pk_bf16(bflo(w.w) * zt, bfhi(w.w) * zt);
            *(LAS u32x4*)(Kt + t * KS + cc * 16) = o; }
        *(LAS u32x4*)(Vt + (tid >> 2) * VS + (tid & 3) * 16) = vreg;
        __syncthreads();
        if (n + 1 < 31) RS_ISSUE(n + 1);
        R[0] = R[0] * gchunk; R[1] = R[1] * gchunk;
#pragma unroll
        for (int s = 0; s < 4; ++s) {
            const bf16x8 a = cat8(vtr(Kt + (32 * s + 8 * g + q4) * KS + (16 * wid + 4 * p4) * 2), vtr(Kt + (32 * s + 8 * g + 4 + q4) * KS + (16 * wid + 4 * p4) * 2));
#pragma unroll
            for (int eb = 0; eb < 2; ++eb) {
                const bf16x8 bb = cat8(vtr(Vt + (32 * s + 8 * g + q4) * VS + (16 * eb + 4 * p4) * 2), vtr(Vt + (32 * s + 8 * g + 4 + q4) * VS + (16 * eb + 4 * p4) * 2));
                R[eb] = __builtin_amdgcn_mfma_f32_16x16x32_bf16(a, bb, R[eb], 0, 0, 0);
            }
        }
    }
#undef RS_ISSUE
    __syncthreads();
}

__device__ __forceinline__ void ret_out_unit(LAS unsigned char* lds, int tid, int wid, int lane, bf16_t* proj, const bf16_t* rprev, int u, bool dry = false) {
    asm volatile("" : "+v"(tid), "+v"(lane)); asm volatile("" : "+s"(wid));
    constexpr int KS = 272, VS = 544, KB = 128 * KS;
    const int h = u % 6, bn = u / 6, n = bn & 31, b = bn >> 5;
    const float lg = log2gamma(h);
    const int g = lane >> 4, l15 = lane & 15, q4 = l15 >> 2, p4 = l15 & 3;
    const int row0 = b * SEQ + n * 128;
    LAS unsigned char* Kt = lds; LAS unsigned char* Vt = lds + KB;
    const bf16_t* kbase = proj + (size_t)row0 * LDP + 768 + h * 128;
    const bf16_t* vbase = proj + (size_t)row0 * LDP + 1536 + h * 256;
#pragma unroll
    for (int i = 0; i < 4; ++i) { const int c = tid + NTHREADS * i, t = c >> 4, cc = c & 15; *(LAS u32x4*)(Kt + t * KS + cc * 16) = *(const GAS u32x4*)(kbase + (size_t)t * LDP + cc * 8); }
#pragma unroll
    for (int i = 0; i < 8; ++i) { const int c = tid + NTHREADS * i, t = c >> 5, cc = c & 31; *(LAS u32x4*)(Vt + t * VS + cc * 16) = *(const GAS u32x4*)(vbase + (size_t)t * LDP + cc * 8); }
    const int qrow = row0 + wid * 16 + l15;
    bf16x8 Qf[4];
#pragma unroll
    for (int k = 0; k < 4; ++k) Qf[k] = *(const GAS bf16x8*)(proj + (size_t)qrow * LDP + h * 128 + k * 32 + g * 8);
    u32x4 rreg[8];
    const bf16_t* rbase = rprev + (size_t)((b * 32 + n) * 6 + h) * 256 * 128;
#pragma unroll
    for (int i = 0; i < 8; ++i) { const int c = tid + NTHREADS * i; rreg[i] = *(const GAS u32x4*)(rbase + (size_t)c * 8); }
    __syncthreads();
    f32x4 S[8];
#pragma unroll
    for (int kb = 0; kb < 8; ++kb) S[kb] = (f32x4){0.f, 0.f, 0.f, 0.f};
#pragma unroll
    for (int kb = 0; kb < 8; ++kb) if (kb <= wid) {
#pragma unroll
        for (int k = 0; k < 4; ++k) {
            const bf16x8 a = *(const LAS bf16x8*)(Kt + (kb * 16 + l15) * KS + (k * 32 + g * 8) * 2);
            S[kb] = __builtin_amdgcn_mfma_f32_16x16x32_bf16(a, Qf[k], S[kb], 0, 0, 0);
        }
    }
    const int tq = wid * 16 + l15;
    bf16x8 Pb[4];
#pragma unroll
    for (int kb = 0; kb < 8; ++kb)
#pragma unroll
        for (int i = 0; i < 4; ++i) { const int tk = kb * 16 + 4 * g + i; S[kb][i] = (tk <= tq) ? S[kb][i] * fexp2(-(float)(tk + 1) * lg) : 0.f; }
#pragma unroll
    for (int s = 0; s < 4; ++s) Pb[s] = pack8(S[2 * s], S[2 * s + 1]);
    f32x4 O[16];
#pragma unroll
    for (int eb = 0; eb < 16; ++eb) O[eb] = (f32x4){0.f, 0.f, 0.f, 0.f};
#pragma unroll
    for (int s = 0; s < 4; ++s) if (2 * s <= wid) {
#pragma unroll
        for (int eb = 0; eb < 16; ++eb) {
            const bf16x8 a = cat8(vtr(Vt + (32 * s + 4 * g + q4) * VS + (16 * eb + 4 * p4) * 2), vtr(Vt + (32 * s + 16 + 4 * g + q4) * VS + (16 * eb + 4 * p4) * 2));
            O[eb] = __builtin_amdgcn_mfma_f32_16x16x32_bf16(a, Pb[s], O[eb], 0, 0, 0);
        }
    }
    __syncthreads();
#pragma unroll
    for (int i = 0; i < 8; ++i) { const int c = tid + NTHREADS * i; *(LAS u32x4*)(Vt + (c >> 4) * KS + (c & 15) * 16) = rreg[i]; }
    __syncthreads();
#pragma unroll
    for (int eb = 0; eb < 16; ++eb)
#pragma unroll
        for (int k = 0; k < 4; ++k) {
            const bf16x8 a = *(const LAS bf16x8*)(Vt + (eb * 16 + l15) * KS + (k * 32 + g * 8) * 2);
            O[eb] = __builtin_amdgcn_mfma_f32_16x16x32_bf16(a, Qf[k], O[eb], 0, 0, 0);
        }
    const float xi = fexp2((float)(tq + 1) * lg);
    float ss = 0.f;
#pragma unroll
    for (int eb = 0; eb < 16; ++eb) { O[eb] = O[eb] * xi; ss += (O[eb][0] * O[eb][0] + O[eb][1] * O[eb][1]) + (O[eb][2] * O[eb][2] + O[eb][3] * O[eb][3]); }
    ss += __shfl_xor(ss, 16); ss += __shfl_xor(ss, 32);
    const float rstd = __builtin_amdgcn_rsqf(ss * (1.0f / 256.0f) + EPSN);
    bf16_t* zp = proj + (size_t)qrow * LDP + 3584 + h * 256 + 4 * g;
#pragma unroll
    for (int eb = 0; eb < 16; ++eb) {
        const u32x2 z = *(const GAS u32x2*)(zp + 16 * eb);
        const f32x4 o = O[eb] * rstd;
        u32x2 w; w.x = cvt_pk_bf16(silu_mul(o[0], bflo(z.x)), silu_mul(o[1], bfhi(z.x))); w.y = cvt_pk_bf16(silu_mul(o[2], bflo(z.y)), silu_mul(o[3], bfhi(z.y)));
        if (!dry) *(GAS u32x2*)(zp + 16 * eb) = w;
    }
    __syncthreads();
}

#define XB_TMO      128
#define XB_XCNT(j)  (256  + 64 * (j))
#define XB_XSUB(j)  (1280 + 64 * (j))
#define XB_XGEN(j)  (2304 + 64 * (j))
#define XB_TOP      3328
#define XB_TOPGEN   3392
#define XCD_BAR_WORDS 3456
#define XB_SPIN_CAP (1u << 18)

__device__ __forceinline__ unsigned xb_ld(unsigned* p)              { return __hip_atomic_load(p, __ATOMIC_RELAXED, __HIP_MEMORY_SCOPE_AGENT); }
__device__ __forceinline__ unsigned xb_add(unsigned* p, unsigned v) { return __hip_atomic_fetch_add(p, v, __ATOMIC_RELAXED, __HIP_MEMORY_SCOPE_AGENT); }
__device__ __forceinline__ unsigned xb_xcc_id() { return (unsigned)__builtin_amdgcn_s_getreg((3 << 11) | 20) & 0xFu; }
#define XB_SPIN(cond, bar) do { unsigned _sp = 0; while (cond) { __builtin_amdgcn_s_sleep(1); \
    if ((++_sp & 255u) == 0u) { if (xb_ld(&(bar)[XB_TMO])) break; if (_sp > XB_SPIN_CAP) { atomicAdd(&(bar)[XB_TMO], 1u); break; } } } } while (0)

struct XcdBarrier {
    unsigned* bar; unsigned x;
    volatile LAS unsigned* st;
};

__device__ __forceinline__ XcdBarrier xcd_barrier_post(unsigned* bar, volatile LAS unsigned* st) {
    XcdBarrier b; b.bar = bar; b.x = xb_xcc_id(); b.st = st;
    if (threadIdx.x == 0) (void)xb_add(&bar[XB_XCNT(b.x)], 1u);
    return b;
}
__device__ __forceinline__ void xcd_barrier_complete(unsigned* bar, unsigned x, unsigned& nloc, unsigned& nx) {
    const unsigned G = gridDim.x * gridDim.y * gridDim.z;
    unsigned sum, cnt, mine, sp = 0u;
    for (;;) {
        sum = 0u; cnt = 0u; mine = 0u;
#pragma unroll
        for (unsigned j = 0; j < 16; ++j) { const unsigned c = xb_ld(&bar[XB_XCNT(j)]); sum += c; cnt += (c > 0u) ? 1u : 0u; mine = (j == x) ? c : mine; }
        if (sum == G) break;
        __builtin_amdgcn_s_sleep(1);
        if ((++sp & 255u) == 0u) { if (xb_ld(&bar[XB_TMO])) break; if (sp > XB_SPIN_CAP) { atomicAdd(&bar[XB_TMO], 1u); break; } }
    }
    nloc = mine > 0u ? mine : 1u; nx = cnt > 0u ? cnt : 1u;
}

__device__ __forceinline__ void xcd_barrier(const XcdBarrier& b) {
    asm volatile("s_waitcnt vmcnt(0)" ::: "memory");
    __syncthreads();
    if (threadIdx.x == 0) {
        unsigned* bar = b.bar;
        __builtin_amdgcn_s_waitcnt(0);
        unsigned nloc = b.st[0], nx = b.st[1];
        if (nloc == 0u) { xcd_barrier_complete(bar, b.x, nloc, nx); b.st[0] = nloc; b.st[1] = nx; }
        const unsigned old = xb_add(&bar[XB_XSUB(b.x)], 1u);
        const unsigned gen = old / nloc;
        if (old + 1u == (gen + 1u) * nloc) {
            __builtin_amdgcn_fence(__ATOMIC_RELEASE, "agent");
            asm volatile("s_waitcnt vmcnt(0)" ::: "memory");
            const unsigned og = xb_add(&bar[XB_TOP], 1u);
            const unsigned tg = og / nx;
            if (og + 1u == (tg + 1u) * nx) xb_add(&bar[XB_TOPGEN], 1u);
            else XB_SPIN(xb_ld(&bar[XB_TOPGEN]) == tg, bar);
            __builtin_amdgcn_fence(__ATOMIC_ACQUIRE, "agent");
            xb_add(&bar[XB_XGEN(b.x)], 1u);
            asm volatile("s_waitcnt vmcnt(0)" ::: "memory");
        } else {
            XB_SPIN(xb_ld(&bar[XB_XGEN(b.x)]) == gen, bar);
            __builtin_amdgcn_fence(__ATOMIC_ACQUIRE, "agent");
            asm volatile("s_waitcnt vmcnt(0)" ::: "memory");
        }
    }
    __syncthreads();
}


#define CONV_WEIGHTS(MASK, worker, nworkers) do { \
        int lane_ = lane, wid_ = wid; asm volatile("" : "+v"(lane_)); asm volatile("" : "+s"(wid_)); LAS float* scr_ = (LAS float*)(lds + wid_ * 16640); \
        int total_ = 0; \
        _Pragma("unroll 1") for (int mi_ = 0; mi_ < 9; ++mi_) if (((MASK) >> mi_) & 1u) total_ += 32 * (mi_ < 4 ? pg8::npad_of(mi_ == 3 ? 0 : mi_) / 64 : (mi_ < 8 ? 32 : 16)); \
        for (int it_ = (worker); it_ < total_; it_ += (nworkers)) { \
            int r_ = it_; \
            _Pragma("unroll 1") for (int mi = 0; mi < 9; ++mi) { \
                if (!(((MASK) >> mi) & 1u)) continue; \
                const float* W; int N, mid_, nblk; const float* gv; bf16_t* WT; \
                if (mi < 4) { const int l_ = mi; mid_ = l_ == 3 ? 0 : l_; N = pg8::nc_of(mid_); nblk = pg8::npad_of(mid_) / 64; \
                    W = args.in[l_ == 0 ? 6 : l_ == 1 ? 10 : l_ == 2 ? 13 : 16]; gv = args.in[l_ == 0 ? 5 : l_ == 1 ? 9 : l_ == 2 ? 12 : 15]; \
                    WT = (bf16_t*)(ws + (l_ == 0 ? WS_WIN0 : l_ == 1 ? WS_WIN1 : l_ == 2 ? WS_WIN2 : WS_WIN3)); } \
                else if (mi < 8) { const int l_ = mi - 4; mid_ = -1; N = 2048; nblk = 32; W = args.in[l_ == 0 ? 8 : l_ == 1 ? 11 : l_ == 2 ? 14 : 18]; gv = nullptr; WT = woutT + (size_t)l_ * 2048 * 2048; } \
                else { mid_ = -1; N = 1024; nblk = 16; W = args.in[4]; gv = args.in[3]; WT = wmemT; } \
                const int cnt_ = 32 * nblk; \
                if (r_ < cnt_) { transpose_item(W, N, mid_, gv, WT, nblk, r_, lane_, scr_); break; } \
                r_ -= cnt_; \
            } \
        } } while (0)

struct Args { const float* in[20]; float* out; unsigned char* ws; };

__device__ __forceinline__ int fetch_unit(unsigned* ctr, volatile LAS unsigned* slot, int tid) {
    if (tid == 0) *slot = atomicAdd(ctr, 1u);
    __syncthreads();
    const unsigned v = *slot;
    __syncthreads();
    return __builtin_amdgcn_readfirstlane((int)v);
}

__global__ void __launch_bounds__(NTHREADS, 2) trunk_fwd(Args args) {
    extern __shared__ __attribute__((aligned(16))) unsigned char lds_raw[];
    cg::grid_group grid = cg::this_grid();
    LAS unsigned char* lds = (LAS unsigned char*)lds_raw;
    volatile LAS unsigned* misc = (volatile LAS unsigned*)(lds + LDS_MISC);
    const int tid = threadIdx.x, lane = tid & 63, wid = __builtin_amdgcn_readfirstlane(tid >> 6);
    const int G = gridDim.x, bx = blockIdx.x;
#define WS_PTRS() unsigned char* ws = args.ws; asm volatile("" : "+s"(ws)); \
    unsigned* ctl = (unsigned*)(ws + WS_CTL); bf16_t* hb = (bf16_t*)(ws + WS_HB); bf16_t* proj = (bf16_t*)(ws + WS_PROJ); \
    bf16_t* memb = (bf16_t*)(ws + WS_MEMB); bf16_t* mkv = (bf16_t*)(ws + WS_MKV); float* rss = (float*)(ws + WS_RSS); float* rssm = (float*)(ws + WS_RSSM); \
    float* ropeA = (float*)(ws + WS_ROPEA); float* ropeB = (float*)(ws + WS_ROPEB); float* ropeC = (float*)(ws + WS_ROPEC); \
    float* kmean = (float*)(ws + WS_KMEAN); bf16_t* rprev = (bf16_t*)(ws + WS_RPREV); bf16_t* woutT = (bf16_t*)(ws + WS_WOUT); bf16_t* wmemT = (bf16_t*)(ws + WS_WMEM); \
    (void)ctl; (void)hb; (void)proj; (void)memb; (void)mkv; (void)rss; (void)rssm; (void)ropeA; (void)ropeB; (void)ropeC; (void)kmean; (void)rprev; (void)woutT; (void)wmemT
#ifndef REP_P0
#define REP_P0 1
#endif
    for (int rep0 = 0; rep0 < REP_P0; ++rep0) {
        if (rep0) grid.sync();
        WS_PTRS(); const float* x = args.in[0];
        const int gw = bx * NWAVES + wid, NGW = G * NWAVES;
        LAS float* scr = (LAS float*)(lds + wid * 16640);
        if (G == 256) CONV_WEIGHTS(0x111u, gw, NGW); else CONV_WEIGHTS(0x1FFu, gw, NGW);
        for (int m = gw; m < MTOK; m += NGW) row_to_bf16(x + (size_t)m * DMODEL, hb + (size_t)m * DMODEL, rss + m, lane);
        for (int m = gw; m < NB * NMEMTOK; m += NGW) row_to_bf16(args.in[1] + (size_t)m * DMODEL, memb + (size_t)m * DMODEL, rssm + m, lane);
        const int* positions = (const int*)args.in[2];
        const int gt = bx * NTHREADS + tid, NGT = G * NTHREADS;
        for (int i = gt; i < MTOK * 88; i += NGT) {
            const int tok = i / 88, f = i % 88;
            float* tb; int F, fl;
            if (f < 8) { tb = ropeA; F = 8; fl = f; } else if (f < 24) { tb = ropeB; F = 16; fl = f - 8; } else { tb = ropeC; F = 64; fl = f - 24; }
            const double rev = (double)positions[tok] * INVF[f] * 0.15915494309189535;
            const float fr = (float)(rev - __builtin_rint(rev));
            *((GAS float*)tb + (size_t)tok * 2 * F + fl) = __builtin_amdgcn_cosf(fr); *((GAS float*)tb + (size_t)tok * 2 * F + F + fl) = __builtin_amdgcn_sinf(fr);
        }
        for (int i = gt; i < 4 * MTOK; i += NGT) *((GAS float*)rss + MTOK + i) = 0.f;
        for (int i = gt; i < 4 * 12 * 16 * 128; i += NGT) *((GAS float*)kmean + i) = 0.f;
        if (bx == 0) for (int i = tid; i < 1024 + XCD_BAR_WORDS; i += NTHREADS) ctl[i] = 0u;
    }
    grid.sync();
    if (tid < 2) misc[8 + tid] = 0u;
    __syncthreads();
    XcdBarrier xbar;
    { unsigned char* ws0 = args.ws; xbar = xcd_barrier_post((unsigned*)(ws0 + WS_CTL) + 1024, misc + 8); }
#define GRID_SYNC() xcd_barrier(xbar)

    const float L2E = 1.4426950408889634f;
#pragma unroll 1
    for (int l = 0; l < 4; ++l) {
        const int mid = (l == 3) ? 0 : l;
        const int nmix = pg8::nmix_of(mid), zoff = nmix + 512;
#pragma unroll 1
#ifndef REP_P1
#define REP_P1 1
#endif
        for (int rep1 = 0; rep1 < REP_P1; ++rep1)
        for (int pass = 0; pass < (l == 0 ? 2 : 1); ++pass) {
            WS_PTRS();
            pg8::Gemm g; pg8::StaticOrder S; pg8::EpiIn E;
            if (pass == 0) {
                g.A = hb; g.Bt = (const bf16_t*)(ws + (l == 0 ? WS_WIN0 : l == 1 ? WS_WIN1 : l == 2 ? WS_WIN2 : WS_WIN3)); g.lda = DMODEL; g.K = DMODEL;
                S.init(MTOK, pg8::npad_of(mid), G, bx);
                E.O = proj; E.ldc = LDP; E.mid = mid; E.rss = rss + (size_t)l * MTOK; E.kmean = kmean;
            } else {
                g.A = memb; g.Bt = wmemT; g.lda = DMODEL; g.K = DMODEL;
                S.init(NB * NMEMTOK, 1024, 1 << 20, bx - (G == 256 ? 240 : 0));
                E.O = mkv; E.ldc = 1024; E.mid = 3; E.rss = rssm; E.kmean = kmean;
            }
            E.rope0 = ropeA;

#ifndef SK_P1
pg8::gemm_phase<pg8::EpiIn, pg8::StaticOrder, true, true>(lds, g, S, E);
#endif

            __syncthreads();
        }
        if (l == 0 && G == 256 && bx >= 128 && bx < 240) {
            WS_PTRS();
            CONV_WEIGHTS(0x066u, (bx - 128) * NWAVES + wid, 112 * NWAVES);
        } else if (l == 2 && G == 256 && bx >= 128) {
            WS_PTRS();
            CONV_WEIGHTS(0x088u, (bx - 128) * NWAVES + wid, 128 * NWAVES);
        }
        GRID_SYNC();

        const int nsub = (mid == 2) ? 2 : 1;
#pragma unroll 1
        for (int sub = 0; sub < nsub; ++sub) {
            int nA, nMem;
            if (mid == 0) { nA = 1536; nMem = 256; } else if (mid == 1) { nA = 96; nMem = 32; } else if (sub == 0) { nA = 192; nMem = 256; } else { nA = 768; nMem = 0; }
#ifndef REP_P2
#define REP_P2 1
#endif
#ifndef REP_MID
#define REP_MID mid
#endif
            const int nrep = (mid == (REP_MID)) ? REP_P2 : 1;
            for (int rep = 0; rep < nrep; ++rep) {
            const bool dry = rep < nrep - 1;
            WS_PTRS();
            unsigned* ctr = ctl + (l * 2 + sub) + 16 * rep;
            if (mid == 1) ctr = ctl + 128 + 64 * (bx & 7) + 16 * rep;
            int u = fetch_unit(ctr, misc, tid);
            if (mid == 0) {
                while (u < nA) {
                    const int hp = u & 3, n = (u >> 2) & 31, r = u >> 7, kvh = r % 3, b = r / 3;
                    const int head = kvh * 8 + hp * 2 + (wid >> 2);
                    const float sink = args.in[l == 0 ? 7 : 17][head] * L2E;
#ifndef SK_SWA
                    attn_unit<64, MODE_SWA>(lds, tid, wid, lane, proj + head * 64, b * SEQ + n * 128 + (wid & 3) * 32, proj + 1536 + kvh * 64, proj + 1728 + kvh * 64, LDP,
                                            n == 0 ? 2 : 4, b * SEQ + n * 128 - (n ? 128 : 0), 0, sink, 1.f, 0u, 0u, proj + zoff + head * 64, dry);
#endif
                    u = fetch_unit(ctr, misc, tid);
                }
            } else if (mid == 1) {
                while (u < nA) {
                    const int qb = 15 - u / 6, bh = (bx & 7) + 8 * (u % 6), b = bh / 12, h = bh % 12;
#ifndef SK_MOBA
                    moba_gate(lds, tid, proj, kmean, b, h, qb);
                    volatile LAS unsigned* selm = (volatile LAS unsigned*)(lds + LDS_MISC - 2048);
                    const unsigned s0 = selm[wid * 32 + (lane & 15)], s1 = selm[wid * 32 + 16 + (lane & 15)];
                    __syncthreads();
                    attn_unit<128, MODE_MOBA>(lds, tid, wid, lane, proj + h * 128, b * SEQ + qb * 256 + wid * 32, proj + 1536 + h * 128, proj + 3072 + h * 128, LDP,
                                              4 + 4 * qb, b * SEQ + qb * 256, b * SEQ, -1e30f, 0.f, s0, s1, proj + zoff + h * 128, dry);
#endif
                    u = fetch_unit(ctr, misc, tid);
                }
            } else if (sub == 0) {
                while (u < nA) {
#ifndef SK_SCAN
                    ret_scan_item(lds, tid, wid, lane, proj, rprev, u);
#endif
                    u = fetch_unit(ctr, misc, tid);
                }
            } else {
                while (u < nA) {
#ifndef SK_ROUT
                    ret_out_unit(lds, tid, wid, lane, proj, rprev, u, dry);
#endif
                    u = fetch_unit(ctr, misc, tid);
                }
            }
            while (u < nA + nMem) {
                const int v = (mid == 1) ? (bx & 7) + 8 * (u - nA) : (u - nA), hm = v & 3, qt = (v >> 2) & 15, b = v >> 6;
#ifndef SK_MEM
                attn_unit<128, MODE_MEM>(lds, tid, wid, lane, proj + nmix + hm * 128, b * SEQ + qt * 256 + wid * 32, mkv + hm * 128, mkv + 512 + hm * 128, 1024,
                                         4, b * NMEMTOK, 0, -1e30f, 0.f, 0u, 0u, proj + zoff + 1536 + hm * 128, dry);
#endif
                u = fetch_unit(ctr, misc, tid);
            }
            GRID_SYNC();
            }
        }

        {
            WS_PTRS(); const float* x = args.in[0]; float* out = args.out;
            pg8::Gemm g; g.A = proj + zoff; g.Bt = woutT + (size_t)l * 2048 * 2048; g.lda = LDP; g.K = DMODEL;
            pg8::StaticOrder S; S.init(MTOK, DMODEL, G, bx);
            pg8::EpiOut E; E.basef = x; E.out = out; E.hb = hb; E.rssn = rss + (size_t)(l + 1) * MTOK; E.mode = (l == 0) ? 0 : (l == 3 ? 2 : 1);

#ifndef SK_P3
pg8::gemm_phase<pg8::EpiOut, pg8::StaticOrder, true, true>(lds, g, S, E);
#endif

            __syncthreads();
        }
        GRID_SYNC();
    }

#ifdef EXTRA_SYNCS
    for (int i = 0; i < EXTRA_SYNCS; ++i) GRID_SYNC();
#endif
    {
        const int gw = bx * NWAVES + wid, NGW = G * NWAVES;
        WS_PTRS(); float* out = args.out;
        int lane_f = lane; asm volatile("" : "+v"(lane_f));
        const float* gf = args.in[19];
        for (int m = gw; m < MTOK; m += NGW) {
            const float s = __builtin_amdgcn_rsqf(*((const GAS float*)rss + 4 * MTOK + m) * (1.0f / DMODEL) + EPSN);
            f32x4* xr = (f32x4*)(out + (size_t)m * DMODEL) + lane_f; const f32x4* gr = (const f32x4*)gf + lane_f;
#pragma unroll
            for (int j = 0; j < 8; ++j) { const f32x4 v = xr[64 * j]; xr[64 * j] = v * s * gr[64 * j]; }
        }
    }
}

extern "C" void kernel_launch(void* const* d_in, const int* in_sizes, int n_in, void* d_out, int out_size, void* d_ws, size_t ws_size, hipStream_t stream) {
    static int grid = 0;
    if (grid == 0) {
        if (n_in != 20 || out_size != MTOK * DMODEL || ws_size < WS_END) { fprintf(stderr, "kernel_launch: unexpected shapes (n_in %d, out %d, ws %zu, need %zu)\n", n_in, out_size, ws_size, (size_t)WS_END); grid = -1; return; }
        int dev = 0, cus = 0, per_cu = 0;
        hipGetDevice(&dev); hipDeviceGetAttribute(&cus, hipDeviceAttributeMultiprocessorCount, dev);
        hipFuncSetAttribute((const void*)trunk_fwd, hipFuncAttributeMaxDynamicSharedMemorySize, LDS_BYTES);
        if (hipOccupancyMaxActiveBlocksPerMultiprocessor(&per_cu, (const void*)trunk_fwd, NTHREADS, LDS_BYTES) != hipSuccess || per_cu < 1) { fprintf(stderr, "kernel_launch: occupancy query gave %d\n", per_cu); per_cu = 1; }
        (void)hipGetLastError();
        grid = cus;
        if (grid != 256) fprintf(stderr, "kernel_launch: note: %d CUs\n", grid);
    }
    if (grid < 0) return;
    Args a{};
    for (int i = 0; i < 20; ++i) a.in[i] = (const float*)d_in[i];
    a.out = (float*)d_out; a.ws = (unsigned char*)d_ws;
    void* kargs[] = {&a};
    hipError_t e = hipLaunchCooperativeKernel((const void*)trunk_fwd, dim3(grid), dim3(NTHREADS), kargs, LDS_BYTES, stream);
    if (e != hipSuccess) fprintf(stderr, "cooperative launch failed: %s (grid %d)\n", hipGetErrorString(e), grid);
}
```

```cpp
#include <hip/hip_runtime.h>
#include <hip/hip_cooperative_groups.h>
#include <cstdio>
#include <cstdint>
namespace cg = cooperative_groups;
#define GAS __attribute__((address_space(1)))
namespace pg8 {
#define PG8_LAS __attribute__((address_space(3)))
typedef unsigned short bf16_t;
typedef short bf16x8 __attribute__((ext_vector_type(8)));
typedef float f32x4 __attribute__((ext_vector_type(4)));
typedef unsigned u32x4 __attribute__((ext_vector_type(4)));
constexpr int BM = 256, BK = 64, HALF = 128, HTB = HALF * BK * 2  , STAGE_BYTES = 8 * HTB, NXCD = 8, WGM = 4;

__host__ __device__ __forceinline__ int lds_byte(int r, int c) { const int st = (r >> 4) * 2 + (c >> 5), rr = r & 15, cc = c & 31, ob = rr * 64 + cc * 2; return st * 1024 + (ob ^ (((ob >> 9) & 1) << 5)); }
__host__ __device__ __forceinline__ void stage_rc(int b, int& R, int& C) { const int st = b / 1024, sb = b % 1024, swz = sb ^ (((sb >> 9) & 1) << 5); R = (st >> 1) * 16 + swz / 64; C = (st & 1) * 32 + (swz % 64) / 2; }
__host__ __device__ __forceinline__ int perm32(int rho) { const int n = rho >> 4, i = rho & 15; return 8 * (i >> 2) + 4 * n + (i & 3); }

struct Unit { int pm, pn; };
struct Gemm { const bf16_t* A; const bf16_t* Bt; int lda, K; };

struct StaticOrder {
    int nM, nN, nwg, G, c;
    __host__ __device__ void init(int M, int N, int G_, int c_) { nM = M / BM; nN = N / BM; nwg = nM * nN; G = G_; c = c_; }
    __host__ __device__ bool next(int i, Unit& u) const {
        const long L = (long)i * G + c; if (L >= nwg || c < 0) return false;
        int wgid = (int)L; { const int q = nwg / NXCD, r = nwg % NXCD, xcd = wgid % NXCD, off = wgid / NXCD; wgid = (xcd < r ? xcd * (q + 1) : r * (q + 1) + (xcd - r) * q) + off; }
        const int nig = WGM * nN, gid = wgid / nig, fm = gid * WGM, gsz = (nM - fm) < WGM ? (nM - fm) : WGM;
        u.pm = fm + ((wgid % nig) % gsz); u.pn = (wgid % nig) / gsz; return true;
    }
    __device__ __forceinline__ void a_ready(const Unit&) const {}
    __device__ __forceinline__ void done(const Unit&) const {}
};

__device__ __forceinline__ unsigned cvt_pk_bf16(float lo, float hi) { unsigned r; asm volatile("v_cvt_pk_bf16_f32 %0, %1, %2" : "=v"(r) : "v"(lo), "v"(hi)); return r; }
constexpr int NB = 4, SEQ = 4096, DMODEL = 2048, MTOK = NB * SEQ, NMEMTOK = 256, LDP = 7168;
constexpr float EPSN = 1e-6f;
__host__ __device__ constexpr int nc_of(int mid)   { return mid == 0 ? 4480 : (mid == 1 ? 7168 : 5632); }
__host__ __device__ constexpr int npad_of(int mid) { return mid == 0 ? 4608 : (mid == 1 ? 7168 : 5632); }
__host__ __device__ constexpr int nmix_of(int mid) { return mid == 0 ? 1920 : (mid == 1 ? 4608 : 3072); }

struct GDesc { int dst0, dst1, rope, rstr; float scale; };
__device__ __forceinline__ GDesc gdesc(int mid, int j0) {
    GDesc d; d.dst0 = j0; d.dst1 = j0 + 4; d.rope = -1; d.rstr = 0; d.scale = 1.f;
    const float L2E = 1.4426950408889634f, R128 = 0.08838834764831845f;
    if (mid == 0) {
        if (j0 >= 4480) { d.dst0 = -1; return d; }
        if (j0 < 1728) { const int hb = j0 & ~63, lg = (j0 & 63) >> 3;
            if (lg < 2) { d.dst0 = hb + 4 * lg; d.dst1 = hb + 8 + 4 * lg; d.rope = 4 * lg; d.rstr = 16; }
            if (j0 < 1536) d.scale = 0.125f * L2E; }
        else if (j0 >= 1920 && j0 < 2432) d.scale = R128 * L2E;
    } else if (mid == 1) {
        if (j0 < 3072) { const int hb = j0 & ~127, lg = (j0 & 127) >> 3;
            if (lg < 4) { d.dst0 = hb + 4 * lg; d.dst1 = hb + 16 + 4 * lg; d.rope = MTOK * 16 + 4 * lg; d.rstr = 32; }
            if (j0 < 1536) d.scale = R128 * L2E; }
        else if (j0 >= 4608 && j0 < 5120) d.scale = R128 * L2E;
    } else if (mid == 2) {
        if (j0 < 1536) { const int hb = j0 & ~127, lg = (j0 & 127) >> 3;
            d.dst0 = hb + 4 * lg; d.dst1 = hb + 64 + 4 * lg; d.rope = MTOK * 48 + 4 * lg; d.rstr = 128;
            if (j0 >= 768) d.scale = R128; }
        else if (j0 >= 3072 && j0 < 3584) d.scale = R128 * L2E;
    }
    return d;
}
__device__ __forceinline__ int src_col(int mid, int j) { const GDesc d = gdesc(mid, j & ~7); if (d.dst0 < 0) return -1; return (j & 4) ? d.dst1 + (j & 3) : d.dst0 + (j & 3); }

typedef unsigned u32x2 __attribute__((ext_vector_type(2)));
struct EpiIn {
    static constexpr bool PERM = true, AFTER_DRAIN = false;
    bf16_t* O; int ldc, mid; const float* rss; const float* rope0; float* kmean;
    __device__ __forceinline__ void operator()(const f32x4 (&acc)[2][2][4][2], const Unit& u, int wr, int wc, int fr, int fq) const {
        const int row0 = u.pm * BM + wr * 64 + fr;
        const bool ksum = (mid == 1) && (u.pn >= 6) && (u.pn < 12);
        float cs[2][8];
#pragma unroll
        for (int bj = 0; bj < 2; ++bj)
#pragma unroll
            for (int e = 0; e < 8; ++e) cs[bj][e] = 0.f;
        GDesc d[2];
#pragma unroll
        for (int bj = 0; bj < 2; ++bj) d[bj] = gdesc(mid, u.pn * BM + bj * HALF + wc * 32 + 8 * fq);
#pragma unroll
        for (int ai = 0; ai < 2; ++ai)
#pragma unroll
            for (int m = 0; m < 4; ++m) {
                const int r = row0 + ai * HALF + m * 16;
                const float s = __builtin_amdgcn_rsqf(*((const GAS float*)rss + r) * (1.0f / DMODEL) + EPSN);
                bf16_t* rowp = O + (size_t)r * ldc;
#pragma unroll
                for (int bj = 0; bj < 2; ++bj) {
                    if (d[bj].dst0 < 0) continue;
                    const float sc = s * d[bj].scale;
                    f32x4 v0 = acc[ai][bj][m][0] * sc, v1 = acc[ai][bj][m][1] * sc;
                    if (d[bj].rope >= 0) {
                        const float* t = rope0 + d[bj].rope + (size_t)r * d[bj].rstr; const int F = d[bj].rstr >> 1;
                        const f32x4 c = *(const GAS f32x4*)t, sn = *(const GAS f32x4*)(t + F);
                        const f32x4 n0 = v0 * c - v1 * sn, n1 = v1 * c + v0 * sn; v0 = n0; v1 = n1;
                    }
                    if (ksum) {
#pragma unroll
                        for (int e = 0; e < 4; ++e) { cs[bj][e] += v0[e]; cs[bj][4 + e] += v1[e]; }
                    }
                    u32x2 w0, w1; w0.x = cvt_pk_bf16(v0[0], v0[1]); w0.y = cvt_pk_bf16(v0[2], v0[3]); w1.x = cvt_pk_bf16(v1[0], v1[1]); w1.y = cvt_pk_bf16(v1[2], v1[3]);
                    if (d[bj].dst1 == d[bj].dst0 + 4) { u32x4 w; w.x = w0.x; w.y = w0.y; w.z = w1.x; w.w = w1.y; *(GAS u32x4*)(rowp + d[bj].dst0) = w; }
                    else { *(GAS u32x2*)(rowp + d[bj].dst0) = w0; *(GAS u32x2*)(rowp + d[bj].dst1) = w1; }
                }
            }
        if (ksum) {
            float* kb = kmean + (size_t)((u.pm >> 4) * 12 * 16 + (u.pm & 15)) * 128;
#pragma unroll
            for (int bj = 0; bj < 2; ++bj)
#pragma unroll
                for (int e = 0; e < 8; ++e) {
                    float v = cs[bj][e];
                    v += __shfl_xor(v, 1); v += __shfl_xor(v, 2); v += __shfl_xor(v, 4); v += __shfl_xor(v, 8);
                    const int col = ((e < 4) ? d[bj].dst0 + e : d[bj].dst1 + e - 4) - 1536, h = col >> 7, dd = col & 127;
                    if (fr == 0) (void)__hip_atomic_fetch_add((GAS float*)(kb + (size_t)h * 16 * 128 + dd), v * (1.0f / 256.0f), __ATOMIC_RELAXED, __HIP_MEMORY_SCOPE_AGENT);
                }
        }
    }
};
struct EpiOut {
    static constexpr bool PERM = true, AFTER_DRAIN = false;
    const float* basef; float* out; bf16_t* hb; float* rssn; int mode;
    __device__ __forceinline__ void operator()(const f32x4 (&acc)[2][2][4][2], const Unit& u, int wr, int wc, int fr, int fq) const {
        const int row0 = u.pm * BM + wr * 64 + fr, col0 = u.pn * BM + wc * 32 + 8 * fq;
#pragma unroll
        for (int ai = 0; ai < 2; ++ai)
#pragma unroll
            for (int m = 0; m < 4; ++m) {
                const int r = row0 + ai * HALF + m * 16; float ss = 0.f;
#pragma unroll
                for (int bj = 0; bj < 2; ++bj) {
                    const size_t off = (size_t)r * DMODEL + col0 + bj * HALF;
                    f32x4 b0, b1;
                    if (mode == 0) { b0 = *(const GAS f32x4*)(basef + off); b1 = *(const GAS f32x4*)(basef + off + 4); }
                    else { const u32x4 hw = *(const GAS u32x4*)(hb + off);
                        b0 = (f32x4){__builtin_bit_cast(float, hw.x << 16), __builtin_bit_cast(float, hw.x & 0xffff0000u), __builtin_bit_cast(float, hw.y << 16), __builtin_bit_cast(float, hw.y & 0xffff0000u)};
                        b1 = (f32x4){__builtin_bit_cast(float, hw.z << 16), __builtin_bit_cast(float, hw.z & 0xffff0000u), __builtin_bit_cast(float, hw.w << 16), __builtin_bit_cast(float, hw.w & 0xffff0000u)}; }
                    const f32x4 v0 = acc[ai][bj][m][0] + b0, v1 = acc[ai][bj][m][1] + b1;
                    if (mode == 2) { *(GAS f32x4*)(out + off) = v0; *(GAS f32x4*)(out + off + 4) = v1; }
                    else { u32x4 w; w.x = cvt_pk_bf16(v0[0], v0[1]); w.y = cvt_pk_bf16(v0[2], v0[3]); w.z = cvt_pk_bf16(v1[0], v1[1]); w.w = cvt_pk_bf16(v1[2], v1[3]);
                        *(GAS u32x4*)(hb + off) = w; }
                    ss += (v0[0] * v0[0] + v0[1] * v0[1]) + (v0[2] * v0[2] + v0[3] * v0[3]) + (v1[0] * v1[0] + v1[1] * v1[1]) + (v1[2] * v1[2] + v1[3] * v1[3]);
                }
                ss += __shfl_xor(ss, 16); ss += __shfl_xor(ss, 32);
                if (fq == 0) (void)__hip_atomic_fetch_add((GAS float*)(rssn + r), ss, __ATOMIC_RELAXED, __HIP_MEMORY_SCOPE_AGENT);
                if (m & 1) asm volatile("" ::: "memory");
            }
    }
};

template <class Epi, class Sched, bool ALIGN_EPI = false, bool SP2 = false>
__device__ __forceinline__ void gemm_phase(PG8_LAS unsigned char* lds, const Gemm g, const Sched& S, const Epi& E) {
    int tid_ = threadIdx.x; asm volatile("" : "+v"(tid_));
    const int tid = tid_, wid = __builtin_amdgcn_readfirstlane(tid >> 6), lane = tid & 63, wr = wid >> 2, wc = wid & 3, fr = lane & 15, fq = lane >> 4;
    const int K = g.K, nt = K / BK;
    unsigned voffA[2], voffB[2];
#pragma unroll
    for (int i = 0; i < 2; ++i) { int R, C; stage_rc(tid * 16 + i * 8192, R, C); const int Rb = Epi::PERM ? ((R & ~31) + perm32(R & 31)) : R;
        voffA[i] = (unsigned)(R * g.lda + C) * 2u; voffB[i] = (unsigned)(Rb * K + C) * 2u; }
    const size_t kstep = (size_t)(BK * 2);
    const size_t hstepA = (size_t)HALF * g.lda * 2, hstepB = (size_t)HALF * K * 2;
    const size_t tstepA = 2 * hstepA, tstepB = 2 * hstepB;
    const unsigned ldsw = (unsigned)wid * 1024u;
    const int aoff = lds_byte(wr * 64 + fr, fq * 8), boff = lds_byte(wc * 32 + fr, fq * 8);
#define PG8_SA(b, h) (((b) * 2 + (h)) * HTB)
#define PG8_SB(b, h) ((4 + (b) * 2 + (h)) * HTB)
#define PG8_STAGE(bufoff, gbase, voff) do { _Pragma("unroll") for (int _i = 0; _i < 2; ++_i) \
        __builtin_amdgcn_global_load_lds((const unsigned*)((const char*)(gbase) + (voff)[_i]), (PG8_LAS unsigned*)(lds + (bufoff) + ldsw + _i * 8192), 16, 0, 0); } while (0)
#define PG8_LDA(dst, b, h) do { _Pragma("unroll") for (int m = 0; m < 4; ++m) _Pragma("unroll") for (int k = 0; k < 2; ++k) dst[m][k] = *(const PG8_LAS bf16x8*)(lds + PG8_SA(b, h) + aoff + m * 2048 + k * 1024); } while (0)
#define PG8_LDB(dst, b, h) do { _Pragma("unroll") for (int n = 0; n < 2; ++n) _Pragma("unroll") for (int k = 0; k < 2; ++k) dst[n][k] = *(const PG8_LAS bf16x8*)(lds + PG8_SB(b, h) + boff + n * 2048 + k * 1024); } while (0)
#define PG8_MMA(ai, bj, At, Bt) do { __builtin_amdgcn_s_setprio(1); _Pragma("unroll") for (int m = 0; m < 4; ++m) _Pragma("unroll") for (int n = 0; n < 2; ++n) _Pragma("unroll") for (int k = 0; k < 2; ++k) \
        acc[ai][bj][m][n] = __builtin_amdgcn_mfma_f32_16x16x32_bf16(Bt[n][k], At[m][k], acc[ai][bj][m][n], 0, 0, 0); __builtin_amdgcn_s_setprio(0); } while (0)
#define PG8_WAIT_V(n) asm volatile("s_waitcnt vmcnt(" #n ")" ::: "memory")
#define PG8_WAIT_L(n) asm volatile("s_waitcnt lgkmcnt(" #n ")" ::: "memory")
#define PG8_BAR __builtin_amdgcn_s_barrier()
#define PG8_SCHED __builtin_amdgcn_sched_barrier(0)
    Unit cur, nxt; int ui = 0;
    if (!S.next(0, cur)) return;
    f32x4 acc[2][2][4][2];
#pragma unroll
    for (int a = 0; a < 2; ++a)
#pragma unroll
        for (int b = 0; b < 2; ++b)
#pragma unroll
            for (int m = 0; m < 4; ++m)
#pragma unroll
                for (int n = 0; n < 2; ++n) acc[a][b][m][n] = (f32x4){0.f, 0.f, 0.f, 0.f};
    bf16x8 At[4][2], B0[2][2], B1[2][2];
    const char* cA = (const char*)g.A + (size_t)cur.pm * tstepA; const char* cB = (const char*)g.Bt + (size_t)cur.pn * tstepB;
    S.a_ready(cur);
    if constexpr (SP2) {
        PG8_STAGE(PG8_SB(0, 0), cB, voffB); PG8_STAGE(PG8_SB(0, 1), cB + hstepB, voffB); PG8_STAGE(PG8_SA(0, 0), cA, voffA); PG8_STAGE(PG8_SA(0, 1), cA + hstepA, voffA);
        if (wr == 1) PG8_BAR;
        PG8_WAIT_V(2); PG8_BAR;
        PG8_STAGE(PG8_SB(1, 0), cB + kstep, voffB); PG8_STAGE(PG8_SA(1, 0), cA + kstep, voffA); PG8_STAGE(PG8_SB(1, 1), cB + hstepB + kstep, voffB);
        PG8_WAIT_V(6); PG8_BAR;
    } else {
        PG8_STAGE(PG8_SB(0, 0), cB, voffB); PG8_STAGE(PG8_SA(0, 0), cA, voffA); PG8_STAGE(PG8_SB(0, 1), cB + hstepB, voffB); PG8_STAGE(PG8_SA(0, 1), cA + hstepA, voffA);
        if (wr == 1) PG8_BAR;
        PG8_WAIT_V(4); PG8_BAR;
        PG8_STAGE(PG8_SB(1, 0), cB + kstep, voffB); PG8_STAGE(PG8_SA(1, 0), cA + kstep, voffA); PG8_STAGE(PG8_SB(1, 1), cB + hstepB + kstep, voffB);
        PG8_WAIT_V(6); PG8_BAR;
    }
    for (;;) {
        const bool has_next = S.next(ui + 1, nxt);
        const char* nA = has_next ? (const char*)g.A + (size_t)nxt.pm * tstepA : cA; const char* nB = has_next ? (const char*)g.Bt + (size_t)nxt.pn * tstepB : cB;
        for (int t = 0; t < nt; t += 2) {
            const bool last = (t == nt - 2);
            const char* a1 = cA + (size_t)(t + 1) * kstep;
            const char* a2 = last ? nA : cA + (size_t)(t + 2) * kstep; const char* b2 = last ? nB : cB + (size_t)(t + 2) * kstep;
            const char* a3 = a2 + kstep; const char* b3 = b2 + kstep;
            if (last && has_next) S.a_ready(nxt);
            if constexpr (SP2) {
            PG8_LDB(B0, 0, 0); PG8_LDB(B1, 0, 1); PG8_SCHED; PG8_LDA(At, 0, 0); PG8_STAGE(PG8_SA(1, 1), a1 + hstepA, voffA);
            PG8_WAIT_V(8); PG8_WAIT_L(0); PG8_BAR; PG8_MMA(0, 0, At, B0); PG8_MMA(0, 1, At, B1); PG8_BAR; PG8_SCHED;
            PG8_LDA(At, 0, 1); PG8_STAGE(PG8_SB(0, 0), b2, voffB); PG8_STAGE(PG8_SB(0, 1), b2 + hstepB, voffB); PG8_STAGE(PG8_SA(0, 0), a2, voffA);
            PG8_WAIT_V(8); PG8_WAIT_L(0); PG8_BAR; PG8_MMA(1, 0, At, B0); PG8_MMA(1, 1, At, B1); PG8_BAR; PG8_SCHED;
            PG8_LDB(B0, 1, 0); PG8_LDB(B1, 1, 1); PG8_SCHED; PG8_LDA(At, 1, 0); PG8_STAGE(PG8_SA(0, 1), a2 + hstepA, voffA);
            PG8_WAIT_V(8); PG8_WAIT_L(0); PG8_BAR; PG8_MMA(0, 0, At, B0); PG8_MMA(0, 1, At, B1); PG8_BAR; PG8_SCHED;
            PG8_LDA(At, 1, 1); PG8_STAGE(PG8_SB(1, 0), b3, voffB); PG8_STAGE(PG8_SB(1, 1), b3 + hstepB, voffB); PG8_STAGE(PG8_SA(1, 0), a3, voffA);
            PG8_WAIT_V(8); PG8_WAIT_L(0); PG8_BAR; PG8_MMA(1, 0, At, B0); PG8_MMA(1, 1, At, B1); PG8_BAR; PG8_SCHED;
            } else {
            PG8_LDB(B0, 0, 0); PG8_SCHED; PG8_LDA(At, 0, 0); PG8_STAGE(PG8_SA(1, 1), a1 + hstepA, voffA);
            PG8_WAIT_L(8); PG8_BAR; PG8_WAIT_L(0); PG8_MMA(0, 0, At, B0); PG8_BAR; PG8_SCHED;
            PG8_LDB(B1, 0, 1); PG8_STAGE(PG8_SB(0, 0), b2, voffB);
            PG8_BAR; PG8_WAIT_L(0); PG8_MMA(0, 1, At, B1); PG8_BAR;
            PG8_LDA(At, 0, 1); PG8_STAGE(PG8_SA(0, 0), a2, voffA);
            PG8_BAR; PG8_WAIT_L(0); PG8_MMA(1, 0, At, B0); PG8_BAR; PG8_SCHED;
            PG8_STAGE(PG8_SB(0, 1), b2 + hstepB, voffB);
            PG8_WAIT_V(6); PG8_BAR; PG8_MMA(1, 1, At, B1); PG8_BAR;
            PG8_LDB(B0, 1, 0); PG8_SCHED; PG8_LDA(At, 1, 0); PG8_STAGE(PG8_SA(0, 1), a2 + hstepA, voffA);
            PG8_WAIT_L(8); PG8_BAR; PG8_WAIT_L(0); PG8_MMA(0, 0, At, B0); PG8_BAR; PG8_SCHED;
            PG8_LDB(B1, 1, 1); PG8_STAGE(PG8_SB(1, 0), b3, voffB);
            PG8_BAR; PG8_WAIT_L(0); PG8_MMA(0, 1, At, B1); PG8_BAR;
            PG8_LDA(At, 1, 1); PG8_STAGE(PG8_SA(1, 0), a3, voffA);
            PG8_BAR; PG8_WAIT_L(0); PG8_MMA(1, 0, At, B0); PG8_BAR; PG8_SCHED;
            PG8_STAGE(PG8_SB(1, 1), b3 + hstepB, voffB);
            PG8_WAIT_V(6); PG8_BAR; PG8_MMA(1, 1, At, B1); PG8_BAR;
            }
        }
        if constexpr (ALIGN_EPI) { if (wr == 0) PG8_BAR; }
        if constexpr (!Epi::AFTER_DRAIN) { E(acc, cur, wr, wc, fr, fq); S.done(cur); }
        if (!has_next) break;
#pragma unroll
        for (int a = 0; a < 2; ++a)
#pragma unroll
            for (int b = 0; b < 2; ++b)
#pragma unroll
                for (int m = 0; m < 4; ++m)
#pragma unroll
                    for (int n = 0; n < 2; ++n) acc[a][b][m][n] = (f32x4){0.f, 0.f, 0.f, 0.f};
        cur = nxt; cA = nA; cB = nB; ++ui;
        if constexpr (ALIGN_EPI) { if (wr == 1) PG8_BAR; }
    }
    PG8_WAIT_V(0);
    if constexpr (!ALIGN_EPI) { if (wr == 0) PG8_BAR; }
    PG8_BAR;
    if constexpr (Epi::AFTER_DRAIN) { E.fused(acc, cur, wr, wc, fr, fq, lds, wid, lane); S.done(cur); }
#undef PG8_SA
#undef PG8_SB
#undef PG8_STAGE
#undef PG8_LDA
#undef PG8_LDB
#undef PG8_MMA
#undef PG8_WAIT_V
#undef PG8_WAIT_L
#undef PG8_BAR
#undef PG8_SCHED
}
}

using pg8::bf16_t; using pg8::bf16x8; using pg8::f32x4; using pg8::u32x4; using pg8::u32x2; using pg8::cvt_pk_bf16;
using pg8::NB; using pg8::SEQ; using pg8::DMODEL; using pg8::MTOK; using pg8::NMEMTOK; using pg8::LDP; using pg8::EPSN;
#define LAS __attribute__((address_space(3)))
typedef short s16x4 __attribute__((ext_vector_type(4)));
typedef float f32x2 __attribute__((ext_vector_type(2)));

constexpr int NTHREADS = 512, NWAVES = 8;
constexpr int LDS_BYTES = 147456;
constexpr int LDS_MISC = 139264;

constexpr size_t al256(size_t x) { return (x + 255) & ~(size_t)255; }
constexpr size_t WS_CTL   = 0;
constexpr size_t WS_WIN0  = 1u << 20;
constexpr size_t WS_WIN1  = WS_WIN0 + (size_t)4608 * 2048 * 2;
constexpr size_t WS_WIN2  = WS_WIN1 + (size_t)7168 * 2048 * 2;
constexpr size_t WS_WIN3  = WS_WIN2 + (size_t)5632 * 2048 * 2;
constexpr size_t WS_WOUT  = WS_WIN3 + (size_t)4608 * 2048 * 2;
constexpr size_t WS_WMEM  = WS_WOUT + (size_t)4 * 2048 * 2048 * 2;
constexpr size_t WS_HB    = WS_WMEM + (size_t)1024 * 2048 * 2;
constexpr size_t WS_PROJ  = WS_HB + (size_t)MTOK * 2048 * 2;
constexpr size_t WS_MEMB  = WS_PROJ + (size_t)MTOK * LDP * 2;
constexpr size_t WS_MKV   = WS_MEMB + (size_t)1024 * 2048 * 2;
constexpr size_t WS_RSS   = WS_MKV + (size_t)1024 * 1024 * 2;
constexpr size_t WS_RSSM  = WS_RSS + (size_t)5 * MTOK * 4;
constexpr size_t WS_ROPEA = WS_RSSM + 4096;
constexpr size_t WS_ROPEB = WS_ROPEA + (size_t)MTOK * 16 * 4;
constexpr size_t WS_ROPEC = WS_ROPEB + (size_t)MTOK * 32 * 4;
constexpr size_t WS_KMEAN = WS_ROPEC + (size_t)MTOK * 128 * 4;
constexpr size_t WS_RPREV = WS_KMEAN + (size_t)4 * 12 * 16 * 128 * 4;
constexpr size_t WS_END   = WS_RPREV + (size_t)4 * 32 * 6 * 256 * 128 * 2;

__constant__ double INVF[88] = {
 1.0, 0.19392274474868576, 0.03760603093086393, 0.007292664737217109, 0.001414213562373095, 0.0002742481756762073, 5.318295896944988e-05, 1.031338537721246e-05,
 1.0, 0.44036660267178046, 0.19392274474868576, 0.08539710028576561, 0.03760603093086393, 0.016560440080994446, 0.007292664737217109, 0.003211445994752591, 0.001414213562373095, 0.000622772421914596, 0.0002742481756762073, 0.00012076973741146504, 5.318295896944988e-05, 2.341999896140934e-05, 1.031338537721246e-05, 4.5416704806078695e-06,
 1.0, 0.8659643233600653, 0.7498942093324559, 0.6493816315762113, 0.5623413251903491, 0.4869675251658631, 0.4216965034285822, 0.3651741272548377, 0.31622776601683794, 0.27384196342643613, 0.23713737056616552, 0.2053525026457146, 0.1778279410038923, 0.1539926526059492, 0.1333521432163324, 0.11547819846894582, 0.1, 0.08659643233600653, 0.07498942093324558, 0.06493816315762113, 0.05623413251903491, 0.04869675251658631, 0.042169650342858224, 0.03651741272548377, 0.03162277660168379, 0.027384196342643614, 0.023713737056616554, 0.02053525026457146, 0.01778279410038923, 0.01539926526059492, 0.01333521432163324, 0.011547819846894581, 0.01, 0.008659643233600654, 0.007498942093324558, 0.006493816315762113, 0.005623413251903491, 0.004869675251658631, 0.004216965034285823, 0.003651741272548377, 0.0031622776601683794, 0.0027384196342643613, 0.0023713737056616554, 0.002053525026457146, 0.0017782794100389228, 0.001539926526059492, 0.001333521432163324, 0.0011547819846894581, 0.001, 0.0008659643233600654, 0.0007498942093324559, 0.0006493816315762113, 0.0005623413251903491, 0.0004869675251658631, 0.00042169650342858224, 0.0003651741272548377, 0.00031622776601683794, 0.0002738419634264361, 0.00023713737056616554, 0.0002053525026457146, 0.00017782794100389227, 0.0001539926526059492, 0.0001333521432163324, 0.00011547819846894582 };
__device__ __forceinline__ float log2gamma(int h) {
    return h == 0 ? -0.04580368961312479f : h == 1 ? -0.02612928206836121f : h == 2 ? -0.014949433599796901f : h == 3 ? -0.008567249848519122f : h == 4 ? -0.004914372264518986f : -0.002820519062378663f;
}

#define LDS_WAIT() asm volatile("s_waitcnt lgkmcnt(0)" ::: "memory")
__device__ __forceinline__ unsigned f2bf(float f) { unsigned u = __builtin_bit_cast(unsigned, f); return (u + 0x7fffu + ((u >> 16) & 1u)) >> 16; }
__device__ __forceinline__ unsigned pk2(float lo, float hi) { return f2bf(lo) | (f2bf(hi) << 16); }
__device__ __forceinline__ float bflo(unsigned w) { return __builtin_bit_cast(float, w << 16); }
__device__ __forceinline__ float bfhi(unsigned w) { return __builtin_bit_cast(float, w & 0xffff0000u); }
__device__ __forceinline__ float wave_sum(float v) {
#pragma unroll
    for (int o = 1; o < 64; o <<= 1) v += __shfl_xor(v, o);
    return v;
}
__device__ __forceinline__ float fexp2(float x) { return __builtin_amdgcn_exp2f(x); }
__device__ __forceinline__ s16x4 vtr(const LAS unsigned char* p) { return __builtin_bit_cast(s16x4, __builtin_amdgcn_ds_read_tr16_b64_v4i16((LAS s16x4*)p)); }
__device__ __forceinline__ bf16x8 cat8(s16x4 a, s16x4 b) { bf16x8 r; r[0] = a[0]; r[1] = a[1]; r[2] = a[2]; r[3] = a[3]; r[4] = b[0]; r[5] = b[1]; r[6] = b[2]; r[7] = b[3]; return r; }
typedef float f32x2_t __attribute__((ext_vector_type(2)));
typedef __bf16 bf16x2_t __attribute__((ext_vector_type(2)));
__device__ __forceinline__ unsigned cvtpk(float lo, float hi) { f32x2_t v = {lo, hi}; bf16x2_t b = __builtin_convertvector(v, bf16x2_t); return __builtin_bit_cast(unsigned, b); }
__device__ __forceinline__ float xmax16(float x) { const auto r = __builtin_amdgcn_permlane16_swap(__builtin_bit_cast(unsigned, x), __builtin_bit_cast(unsigned, x), false, false); return fmaxf(__builtin_bit_cast(float, r[0]), __builtin_bit_cast(float, r[1])); }
__device__ __forceinline__ float xmax32(float x) { const auto r = __builtin_amdgcn_permlane32_swap(__builtin_bit_cast(unsigned, x), __builtin_bit_cast(unsigned, x), false, false); return fmaxf(__builtin_bit_cast(float, r[0]), __builtin_bit_cast(float, r[1])); }
__device__ __forceinline__ bf16x8 pack8s(f32x4 a, f32x4 b) { u32x4 w; w.x = cvtpk(a[0], a[1]); w.y = cvtpk(a[2], a[3]); w.z = cvtpk(b[0], b[1]); w.w = cvtpk(b[2], b[3]); return __builtin_bit_cast(bf16x8, w); }
__device__ __forceinline__ bf16x8 pack8(f32x4 a, f32x4 b) { u32x4 w; w.x = cvt_pk_bf16(a[0], a[1]); w.y = cvt_pk_bf16(a[2], a[3]); w.z = cvt_pk_bf16(b[0], b[1]); w.w = cvt_pk_bf16(b[2], b[3]); return __builtin_bit_cast(bf16x8, w); }
__device__ __forceinline__ float silu_mul(float o, float z) { return o * z * __builtin_amdgcn_rcpf(1.0f + fexp2(-1.4426950408889634f * z)); }

__device__ __forceinline__ void transpose_item(const float* W, int N, int mid, const float* gvec, bf16_t* WT, int nblk, int item, int lane, LAS float* scr) {
    const int kb = item / nblk, nb = item % nblk, k0 = 64 * kb, n0 = 64 * nb;
    const int c4 = lane & 15, r4 = lane >> 4, j = n0 + 4 * c4;
    const int sc = (mid < 0) ? j : pg8::src_col(mid, j);
    f32x4 v[16];
#pragma unroll
    for (int i = 0; i < 16; ++i) { v[i] = (f32x4){0.f, 0.f, 0.f, 0.f}; if (sc >= 0) v[i] = *(const GAS f32x4*)(W + (size_t)(k0 + 4 * i + r4) * N + sc); }
#pragma unroll
    for (int i = 0; i < 16; ++i) { const int kk = 4 * i + r4; const float gk = gvec ? gvec[k0 + kk] : 1.0f; LAS float* d = scr + kk * 65 + 4 * c4;
        d[0] = v[i][0] * gk; d[1] = v[i][1] * gk; d[2] = v[i][2] * gk; d[3] = v[i][3] * gk; }
    LDS_WAIT(); asm volatile("" ::: "memory");
    const int c = lane & 7;
#pragma unroll
    for (int jj = 0; jj < 8; ++jj) { const int n = (lane >> 3) + 8 * jj; const LAS float* sp = scr + (8 * c) * 65 + n;
        u32x4 o; o.x = pk2(sp[0 * 65], sp[1 * 65]); o.y = pk2(sp[2 * 65], sp[3 * 65]); o.z = pk2(sp[4 * 65], sp[5 * 65]); o.w = pk2(sp[6 * 65], sp[7 * 65]);
        *(GAS u32x4*)(WT + (size_t)(n0 + n) * 2048 + k0 + 8 * c) = o; }
    LDS_WAIT(); asm volatile("" ::: "memory");
}
__device__ __forceinline__ void row_to_bf16(const float* xrow, bf16_t* orow, float* rss, int lane) {
    const f32x4* xr = (const f32x4*)xrow + lane; float s = 0.f;
    GAS u32x2* o8 = (GAS u32x2*)orow + lane;
#pragma unroll
    for (int j = 0; j < 8; ++j) { const f32x4 v = xr[64 * j]; s += (v.x * v.x + v.y * v.y) + (v.z * v.z + v.w * v.w);
        u32x2 w; w.x = pk2(v.x, v.y); w.y = pk2(v.z, v.w); o8[64 * j] = w; }
    s = wave_sum(s);
    if (lane == 0) *(GAS float*)rss = s;
}

enum { MODE_SWA = 0, MODE_MOBA = 1, MODE_MEM = 2 };
template <int DH, int MODE>
__device__ __forceinline__ void attn_unit(LAS unsigned char* lds, int tid, int wid, int lane,
        const bf16_t* Q,
        int qrow0,
        const bf16_t* Kb, const bf16_t* Vb, int ldkv,
        int nt, int krow_a, int krow_b,
        float m_init, float l_init, unsigned sel0, unsigned sel1,
        bf16_t* Zy,
        bool dry = false)
{
    asm volatile("" : "+v"(tid), "+v"(lane)); asm volatile("" : "+s"(wid));
    constexpr int KSTR = DH * 2 + 16, VSTR = DH * 2 + 32, KBYTES = 64 * KSTR, VBYTES = 64 * VSTR, STG = KBYTES + VBYTES;
    constexpr int CPR = DH / 8  , CPT = (64 * CPR) / NTHREADS  ;
    constexpr int NK = DH / 32, NDB = DH / 16;
    const int g = lane >> 4, l15 = lane & 15, q4 = l15 >> 2, p4 = l15 & 3;
    bf16x8 Qf[2][NK];
#pragma unroll
    for (int j = 0; j < 2; ++j)
#pragma unroll
        for (int k = 0; k < NK; ++k) Qf[j][k] = *(const GAS bf16x8*)(Q + (size_t)(qrow0 + j * 16 + l15) * LDP + k * 32 + g * 8);
    f32x4 O[NDB][2];
#pragma unroll
    for (int db = 0; db < NDB; ++db) { O[db][0] = (f32x4){0.f, 0.f, 0.f, 0.f}; O[db][1] = (f32x4){0.f, 0.f, 0.f, 0.f}; }
    const float m0 = (MODE == MODE_SWA) ? m_init : 0.f;
    float mrow[2] = {m0, m0}, lrow[2] = {g == 0 ? l_init : 0.f, g == 0 ? l_init : 0.f};
    bool first = (MODE != MODE_SWA);
    const unsigned sel[2] = {sel0, sel1};

    u32x4 kreg[2][CPT], vreg[2][CPT];
#define ATT_KROW(it) ((MODE == MODE_MOBA && (it) >= 4) ? (krow_b + 64 * ((it) - 4)) : (krow_a + 64 * (it)))
#define ATT_ISSUE(hf_, it) do { const int kr_ = ATT_KROW(it); _Pragma("unroll") for (int i_ = 0; i_ < CPT; ++i_) { const int c_ = tid + NTHREADS * i_, r_ = c_ / CPR, cc_ = c_ % CPR; \
        kreg[hf_][i_] = *(const GAS u32x4*)(Kb + (size_t)(kr_ + r_) * ldkv + cc_ * 8); vreg[hf_][i_] = *(const GAS u32x4*)(Vb + (size_t)(kr_ + r_) * ldkv + cc_ * 8); } } while (0)
    constexpr bool PF2 = false;
    ATT_ISSUE(0, 0);
    if (PF2 && nt > 1) ATT_ISSUE(1, 1);
    for (int it0 = 0; it0 < nt; it0 += 2) {
#pragma unroll
      for (int hf = 0; hf < 2; ++hf) {
        const int it = it0 + hf;
        if (it >= nt) break;
        LAS unsigned char* Kt = lds + hf * STG; LAS unsigned char* Vt = Kt + KBYTES;
#pragma unroll
        for (int i = 0; i < CPT; ++i) { const int c = tid + NTHREADS * i, r = c / CPR, cc = c % CPR;
            *(LAS u32x4*)(Kt + r * KSTR + cc * 16) = kreg[PF2 ? hf : 0][i]; *(LAS u32x4*)(Vt + r * VSTR + cc * 16) = vreg[PF2 ? hf : 0][i]; }
        if (PF2) { if (it + 2 < nt) ATT_ISSUE(hf, it + 2); } else { if (it + 1 < nt) ATT_ISSUE(0, it + 1); }
        __syncthreads();
        const int kp = ATT_KROW(it);
        bool active = true;
        if (MODE == MODE_SWA) active = !(kp > qrow0 + 31 || kp + 63 <= qrow0 - 128);
        if (MODE == MODE_MOBA) active = !(kp > qrow0 + 31);
        if (active) {
            f32x4 S[4][2];
            float sinit[2] = {-mrow[0], -mrow[1]};
            if (MODE == MODE_MOBA && it >= 4) {
                const int pb = (it - 4) >> 2;
                sinit[0] = ((sel[0] >> pb) & 1u) ? sinit[0] : -INFINITY; sinit[1] = ((sel[1] >> pb) & 1u) ? sinit[1] : -INFINITY;
            }
#pragma unroll
            for (int kb = 0; kb < 4; ++kb) { S[kb][0] = (f32x4){sinit[0], sinit[0], sinit[0], sinit[0]}; S[kb][1] = (f32x4){sinit[1], sinit[1], sinit[1], sinit[1]}; }
#pragma unroll
            for (int kb = 0; kb < 4; ++kb) {
#pragma unroll
                for (int k = 0; k < NK; ++k) {
                    const bf16x8 a = *(const LAS bf16x8*)(Kt + (kb * 16 + l15) * KSTR + (k * 32 + g * 8) * 2);
                    S[kb][0] = __builtin_amdgcn_mfma_f32_16x16x32_bf16(a, Qf[0][k], S[kb][0], 0, 0, 0);
                    S[kb][1] = __builtin_amdgcn_mfma_f32_16x16x32_bf16(a, Qf[1][k], S[kb][1], 0, 0, 0);
                }
                if (kb & 1) __builtin_amdgcn_sched_barrier(0);
            }
            bf16x8 Pb[2][2];
#pragma unroll
            for (int j = 0; j < 2; ++j) {
                const int qi = qrow0 + j * 16 + l15;
                if (MODE == MODE_SWA) {
                    if (!(kp + 63 <= qrow0 && kp > qrow0 + 31 - 128)) {
                        const unsigned dbase = (unsigned)(qi - kp - 4 * g);
#pragma unroll
                        for (int kb = 0; kb < 4; ++kb)
#pragma unroll
                            for (int i = 0; i < 4; ++i) S[kb][j][i] = ((dbase - (unsigned)(kb * 16 + i)) < 128u) ? S[kb][j][i] : -INFINITY;
                    }
                } else if (MODE == MODE_MOBA) {
                    if (kp + 63 > qrow0) {
#pragma unroll
                        for (int kb = 0; kb < 4; ++kb)
#pragma unroll
                            for (int i = 0; i < 4; ++i) S[kb][j][i] = ((qi - kp - 4 * g) >= (kb * 16 + i)) ? S[kb][j][i] : -INFINITY;
                    }
                }
                float mx = -INFINITY;
#pragma unroll
                for (int kb = 0; kb < 4; ++kb) mx = fmaxf(mx, fmaxf(fmaxf(S[kb][j][0], S[kb][j][1]), fmaxf(S[kb][j][2], S[kb][j][3])));
                mx = xmax16(mx); mx = xmax32(mx);
                const bool need = (first && mx > -INFINITY) || (mx > 8.0f);
                if (__builtin_amdgcn_ballot_w64(need) != 0ull) {
                    const float dlt = need ? mx : 0.f, alpha = fexp2(-dlt);
#pragma unroll
                    for (int kb = 0; kb < 4; ++kb) S[kb][j] = S[kb][j] - dlt;
                    mrow[j] += dlt; lrow[j] *= alpha;
#pragma unroll
                    for (int db = 0; db < NDB; ++db) O[db][j] = O[db][j] * alpha;
                }
                float ps = 0.f;
#pragma unroll
                for (int kb = 0; kb < 4; ++kb)
#pragma unroll
                    for (int i = 0; i < 4; ++i) { const float p = fexp2(S[kb][j][i]); S[kb][j][i] = p; ps += p; }
                lrow[j] += ps;
                Pb[j][0] = pack8s(S[0][j], S[1][j]); Pb[j][1] = pack8s(S[2][j], S[3][j]);
            }
#pragma unroll
            for (int s = 0; s < 2; ++s)
#pragma unroll
                for (int db = 0; db < NDB; ++db) {
                    const s16x4 lo = vtr(Vt + (32 * s + 4 * g + q4) * VSTR + (16 * db + 4 * p4) * 2);
                    const s16x4 hi = vtr(Vt + (32 * s + 16 + 4 * g + q4) * VSTR + (16 * db + 4 * p4) * 2);
                    const bf16x8 a = cat8(lo, hi);
                    O[db][0] = __builtin_amdgcn_mfma_f32_16x16x32_bf16(a, Pb[0][s], O[db][0], 0, 0, 0);
                    O[db][1] = __builtin_amdgcn_mfma_f32_16x16x32_bf16(a, Pb[1][s], O[db][1], 0, 0, 0);
                    if ((db & 3) == 3) __builtin_amdgcn_sched_barrier(0);
                }
            first = false;
        }
      }
    }
#undef ATT_ISSUE
#undef ATT_KROW
#pragma unroll
    for (int j = 0; j < 2; ++j) {
        float l = lrow[j]; l += __shfl_xor(l, 16); l += __shfl_xor(l, 32);
        const float inv = 1.0f / l;
        bf16_t* zp = Zy + (size_t)(qrow0 + j * 16 + l15) * LDP + 4 * g;
#pragma unroll
        for (int db = 0; db < NDB; ++db) {
            const u32x2 z = *(const GAS u32x2*)(zp + 16 * db);
            const f32x4 o = O[db][j] * inv;
            u32x2 w; w.x = cvt_pk_bf16(silu_mul(o[0], bflo(z.x)), silu_mul(o[1], bfhi(z.x))); w.y = cvt_pk_bf16(silu_mul(o[2], bflo(z.y)), silu_mul(o[3], bfhi(z.y)));
            if (!dry) *(GAS u32x2*)(zp + 16 * db) = w;
        }
    }
    __syncthreads();
}

__device__ __forceinline__ void moba_gate(LAS unsigned char* lds, int tid, const bf16_t* proj, const float* kmean, int b, int h, int qb) {
    asm volatile("" : "+v"(tid));
    LAS float* km = (LAS float*)lds;
    LAS unsigned* selm = (LAS unsigned*)(lds + LDS_MISC - 2048);
    for (int i = tid; i < 16 * 128; i += NTHREADS) km[i] = *((const GAS float*)kmean + (size_t)((b * 12 + h) * 16) * 128 + i);
    __syncthreads();
    const int q = tid >> 1, half = tid & 1;
    const bf16_t* qp = proj + (size_t)(b * SEQ + qb * 256 + q) * LDP + h * 128 + half * 64;
    float gsc[15];
#pragma unroll
    for (int n = 0; n < 15; ++n) gsc[n] = 0.f;
#pragma unroll 1
    for (int c = 0; c < 8; ++c) {
        const u32x4 w = *(const GAS u32x4*)(qp + c * 8);
        float qv[8] = {bflo(w.x), bfhi(w.x), bflo(w.y), bfhi(w.y), bflo(w.z), bfhi(w.z), bflo(w.w), bfhi(w.w)};
#pragma unroll
        for (int n = 0; n < 15; ++n) if (n < qb) {
            const LAS float* kr = km + n * 128 + half * 64 + c * 8;
#pragma unroll
            for (int e = 0; e < 8; ++e) gsc[n] += qv[e] * kr[e];
        }
    }
    unsigned mask = 0u;
#pragma unroll
    for (int n = 0; n < 15; ++n) { gsc[n] += __shfl_xor(gsc[n], 1); if (n >= qb) gsc[n] = -INFINITY; }
#pragma unroll
    for (int r = 0; r < 3; ++r) {
        float best = -INFINITY; int bi = -1;
#pragma unroll
        for (int n = 0; n < 15; ++n) { const bool taken = (mask >> n) & 1u; if (!taken && gsc[n] > best) { best = gsc[n]; bi = n; } }
        if (bi >= 0) mask |= 1u << bi;
    }
    if (half == 0) selm[q] = mask;
    __syncthreads();
}

__device__ __forceinline__ void kmean_unit(LAS unsigned char* lds, int tid, const bf16_t* proj, float* kmean, int u) {
    asm volatile("" : "+v"(tid));
    const int blk = u & 15, bh = u >> 4, b = bh / 12, h = bh % 12;
    const int cc = tid & 15, kg = tid >> 4;
    float s[8] = {0.f, 0.f, 0.f, 0.f, 0.f, 0.f, 0.f, 0.f};
    const bf16_t* kp = proj + (size_t)(b * SEQ + blk * 256 + kg * 8) * LDP + 1536 + h * 128 + cc * 8;
#pragma unroll
    for (int r = 0; r < 8; ++r) { const u32x4 w = *(const GAS u32x4*)(kp + (size_t)r * LDP);
        s[0] += bflo(w.x); s[1] += bfhi(w.x); s[2] += bflo(w.y); s[3] += bfhi(w.y); s[4] += bflo(w.z); s[5] += bfhi(w.z); s[6] += bflo(w.w); s[7] += bfhi(w.w); }
    LAS float* red = (LAS float*)lds;
#pragma unroll
    for (int e = 0; e < 8; ++e) red[kg * 128 + cc * 8 + e] = s[e];
    __syncthreads();
    if (tid < 128) { float a = 0.f;
#pragma unroll 8
        for (int k = 0; k < 32; ++k) a += red[k * 128 + tid];
        *((GAS float*)kmean + (size_t)u * 128 + tid) = a * (1.0f / 256.0f); }
    __syncthreads();
}

__device__ __forceinline__ void ret_scan_item(LAS unsigned char* lds, int tid, int wid, int lane, const bf16_t* proj, bf16_t* rprev, int item) {
    asm volatile("" : "+v"(tid), "+v"(lane)); asm volatile("" : "+s"(wid));
    constexpr int KS = 288, VS = 96, KB = 128 * KS, STG = KB + 128 * VS;
    const int es = item & 7, bh = item >> 3, b = bh / 6, h = bh % 6;
    const float lg = log2gamma(h), gchunk = fexp2(128.f * lg);
    const int g = lane >> 4, l15 = lane & 15, q4 = l15 >> 2, p4 = l15 & 3;
    const bf16_t* kbase = proj + (size_t)(b * SEQ) * LDP + 768 + h * 128;
    const bf16_t* vbase = proj + (size_t)(b * SEQ) * LDP + 1536 + h * 256 + es * 32;
    f32x4 R[2] = {(f32x4){0.f, 0.f, 0.f, 0.f}, (f32x4){0.f, 0.f, 0.f, 0.f}};
    u32x4 kreg[4], vreg;
#define RS_ISSUE(n) do { _Pragma("unroll") for (int i_ = 0; i_ < 4; ++i_) { const int c_ = tid + NTHREADS * i_; kreg[i_] = *(const GAS u32x4*)(kbase + (size_t)((n) * 128 + (c_ >> 4)) * LDP + (c_ & 15) * 8); } \
        vreg = *(const GAS u32x4*)(vbase + (size_t)((n) * 128 + (tid >> 2)) * LDP + (tid & 3) * 8); } while (0)
    RS_ISSUE(0);
    for (int n = 0; n < 32; ++n) {
        bf16_t* rp = rprev + ((size_t)((b * 32 + n) * 6 + h) * 256 + es * 32 + l15) * 128 + wid * 16 + 4 * g;
#pragma unroll
        for (int eb = 0; eb < 2; ++eb) { u32x2 w; w.x = cvt_pk_bf16(R[eb][0], R[eb][1]); w.y = cvt_pk_bf16(R[eb][2], R[eb][3]); *(GAS u32x2*)(rp + (size_t)eb * 16 * 128) = w; }
        if (n == 31) break;
        LAS unsigned char* Kt = lds + (n & 1) * STG; LAS unsigned char* Vt = Kt + KB;
#pragma unroll
        for (int i = 0; i < 4; ++i) { const int c = tid + NTHREADS * i, t = c >> 4, cc = c & 15;
            const float zt = fexp2((float)(127 - t) * lg);
            const u32x4 w = kreg[i]; u32x4 o;
            o.x = cvt_pk_bf16(bflo(w.x) * zt, bfhi(w.x) * zt); o.y = cvt_pk_bf16(bflo(w.y) * zt, bfhi(w.y) * zt); o.z = cvt_pk_bf16(bflo(w.z) * zt, bfhi(w.z) * zt); o.w = cvt_pk_bf16(bflo(w.w) * zt, bfhi(w.w) * zt);
            *(LAS u32x4*)(Kt + t * KS + cc * 16) = o; }
        *(LAS u32x4*)(Vt + (tid >> 2) * VS + (tid & 3) * 16) = vreg;
        __syncthreads();
        if (n + 1 < 31) RS_ISSUE(n + 1);
        R[0] = R[0] * gchunk; R[1] = R[1] * gchunk;
#pragma unroll
        for (int s = 0; s < 4; ++s) {
            const bf16x8 a = cat8(vtr(Kt + (32 * s + 8 * g + q4) * KS + (16 * wid + 4 * p4) * 2), vtr(Kt + (32 * s + 8 * g + 4 + q4) * KS + (16 * wid + 4 * p4) * 2));
#pragma unroll
            for (int eb = 0; eb < 2; ++eb) {
                const bf16x8 bb = cat8(vtr(Vt + (32 * s + 8 * g + q4) * VS + (16 * eb + 4 * p4) * 2), vtr(Vt + (32 * s + 8 * g + 4 + q4) * VS + (16 * eb + 4 * p4) * 2));
                R[eb] = __builtin_amdgcn_mfma_f32_16x16x32_bf16(a, bb, R[eb], 0, 0, 0);
            }
        }
    }
#undef RS_ISSUE
    __syncthreads();
}

__device__ __forceinline__ void ret_out_unit(LAS unsigned char* lds, int tid, int wid, int lane, bf16_t* proj, const bf16_t* rprev, int u, bool dry = false) {
    asm volatile("" : "+v"(tid), "+v"(lane)); asm volatile("" : "+s"(wid));
    constexpr int KS = 272, VS = 544, KB = 128 * KS;
    const int h = u % 6, bn = u / 6, n = bn & 31, b = bn >> 5;
    const float lg = log2gamma(h);
    const int g = lane >> 4, l15 = lane & 15, q4 = l15 >> 2, p4 = l15 & 3;
    const int row0 = b * SEQ + n * 128;
    LAS unsigned char* Kt = lds; LAS unsigned char* Vt = lds + KB;
    const bf16_t* kbase = proj + (size_t)row0 * LDP + 768 + h * 128;
    const bf16_t* vbase = proj + (size_t)row0 * LDP + 1536 + h * 256;
#pragma unroll
    for (int i = 0; i < 4; ++i) { const int c = tid + NTHREADS * i, t = c >> 4, cc = c & 15; *(LAS u32x4*)(Kt + t * KS + cc * 16) = *(const GAS u32x4*)(kbase + (size_t)t * LDP + cc * 8); }
#pragma unroll
    for (int i = 0; i < 8; ++i) { const int c = tid + NTHREADS * i, t = c >> 5, cc = c & 31; *(LAS u32x4*)(Vt + t * VS + cc * 16) = *(const GAS u32x4*)(vbase + (size_t)t * LDP + cc * 8); }
    const int qrow = row0 + wid * 16 + l15;
    bf16x8 Qf[4];
#pragma unroll
    for (int k = 0; k < 4; ++k) Qf[k] = *(const GAS bf16x8*)(proj + (size_t)qrow * LDP + h * 128 + k * 32 + g * 8);
    u32x4 rreg[8];
    const bf16_t* rbase = rprev + (size_t)((b * 32 + n) * 6 + h) * 256 * 128;
#pragma unroll
    for (int i = 0; i < 8; ++i) { const int c = tid + NTHREADS * i; rreg[i] = *(const GAS u32x4*)(rbase + (size_t)c * 8); }
    __syncthreads();
    f32x4 S[8];
#pragma unroll
    for (int kb = 0; kb < 8; ++kb) S[kb] = (f32x4){0.f, 0.f, 0.f, 0.f};
#pragma unroll
    for (int kb = 0; kb < 8; ++kb) if (kb <= wid) {
#pragma unroll
        for (int k = 0; k < 4; ++k) {
            const bf16x8 a = *(const LAS bf16x8*)(Kt + (kb * 16 + l15) * KS + (k * 32 + g * 8) * 2);
            S[kb] = __builtin_amdgcn_mfma_f32_16x16x32_bf16(a, Qf[k], S[kb], 0, 0, 0);
        }
    }
    const int tq = wid * 16 + l15;
    bf16x8 Pb[4];
#pragma unroll
    for (int kb = 0; kb < 8; ++kb)
#pragma unroll
        for (int i = 0; i < 4; ++i) { const int tk = kb * 16 + 4 * g + i; S[kb][i] = (tk <= tq) ? S[kb][i] * fexp2(-(float)(tk + 1) * lg) : 0.f; }
#pragma unroll
    for (int s = 0; s < 4; ++s) Pb[s] = pack8(S[2 * s], S[2 * s + 1]);
    f32x4 O[16];
#pragma unroll
    for (int eb = 0; eb < 16; ++eb) O[eb] = (f32x4){0.f, 0.f, 0.f, 0.f};
#pragma unroll
    for (int s = 0; s < 4; ++s) if (2 * s <= wid) {
#pragma unroll
        for (int eb = 0; eb < 16; ++eb) {
            const bf16x8 a = cat8(vtr(Vt + (32 * s + 4 * g + q4) * VS + (16 * eb + 4 * p4) * 2), vtr(Vt + (32 * s + 16 + 4 * g + q4) * VS + (16 * eb + 4 * p4) * 2));
            O[eb] = __builtin_amdgcn_mfma_f32_16x16x32_bf16(a, Pb[s], O[eb], 0, 0, 0);
        }
    }
    __syncthreads();
#pragma unroll
    for (int i = 0; i < 8; ++i) { const int c = tid + NTHREADS * i; *(LAS u32x4*)(Vt + (c >> 4) * KS + (c & 15) * 16) = rreg[i]; }
    __syncthreads();
#pragma unroll
    for (int eb = 0; eb < 16; ++eb)
#pragma unroll
        for (int k = 0; k < 4; ++k) {
            const bf16x8 a = *(const LAS bf16x8*)(Vt + (eb * 16 + l15) * KS + (k * 32 + g * 8) * 2);
            O[eb] = __builtin_amdgcn_mfma_f32_16x16x32_bf16(a, Qf[k], O[eb], 0, 0, 0);
        }
    const float xi = fexp2((float)(tq + 1) * lg);
    float ss = 0.f;
#pragma unroll
    for (int eb = 0; eb < 16; ++eb) { O[eb] = O[eb] * xi; ss += (O[eb][0] * O[eb][0] + O[eb][1] * O[eb][1]) + (O[eb][2] * O[eb][2] + O[eb][3] * O[eb][3]); }
    ss += __shfl_xor(ss, 16); ss += __shfl_xor(ss, 32);
    const float rstd = __builtin_amdgcn_rsqf(ss * (1.0f / 256.0f) + EPSN);
    bf16_t* zp = proj + (size_t)qrow * LDP + 3584 + h * 256 + 4 * g;
#pragma unroll
    for (int eb = 0; eb < 16; ++eb) {
        const u32x2 z = *(const GAS u32x2*)(zp + 16 * eb);
        const f32x4 o = O[eb] * rstd;
        u32x2 w; w.x = cvt_pk_bf16(silu_mul(o[0], bflo(z.x)), silu_mul(o[1], bfhi(z.x))); w.y = cvt_pk_bf16(silu_mul(o[2], bflo(z.y)), silu_mul(o[3], bfhi(z.y)));
        if (!dry) *(GAS u32x2*)(zp + 16 * eb) = w;
    }
    __syncthreads();
}

#define XB_TMO      128
#define XB_XCNT(j)  (256  + 64 * (j))
#define XB_XSUB(j)  (1280 + 64 * (j))
#define XB_XGEN(j)  (2304 + 64 * (j))
#define XB_TOP      3328
#define XB_TOPGEN   3392
#define XCD_BAR_WORDS 3456
#define XB_SPIN_CAP (1u << 18)

__device__ __forceinline__ unsigned xb_ld(unsigned* p)              { return __hip_atomic_load(p, __ATOMIC_RELAXED, __HIP_MEMORY_SCOPE_AGENT); }
__device__ __forceinline__ unsigned xb_add(unsigned* p, unsigned v) { return __hip_atomic_fetch_add(p, v, __ATOMIC_RELAXED, __HIP_MEMORY_SCOPE_AGENT); }
__device__ __forceinline__ unsigned xb_xcc_id() { return (unsigned)__builtin_amdgcn_s_getreg((3 << 11) | 20) & 0xFu; }
#define XB_SPIN(cond, bar) do { unsigned _sp = 0; while (cond) { __builtin_amdgcn_s_sleep(1); \
    if ((++_sp & 255u) == 0u) { if (xb_ld(&(bar)[XB_TMO])) break; if (_sp > XB_SPIN_CAP) { atomicAdd(&(bar)[XB_TMO], 1u); break; } } } } while (0)

struct XcdBarrier {
    unsigned* bar; unsigned x;
    volatile LAS unsigned* st;
};

__device__ __forceinline__ XcdBarrier xcd_barrier_post(unsigned* bar, volatile LAS unsigned* st) {
    XcdBarrier b; b.bar = bar; b.x = xb_xcc_id(); b.st = st;
    if (threadIdx.x == 0) (void)xb_add(&bar[XB_XCNT(b.x)], 1u);
    return b;
}
__device__ __forceinline__ void xcd_barrier_complete(unsigned* bar, unsigned x, unsigned& nloc, unsigned& nx) {
    const unsigned G = gridDim.x * gridDim.y * gridDim.z;
    unsigned sum, cnt, mine, sp = 0u;
    for (;;) {
        sum = 0u; cnt = 0u; mine = 0u;
#pragma unroll
        for (unsigned j = 0; j < 16; ++j) { const unsigned c = xb_ld(&bar[XB_XCNT(j)]); sum += c; cnt += (c > 0u) ? 1u : 0u; mine = (j == x) ? c : mine; }
        if (sum == G) break;
        __builtin_amdgcn_s_sleep(1);
        if ((++sp & 255u) == 0u) { if (xb_ld(&bar[XB_TMO])) break; if (sp > XB_SPIN_CAP) { atomicAdd(&bar[XB_TMO], 1u); break; } }
    }
    nloc = mine > 0u ? mine : 1u; nx = cnt > 0u ? cnt : 1u;
}

__device__ __forceinline__ void xcd_barrier(const XcdBarrier& b) {
    asm volatile("s_waitcnt vmcnt(0)" ::: "memory");
    __syncthreads();
    if (threadIdx.x == 0) {
        unsigned* bar = b.bar;
        __builtin_amdgcn_s_waitcnt(0);
        unsigned nloc = b.st[0], nx = b.st[1];
        if (nloc == 0u) { xcd_barrier_complete(bar, b.x, nloc, nx); b.st[0] = nloc; b.st[1] = nx; }
        const unsigned old = xb_add(&bar[XB_XSUB(b.x)], 1u);
        const unsigned gen = old / nloc;
        if (old + 1u == (gen + 1u) * nloc) {
            __builtin_amdgcn_fence(__ATOMIC_RELEASE, "agent");
            asm volatile("s_waitcnt vmcnt(0)" ::: "memory");
            const unsigned og = xb_add(&bar[XB_TOP], 1u);
            const unsigned tg = og / nx;
            if (og + 1u == (tg + 1u) * nx) xb_add(&bar[XB_TOPGEN], 1u);
            else XB_SPIN(xb_ld(&bar[XB_TOPGEN]) == tg, bar);
            __builtin_amdgcn_fence(__ATOMIC_ACQUIRE, "agent");
            xb_add(&bar[XB_XGEN(b.x)], 1u);
            asm volatile("s_waitcnt vmcnt(0)" ::: "memory");
        } else {
            XB_SPIN(xb_ld(&bar[XB_XGEN(b.x)]) == gen, bar);
            __builtin_amdgcn_fence(__ATOMIC_ACQUIRE, "agent");
            asm volatile("s_waitcnt vmcnt(0)" ::: "memory");
        }
    }
    __syncthreads();
}


#define CONV_WEIGHTS(MASK, worker, nworkers) do { \
        int lane_ = lane, wid_ = wid; asm volatile("" : "+v"(lane_)); asm volatile("" : "+s"(wid_)); LAS float* scr_ = (LAS float*)(lds + wid_ * 16640); \
        int total_ = 0; \
        _Pragma("unroll 1") for (int mi_ = 0; mi_ < 9; ++mi_) if (((MASK) >> mi_) & 1u) total_ += 32 * (mi_ < 4 ? pg8::npad_of(mi_ == 3 ? 0 : mi_) / 64 : (mi_ < 8 ? 32 : 16)); \
        for (int it_ = (worker); it_ < total_; it_ += (nworkers)) { \
            int r_ = it_; \
            _Pragma("unroll 1") for (int mi = 0; mi < 9; ++mi) { \
                if (!(((MASK) >> mi) & 1u)) continue; \
                const float* W; int N, mid_, nblk; const float* gv; bf16_t* WT; \
                if (mi < 4) { const int l_ = mi; mid_ = l_ == 3 ? 0 : l_; N = pg8::nc_of(mid_); nblk = pg8::npad_of(mid_) / 64; \
                    W = args.in[l_ == 0 ? 6 : l_ == 1 ? 10 : l_ == 2 ? 13 : 16]; gv = args.in[l_ == 0 ? 5 : l_ == 1 ? 9 : l_ == 2 ? 12 : 15]; \
                    WT = (bf16_t*)(ws + (l_ == 0 ? WS_WIN0 : l_ == 1 ? WS_WIN1 : l_ == 2 ? WS_WIN2 : WS_WIN3)); } \
                else if (mi < 8) { const int l_ = mi - 4; mid_ = -1; N = 2048; nblk = 32; W = args.in[l_ == 0 ? 8 : l_ == 1 ? 11 : l_ == 2 ? 14 : 18]; gv = nullptr; WT = woutT + (size_t)l_ * 2048 * 2048; } \
                else { mid_ = -1; N = 1024; nblk = 16; W = args.in[4]; gv = args.in[3]; WT = wmemT; } \
                const int cnt_ = 32 * nblk; \
                if (r_ < cnt_) { transpose_item(W, N, mid_, gv, WT, nblk, r_, lane_, scr_); break; } \
                r_ -= cnt_; \
            } \
        } } while (0)

struct Args { const float* in[20]; float* out; unsigned char* ws; };

__device__ __forceinline__ int fetch_unit(unsigned* ctr, volatile LAS unsigned* slot, int tid) {
    if (tid == 0) *slot = atomicAdd(ctr, 1u);
    __syncthreads();
    const unsigned v = *slot;
    __syncthreads();
    return __builtin_amdgcn_readfirstlane((int)v);
}

__global__ void __launch_bounds__(NTHREADS, 2) trunk_fwd(Args args) {
    extern __shared__ __attribute__((aligned(16))) unsigned char lds_raw[];
    cg::grid_group grid = cg::this_grid();
    LAS unsigned char* lds = (LAS unsigned char*)lds_raw;
    volatile LAS unsigned* misc = (volatile LAS unsigned*)(lds + LDS_MISC);
    const int tid = threadIdx.x, lane = tid & 63, wid = __builtin_amdgcn_readfirstlane(tid >> 6);
    const int G = gridDim.x, bx = blockIdx.x;
#define WS_PTRS() unsigned char* ws = args.ws; asm volatile("" : "+s"(ws)); \
    unsigned* ctl = (unsigned*)(ws + WS_CTL); bf16_t* hb = (bf16_t*)(ws + WS_HB); bf16_t* proj = (bf16_t*)(ws + WS_PROJ); \
    bf16_t* memb = (bf16_t*)(ws + WS_MEMB); bf16_t* mkv = (bf16_t*)(ws + WS_MKV); float* rss = (float*)(ws + WS_RSS); float* rssm = (float*)(ws + WS_RSSM); \
    float* ropeA = (float*)(ws + WS_ROPEA); float* ropeB = (float*)(ws + WS_ROPEB); float* ropeC = (float*)(ws + WS_ROPEC); \
    float* kmean = (float*)(ws + WS_KMEAN); bf16_t* rprev = (bf16_t*)(ws + WS_RPREV); bf16_t* woutT = (bf16_t*)(ws + WS_WOUT); bf16_t* wmemT = (bf16_t*)(ws + WS_WMEM); \
    (void)ctl; (void)hb; (void)proj; (void)memb; (void)mkv; (void)rss; (void)rssm; (void)ropeA; (void)ropeB; (void)ropeC; (void)kmean; (void)rprev; (void)woutT; (void)wmemT
#ifndef REP_P0
#define REP_P0 1
#endif
    for (int rep0 = 0; rep0 < REP_P0; ++rep0) {
        if (rep0) grid.sync();
        WS_PTRS(); const float* x = args.in[0];
        const int gw = bx * NWAVES + wid, NGW = G * NWAVES;
        LAS float* scr = (LAS float*)(lds + wid * 16640);
        if (G == 256) CONV_WEIGHTS(0x111u, gw, NGW); else CONV_WEIGHTS(0x1FFu, gw, NGW);
        for (int m = gw; m < MTOK; m += NGW) row_to_bf16(x + (size_t)m * DMODEL, hb + (size_t)m * DMODEL, rss + m, lane);
        for (int m = gw; m < NB * NMEMTOK; m += NGW) row_to_bf16(args.in[1] + (size_t)m * DMODEL, memb + (size_t)m * DMODEL, rssm + m, lane);
        const int* positions = (const int*)args.in[2];
        const int gt = bx * NTHREADS + tid, NGT = G * NTHREADS;
        for (int i = gt; i < MTOK * 88; i += NGT) {
            const int tok = i / 88, f = i % 88;
            float* tb; int F, fl;
            if (f < 8) { tb = ropeA; F = 8; fl = f; } else if (f < 24) { tb = ropeB; F = 16; fl = f - 8; } else { tb = ropeC; F = 64; fl = f - 24; }
            const double rev = (double)positions[tok] * INVF[f] * 0.15915494309189535;
            const float fr = (float)(rev - __builtin_rint(rev));
            *((GAS float*)tb + (size_t)tok * 2 * F + fl) = __builtin_amdgcn_cosf(fr); *((GAS float*)tb + (size_t)tok * 2 * F + F + fl) = __builtin_amdgcn_sinf(fr);
        }
        for (int i = gt; i < 4 * MTOK; i += NGT) *((GAS float*)rss + MTOK + i) = 0.f;
        for (int i = gt; i < 4 * 12 * 16 * 128; i += NGT) *((GAS float*)kmean + i) = 0.f;
        if (bx == 0) for (int i = tid; i < 1024 + XCD_BAR_WORDS; i += NTHREADS) ctl[i] = 0u;
    }
    grid.sync();
    if (tid < 2) misc[8 + tid] = 0u;
    __syncthreads();
    XcdBarrier xbar;
    { unsigned char* ws0 = args.ws; xbar = xcd_barrier_post((unsigned*)(ws0 + WS_CTL) + 1024, misc + 8); }
#define GRID_SYNC() xcd_barrier(xbar)

    const float L2E = 1.4426950408889634f;
#pragma unroll 1
    for (int l = 0; l < 4; ++l) {
        const int mid = (l == 3) ? 0 : l;
        const int nmix = pg8::nmix_of(mid), zoff = nmix + 512;
#pragma unroll 1
#ifndef REP_P1
#define REP_P1 1
#endif
        for (int rep1 = 0; rep1 < REP_P1; ++rep1)
        for (int pass = 0; pass < (l == 0 ? 2 : 1); ++pass) {
            WS_PTRS();
            pg8::Gemm g; pg8::StaticOrder S; pg8::EpiIn E;
            if (pass == 0) {
                g.A = hb; g.Bt = (const bf16_t*)(ws + (l == 0 ? WS_WIN0 : l == 1 ? WS_WIN1 : l == 2 ? WS_WIN2 : WS_WIN3)); g.lda = DMODEL; g.K = DMODEL;
                S.init(MTOK, pg8::npad_of(mid), G, bx);
                E.O = proj; E.ldc = LDP; E.mid = mid; E.rss = rss + (size_t)l * MTOK; E.kmean = kmean;
            } else {
                g.A = memb; g.Bt = wmemT; g.lda = DMODEL; g.K = DMODEL;
                S.init(NB * NMEMTOK, 1024, 1 << 20, bx - (G == 256 ? 240 : 0));
                E.O = mkv; E.ldc = 1024; E.mid = 3; E.rss = rssm; E.kmean = kmean;
            }
            E.rope0 = ropeA;

#ifndef SK_P1
pg8::gemm_phase<pg8::EpiIn, pg8::StaticOrder, true, true>(lds, g, S, E);
#endif

            __syncthreads();
        }
        if (l == 0 && G == 256 && bx >= 128 && bx < 240) {
            WS_PTRS();
            CONV_WEIGHTS(0x066u, (bx - 128) * NWAVES + wid, 112 * NWAVES);
        } else if (l == 2 && G == 256 && bx >= 128) {
            WS_PTRS();
            CONV_WEIGHTS(0x088u, (bx - 128) * NWAVES + wid, 128 * NWAVES);
        }
        GRID_SYNC();

        const int nsub = (mid == 2) ? 2 : 1;
#pragma unroll 1
        for (int sub = 0; sub < nsub; ++sub) {
            int nA, nMem;
            if (mid == 0) { nA = 1536; nMem = 256; } else if (mid == 1) { nA = 96; nMem = 32; } else if (sub == 0) { nA = 192; nMem = 256; } else { nA = 768; nMem = 0; }
#ifndef REP_P2
#define REP_P2 1
#endif
#ifndef REP_MID
#define REP_MID mid
#endif
            const int nrep = (mid == (REP_MID)) ? REP_P2 : 1;
            for (int rep = 0; rep < nrep; ++rep) {
            const bool dry = rep < nrep - 1;
            WS_PTRS();
            unsigned* ctr = ctl + (l * 2 + sub) + 16 * rep;
            if (mid == 1) ctr = ctl + 128 + 64 * (bx & 7) + 16 * rep;
            int u = fetch_unit(ctr, misc, tid);
            if (mid == 0) {
                while (u < nA) {
                    const int hp = u & 3, n = (u >> 2) & 31, r = u >> 7, kvh = r % 3, b = r / 3;
                    const int head = kvh * 8 + hp * 2 + (wid >> 2);
                    const float sink = args.in[l == 0 ? 7 : 17][head] * L2E;
#ifndef SK_SWA
                    attn_unit<64, MODE_SWA>(lds, tid, wid, lane, proj + head * 64, b * SEQ + n * 128 + (wid & 3) * 32, proj + 1536 + kvh * 64, proj + 1728 + kvh * 64, LDP,
                                            n == 0 ? 2 : 4, b * SEQ + n * 128 - (n ? 128 : 0), 0, sink, 1.f, 0u, 0u, proj + zoff + head * 64, dry);
#endif
                    u = fetch_unit(ctr, misc, tid);
                }
            } else if (mid == 1) {
                while (u < nA) {
                    const int qb = 15 - u / 6, bh = (bx & 7) + 8 * (u % 6), b = bh / 12, h = bh % 12;
#ifndef SK_MOBA
                    moba_gate(lds, tid, proj, kmean, b, h, qb);
                    volatile LAS unsigned* selm = (volatile LAS unsigned*)(lds + LDS_MISC - 2048);
                    const unsigned s0 = selm[wid * 32 + (lane & 15)], s1 = selm[wid * 32 + 16 + (lane & 15)];
                    __syncthreads();
                    attn_unit<128, MODE_MOBA>(lds, tid, wid, lane, proj + h * 128, b * SEQ + qb * 256 + wid * 32, proj + 1536 + h * 128, proj + 3072 + h * 128, LDP,
                                              4 + 4 * qb, b * SEQ + qb * 256, b * SEQ, -1e30f, 0.f, s0, s1, proj + zoff + h * 128, dry);
#endif
                    u = fetch_unit(ctr, misc, tid);
                }
            } else if (sub == 0) {
                while (u < nA) {
#ifndef SK_SCAN
                    ret_scan_item(lds, tid, wid, lane, proj, rprev, u);
#endif
                    u = fetch_unit(ctr, misc, tid);
                }
            } else {
                while (u < nA) {
#ifndef SK_ROUT
                    ret_out_unit(lds, tid, wid, lane, proj, rprev, u, dry);
#endif
                    u = fetch_unit(ctr, misc, tid);
                }
            }
            while (u < nA + nMem) {
                const int v = (mid == 1) ? (bx & 7) + 8 * (u - nA) : (u - nA), hm = v & 3, qt = (v >> 2) & 15, b = v >> 6;
#ifndef SK_MEM
                attn_unit<128, MODE_MEM>(lds, tid, wid, lane, proj + nmix + hm * 128, b * SEQ + qt * 256 + wid * 32, mkv + hm * 128, mkv + 512 + hm * 128, 1024,
                                         4, b * NMEMTOK, 0, -1e30f, 0.f, 0u, 0u, proj + zoff + 1536 + hm * 128, dry);
#endif
                u = fetch_unit(ctr, misc, tid);
            }
            GRID_SYNC();
            }
        }

        {
            WS_PTRS(); const float* x = args.in[0]; float* out = args.out;
            pg8::Gemm g; g.A = proj + zoff; g.Bt = woutT + (size_t)l * 2048 * 2048; g.lda = LDP; g.K = DMODEL;
            pg8::StaticOrder S; S.init(MTOK, DMODEL, G, bx);
            pg8::EpiOut E; E.basef = x; E.out = out; E.hb = hb; E.rssn = rss + (size_t)(l + 1) * MTOK; E.mode = (l == 0) ? 0 : (l == 3 ? 2 : 1);

#ifndef SK_P3
pg8::gemm_phase<pg8::EpiOut, pg8::StaticOrder, true, true>(lds, g, S, E);
#endif

            __syncthreads();
        }
        GRID_SYNC();
    }

#ifdef EXTRA_SYNCS
    for (int i = 0; i < EXTRA_SYNCS; ++i) GRID_SYNC();
#endif
    {
        const int gw = bx * NWAVES + wid, NGW = G * NWAVES;
        WS_PTRS(); float* out = args.out;
        int lane_f = lane; asm volatile("" : "+v"(lane_f));
        const float* gf = args.in[19];
        for (int m = gw; m < MTOK; m += NGW) {
            const float s = __builtin_amdgcn_rsqf(*((const GAS float*)rss + 4 * MTOK + m) * (1.0f / DMODEL) + EPSN);
            f32x4* xr = (f32x4*)(out + (size_t)m * DMODEL) + lane_f; const f32x4* gr = (const f32x4*)gf + lane_f;
#pragma unroll
            for (int j = 0; j < 8; ++j) { const f32x4 v = xr[64 * j]; xr[64 * j] = v * s * gr[64 * j]; }
        }
    }
}

extern "C" void kernel_launch(void* const* d_in, const int* in_sizes, int n_in, void* d_out, int out_size, void* d_ws, size_t ws_size, hipStream_t stream) {
    static int grid = 0;
    if (grid == 0) {
        if (n_in != 20 || out_size != MTOK * DMODEL || ws_size < WS_END) { fprintf(stderr, "kernel_launch: unexpected shapes (n_in %d, out %d, ws %zu, need %zu)\n", n_in, out_size, ws_size, (size_t)WS_END); grid = -1; return; }
        int dev = 0, cus = 0, per_cu = 0;
        hipGetDevice(&dev); hipDeviceGetAttribute(&cus, hipDeviceAttributeMultiprocessorCount, dev);
        hipFuncSetAttribute((const void*)trunk_fwd, hipFuncAttributeMaxDynamicSharedMemorySize, LDS_BYTES);
        if (hipOccupancyMaxActiveBlocksPerMultiprocessor(&per_cu, (const void*)trunk_fwd, NTHREADS, LDS_BYTES) != hipSuccess || per_cu < 1) { fprintf(stderr, "kernel_launch: occupancy query gave %d\n", per_cu); per_cu = 1; }
        (void)hipGetLastError();
        grid = cus;
        if (grid != 256) fprintf(stderr, "kernel_launch: note: %d CUs\n", grid);
    }
    if (grid < 0) return;
    Args a{};
    for (int i = 0; i < 20; ++i) a.in[i] = (const float*)d_in[i];
    a.out = (float*)d_out; a.ws = (unsigned char*)d_ws;
    void* kargs[] = {&a};
    hipError_t e = hipLaunchCooperativeKernel((const void*)trunk_fwd, dim3(grid), dim3(NTHREADS), kargs, LDS_BYTES, stream);
    if (e != hipSuccess) fprintf(stderr, "cooperative launch failed: %s (grid %d)\n", hipGetErrorString(e), grid);
}
```

```cpp
#include <hip/hip_runtime.h>
#include <hip/hip_cooperative_groups.h>
#include <cstdio>
#include <cstdint>
namespace cg = cooperative_groups;
#define GAS __attribute__((address_space(1)))
namespace pg8 {
#define PG8_LAS __attribute__((address_space(3)))
typedef unsigned short bf16_t;
typedef short bf16x8 __attribute__((ext_vector_type(8)));
typedef float f32x4 __attribute__((ext_vector_type(4)));
typedef unsigned u32x4 __attribute__((ext_vector_type(4)));
constexpr int BM = 256, BK = 64, HALF = 128, HTB = HALF * BK * 2  , STAGE_BYTES = 8 * HTB, NXCD = 8, WGM = 4;

__host__ __device__ __forceinline__ int lds_byte(int r, int c) { const int st = (r >> 4) * 2 + (c >> 5), rr = r & 15, cc = c & 31, ob = rr * 64 + cc * 2; return st * 1024 + (ob ^ (((ob >> 9) & 1) << 5)); }
__host__ __device__ __forceinline__ void stage_rc(int b, int& R, int& C) { const int st = b / 1024, sb = b % 1024, swz = sb ^ (((sb >> 9) & 1) << 5); R = (st >> 1) * 16 + swz / 64; C = (st & 1) * 32 + (swz % 64) / 2; }
__host__ __device__ __forceinline__ int perm32(int rho) { const int n = rho >> 4, i = rho & 15; return 8 * (i >> 2) + 4 * n + (i & 3); }

struct Unit { int pm, pn; };
struct Gemm { const bf16_t* A; const bf16_t* Bt; int lda, K; };

struct StaticOrder {
    int nM, nN, nwg, G, c;
    __host__ __device__ void init(int M, int N, int G_, int c_) { nM = M / BM; nN = N / BM; nwg = nM * nN; G = G_; c = c_; }
    __host__ __device__ bool next(int i, Unit& u) const {
        const long L = (long)i * G + c; if (L >= nwg || c < 0) return false;
        int wgid = (int)L; const int xcd0 = wgid % NXCD; { const int q = nwg / NXCD, r = nwg % NXCD, xcd = wgid % NXCD, off = wgid / NXCD; wgid = (xcd < r ? xcd * (q + 1) : r * (q + 1) + (xcd - r) * q) + off; }
        const int nig = WGM * nN, gid = wgid / nig, fm = gid * WGM, gsz = (nM - fm) < WGM ? (nM - fm) : WGM;
        u.pm = fm + ((wgid % nig) % gsz); u.pn = (wgid % nig) / gsz;
        if (nwg % NXCD == 0 && (nwg / NXCD) % (WGM * nN) == 0) u.pn = (u.pn + xcd0 * nN / NXCD) % nN;
        return true;
    }
    __device__ __forceinline__ void a_ready(const Unit&) const {}
    __device__ __forceinline__ void done(const Unit&) const {}
};

__device__ __forceinline__ unsigned cvt_pk_bf16(float lo, float hi) { unsigned r; asm volatile("v_cvt_pk_bf16_f32 %0, %1, %2" : "=v"(r) : "v"(lo), "v"(hi)); return r; }
constexpr int NB = 4, SEQ = 4096, DMODEL = 2048, MTOK = NB * SEQ, NMEMTOK = 256, LDP = 7168;
constexpr float EPSN = 1e-6f;
__host__ __device__ constexpr int nc_of(int mid)   { return mid == 0 ? 4480 : (mid == 1 ? 7168 : 5632); }
__host__ __device__ constexpr int npad_of(int mid) { return mid == 0 ? 4608 : (mid == 1 ? 7168 : 5632); }
__host__ __device__ constexpr int nmix_of(int mid) { return mid == 0 ? 1920 : (mid == 1 ? 4608 : 3072); }

struct GDesc { int dst0, dst1, rope, rstr; float scale; };
__device__ __forceinline__ GDesc gdesc(int mid, int j0) {
    GDesc d; d.dst0 = j0; d.dst1 = j0 + 4; d.rope = -1; d.rstr = 0; d.scale = 1.f;
    const float L2E = 1.4426950408889634f, R128 = 0.08838834764831845f;
    if (mid == 0) {
        if (j0 >= 4480) { d.dst0 = -1; return d; }
        if (j0 < 1728) { const int hb = j0 & ~63, lg = (j0 & 63) >> 3;
            if (lg < 2) { d.dst0 = hb + 4 * lg; d.dst1 = hb + 8 + 4 * lg; d.rope = 4 * lg; d.rstr = 16; }
            if (j0 < 1536) d.scale = 0.125f * L2E; }
        else if (j0 >= 1920 && j0 < 2432) d.scale = R128 * L2E;
    } else if (mid == 1) {
        if (j0 < 3072) { const int hb = j0 & ~127, lg = (j0 & 127) >> 3;
            if (lg < 4) { d.dst0 = hb + 4 * lg; d.dst1 = hb + 16 + 4 * lg; d.rope = MTOK * 16 + 4 * lg; d.rstr = 32; }
            if (j0 < 1536) d.scale = R128 * L2E; }
        else if (j0 >= 4608 && j0 < 5120) d.scale = R128 * L2E;
    } else if (mid == 2) {
        if (j0 < 1536) { const int hb = j0 & ~127, lg = (j0 & 127) >> 3;
            d.dst0 = hb + 4 * lg; d.dst1 = hb + 64 + 4 * lg; d.rope = MTOK * 48 + 4 * lg; d.rstr = 128;
            if (j0 >= 768) d.scale = R128; }
        else if (j0 >= 3072 && j0 < 3584) d.scale = R128 * L2E;
    }
    return d;
}
__device__ __forceinline__ int src_col(int mid, int j) { const GDesc d = gdesc(mid, j & ~7); if (d.dst0 < 0) return -1; return (j & 4) ? d.dst1 + (j & 3) : d.dst0 + (j & 3); }

typedef unsigned u32x2 __attribute__((ext_vector_type(2)));
struct EpiIn {
    static constexpr bool PERM = true, AFTER_DRAIN = false;
    bf16_t* O; int ldc, mid; const float* rss; const float* rope0; float* kmean;
    __device__ __forceinline__ void operator()(const f32x4 (&acc)[2][2][4][2], const Unit& u, int wr, int wc, int fr, int fq) const {
        const int row0 = u.pm * BM + wr * 64 + fr;
        const bool ksum = (mid == 1) && (u.pn >= 6) && (u.pn < 12);
        float cs[2][8];
#pragma unroll
        for (int bj = 0; bj < 2; ++bj)
#pragma unroll
            for (int e = 0; e < 8; ++e) cs[bj][e] = 0.f;
        GDesc d[2];
#pragma unroll
        for (int bj = 0; bj < 2; ++bj) d[bj] = gdesc(mid, u.pn * BM + bj * HALF + wc * 32 + 8 * fq);
#pragma unroll
        for (int ai = 0; ai < 2; ++ai)
#pragma unroll
            for (int m = 0; m < 4; ++m) {
                const int r = row0 + ai * HALF + m * 16;
                const float s = __builtin_amdgcn_rsqf(*((const GAS float*)rss + r) * (1.0f / DMODEL) + EPSN);
                bf16_t* rowp = O + (size_t)r * ldc;
#pragma unroll
                for (int bj = 0; bj < 2; ++bj) {
                    if (d[bj].dst0 < 0) continue;
                    const float sc = s * d[bj].scale;
                    f32x4 v0 = acc[ai][bj][m][0] * sc, v1 = acc[ai][bj][m][1] * sc;
                    if (d[bj].rope >= 0) {
                        const float* t = rope0 + d[bj].rope + (size_t)r * d[bj].rstr; const int F = d[bj].rstr >> 1;
                        const f32x4 c = *(const GAS f32x4*)t, sn = *(const GAS f32x4*)(t + F);
                        const f32x4 n0 = v0 * c - v1 * sn, n1 = v1 * c + v0 * sn; v0 = n0; v1 = n1;
                    }
                    if (ksum) {
#pragma unroll
                        for (int e = 0; e < 4; ++e) { cs[bj][e] += v0[e]; cs[bj][4 + e] += v1[e]; }
                    }
                    u32x2 w0, w1; w0.x = cvt_pk_bf16(v0[0], v0[1]); w0.y = cvt_pk_bf16(v0[2], v0[3]); w1.x = cvt_pk_bf16(v1[0], v1[1]); w1.y = cvt_pk_bf16(v1[2], v1[3]);
                    if (d[bj].dst1 == d[bj].dst0 + 4) { u32x4 w; w.x = w0.x; w.y = w0.y; w.z = w1.x; w.w = w1.y; *(GAS u32x4*)(rowp + d[bj].dst0) = w; }
                    else { *(GAS u32x2*)(rowp + d[bj].dst0) = w0; *(GAS u32x2*)(rowp + d[bj].dst1) = w1; }
                }
            }
        if (ksum) {
            float* kb = kmean + (size_t)((u.pm >> 4) * 12 * 16 + (u.pm & 15)) * 128;
#pragma unroll
            for (int bj = 0; bj < 2; ++bj)
#pragma unroll
                for (int e = 0; e < 8; ++e) {
                    float v = cs[bj][e];
                    v += __shfl_xor(v, 1); v += __shfl_xor(v, 2); v += __shfl_xor(v, 4); v += __shfl_xor(v, 8);
                    const int col = ((e < 4) ? d[bj].dst0 + e : d[bj].dst1 + e - 4) - 1536, h = col >> 7, dd = col & 127;
                    if (fr == 0) (void)__hip_atomic_fetch_add((GAS float*)(kb + (size_t)h * 16 * 128 + dd), v * (1.0f / 256.0f), __ATOMIC_RELAXED, __HIP_MEMORY_SCOPE_AGENT);
                }
        }
    }
};
struct EpiOut {
    static constexpr bool PERM = true, AFTER_DRAIN = false;
    const float* basef; float* out; bf16_t* hb; float* rssn; int mode;
    __device__ __forceinline__ void operator()(const f32x4 (&acc)[2][2][4][2], const Unit& u, int wr, int wc, int fr, int fq) const {
        const int row0 = u.pm * BM + wr * 64 + fr, col0 = u.pn * BM + wc * 32 + 8 * fq;
#pragma unroll
        for (int ai = 0; ai < 2; ++ai)
#pragma unroll
            for (int m = 0; m < 4; ++m) {
                const int r = row0 + ai * HALF + m * 16; float ss = 0.f;
#pragma unroll
                for (int bj = 0; bj < 2; ++bj) {
                    const size_t off = (size_t)r * DMODEL + col0 + bj * HALF;
                    f32x4 b0, b1;
                    if (mode == 0) { b0 = *(const GAS f32x4*)(basef + off); b1 = *(const GAS f32x4*)(basef + off + 4); }
                    else { const u32x4 hw = *(const GAS u32x4*)(hb + off);
                        b0 = (f32x4){__builtin_bit_cast(float, hw.x << 16), __builtin_bit_cast(float, hw.x & 0xffff0000u), __builtin_bit_cast(float, hw.y << 16), __builtin_bit_cast(float, hw.y & 0xffff0000u)};
                        b1 = (f32x4){__builtin_bit_cast(float, hw.z << 16), __builtin_bit_cast(float, hw.z & 0xffff0000u), __builtin_bit_cast(float, hw.w << 16), __builtin_bit_cast(float, hw.w & 0xffff0000u)}; }
                    const f32x4 v0 = acc[ai][bj][m][0] + b0, v1 = acc[ai][bj][m][1] + b1;
                    if (mode == 2) { *(GAS f32x4*)(out + off) = v0; *(GAS f32x4*)(out + off + 4) = v1; }
                    else { u32x4 w; w.x = cvt_pk_bf16(v0[0], v0[1]); w.y = cvt_pk_bf16(v0[2], v0[3]); w.z = cvt_pk_bf16(v1[0], v1[1]); w.w = cvt_pk_bf16(v1[2], v1[3]);
                        *(GAS u32x4*)(hb + off) = w; }
                    ss += (v0[0] * v0[0] + v0[1] * v0[1]) + (v0[2] * v0[2] + v0[3] * v0[3]) + (v1[0] * v1[0] + v1[1] * v1[1]) + (v1[2] * v1[2] + v1[3] * v1[3]);
                }
                ss += __shfl_xor(ss, 16); ss += __shfl_xor(ss, 32);
                if (fq == 0) (void)__hip_atomic_fetch_add((GAS float*)(rssn + r), ss, __ATOMIC_RELAXED, __HIP_MEMORY_SCOPE_AGENT);
                if (m & 1) asm volatile("" ::: "memory");
            }
    }
};

template <class Epi, class Sched, bool ALIGN_EPI = false, bool SP2 = false>
__device__ __forceinline__ void gemm_phase(PG8_LAS unsigned char* lds, const Gemm g, const Sched& S, const Epi& E) {
    int tid_ = threadIdx.x; asm volatile("" : "+v"(tid_));
    const int tid = tid_, wid = __builtin_amdgcn_readfirstlane(tid >> 6), lane = tid & 63, wr = wid >> 2, wc = wid & 3, fr = lane & 15, fq = lane >> 4;
    const int K = g.K, nt = K / BK;
    unsigned voffA[2], voffB[2];
#pragma unroll
    for (int i = 0; i < 2; ++i) { int R, C; stage_rc(tid * 16 + i * 8192, R, C); const int Rb = Epi::PERM ? ((R & ~31) + perm32(R & 31)) : R;
        voffA[i] = (unsigned)(R * g.lda + C) * 2u; voffB[i] = (unsigned)(Rb * K + C) * 2u; }
    const size_t kstep = (size_t)(BK * 2);
    const size_t hstepA = (size_t)HALF * g.lda * 2, hstepB = (size_t)HALF * K * 2;
    const size_t tstepA = 2 * hstepA, tstepB = 2 * hstepB;
    const unsigned ldsw = (unsigned)wid * 1024u;
    const int aoff = lds_byte(wr * 64 + fr, fq * 8), boff = lds_byte(wc * 32 + fr, fq * 8);
#define PG8_SA(b, h) (((b) * 2 + (h)) * HTB)
#define PG8_SB(b, h) ((4 + (b) * 2 + (h)) * HTB)
#define PG8_STAGE(bufoff, gbase, voff) do { _Pragma("unroll") for (int _i = 0; _i < 2; ++_i) \
        __builtin_amdgcn_global_load_lds((const unsigned*)((const char*)(gbase) + (voff)[_i]), (PG8_LAS unsigned*)(lds + (bufoff) + ldsw + _i * 8192), 16, 0, 0); } while (0)
#define PG8_LDA(dst, b, h) do { _Pragma("unroll") for (int m = 0; m < 4; ++m) _Pragma("unroll") for (int k = 0; k < 2; ++k) dst[m][k] = *(const PG8_LAS bf16x8*)(lds + PG8_SA(b, h) + aoff + m * 2048 + k * 1024); } while (0)
#define PG8_LDB(dst, b, h) do { _Pragma("unroll") for (int n = 0; n < 2; ++n) _Pragma("unroll") for (int k = 0; k < 2; ++k) dst[n][k] = *(const PG8_LAS bf16x8*)(lds + PG8_SB(b, h) + boff + n * 2048 + k * 1024); } while (0)
#define PG8_MMA(ai, bj, At, Bt) do { __builtin_amdgcn_s_setprio(1); _Pragma("unroll") for (int m = 0; m < 4; ++m) _Pragma("unroll") for (int n = 0; n < 2; ++n) _Pragma("unroll") for (int k = 0; k < 2; ++k) \
        acc[ai][bj][m][n] = __builtin_amdgcn_mfma_f32_16x16x32_bf16(Bt[n][k], At[m][k], acc[ai][bj][m][n], 0, 0, 0); __builtin_amdgcn_s_setprio(0); } while (0)
#define PG8_WAIT_V(n) asm volatile("s_waitcnt vmcnt(" #n ")" ::: "memory")
#define PG8_WAIT_L(n) asm volatile("s_waitcnt lgkmcnt(" #n ")" ::: "memory")
#define PG8_BAR __builtin_amdgcn_s_barrier()
#define PG8_SCHED __builtin_amdgcn_sched_barrier(0)
    Unit cur, nxt; int ui = 0;
    if (!S.next(0, cur)) return;
    f32x4 acc[2][2][4][2];
#pragma unroll
    for (int a = 0; a < 2; ++a)
#pragma unroll
        for (int b = 0; b < 2; ++b)
#pragma unroll
            for (int m = 0; m < 4; ++m)
#pragma unroll
                for (int n = 0; n < 2; ++n) acc[a][b][m][n] = (f32x4){0.f, 0.f, 0.f, 0.f};
    bf16x8 At[4][2], B0[2][2], B1[2][2];
    const char* cA = (const char*)g.A + (size_t)cur.pm * tstepA; const char* cB = (const char*)g.Bt + (size_t)cur.pn * tstepB;
    S.a_ready(cur);
    if constexpr (SP2) {
        PG8_STAGE(PG8_SB(0, 0), cB, voffB); PG8_STAGE(PG8_SB(0, 1), cB + hstepB, voffB); PG8_STAGE(PG8_SA(0, 0), cA, voffA); PG8_STAGE(PG8_SA(0, 1), cA + hstepA, voffA);
        if (wr == 1) PG8_BAR;
        PG8_WAIT_V(2); PG8_BAR;
        PG8_STAGE(PG8_SB(1, 0), cB + kstep, voffB); PG8_STAGE(PG8_SA(1, 0), cA + kstep, voffA); PG8_STAGE(PG8_SB(1, 1), cB + hstepB + kstep, voffB);
        PG8_WAIT_V(6); PG8_BAR;
    } else {
        PG8_STAGE(PG8_SB(0, 0), cB, voffB); PG8_STAGE(PG8_SA(0, 0), cA, voffA); PG8_STAGE(PG8_SB(0, 1), cB + hstepB, voffB); PG8_STAGE(PG8_SA(0, 1), cA + hstepA, voffA);
        if (wr == 1) PG8_BAR;
        PG8_WAIT_V(4); PG8_BAR;
        PG8_STAGE(PG8_SB(1, 0), cB + kstep, voffB); PG8_STAGE(PG8_SA(1, 0), cA + kstep, voffA); PG8_STAGE(PG8_SB(1, 1), cB + hstepB + kstep, voffB);
        PG8_WAIT_V(6); PG8_BAR;
    }
    for (;;) {
        const bool has_next = S.next(ui + 1, nxt);
        const char* nA = has_next ? (const char*)g.A + (size_t)nxt.pm * tstepA : cA; const char* nB = has_next ? (const char*)g.Bt + (size_t)nxt.pn * tstepB : cB;
        for (int t = 0; t < nt; t += 2) {
            const bool last = (t == nt - 2);
            const char* a1 = cA + (size_t)(t + 1) * kstep;
            const char* a2 = last ? nA : cA + (size_t)(t + 2) * kstep; const char* b2 = last ? nB : cB + (size_t)(t + 2) * kstep;
            const char* a3 = a2 + kstep; const char* b3 = b2 + kstep;
            if (last && has_next) S.a_ready(nxt);
            if constexpr (SP2) {
            PG8_LDB(B0, 0, 0); PG8_LDB(B1, 0, 1); PG8_SCHED; PG8_LDA(At, 0, 0); PG8_STAGE(PG8_SA(1, 1), a1 + hstepA, voffA);
            PG8_WAIT_V(8); PG8_WAIT_L(0); PG8_BAR; PG8_MMA(0, 0, At, B0); PG8_MMA(0, 1, At, B1); PG8_BAR; PG8_SCHED;
            PG8_LDA(At, 0, 1); PG8_STAGE(PG8_SB(0, 0), b2, voffB); PG8_STAGE(PG8_SB(0, 1), b2 + hstepB, voffB); PG8_STAGE(PG8_SA(0, 0), a2, voffA);
            PG8_WAIT_V(8); PG8_WAIT_L(0); PG8_BAR; PG8_MMA(1, 0, At, B0); PG8_MMA(1, 1, At, B1); PG8_BAR; PG8_SCHED;
            PG8_LDB(B0, 1, 0); PG8_LDB(B1, 1, 1); PG8_SCHED; PG8_LDA(At, 1, 0); PG8_STAGE(PG8_SA(0, 1), a2 + hstepA, voffA);
            PG8_WAIT_V(8); PG8_WAIT_L(0); PG8_BAR; PG8_MMA(0, 0, At, B0); PG8_MMA(0, 1, At, B1); PG8_BAR; PG8_SCHED;
            PG8_LDA(At, 1, 1); PG8_STAGE(PG8_SB(1, 0), b3, voffB); PG8_STAGE(PG8_SB(1, 1), b3 + hstepB, voffB); PG8_STAGE(PG8_SA(1, 0), a3, voffA);
            PG8_WAIT_V(8); PG8_WAIT_L(0); PG8_BAR; PG8_MMA(1, 0, At, B0); PG8_MMA(1, 1, At, B1); PG8_BAR; PG8_SCHED;
            } else {
            PG8_LDB(B0, 0, 0); PG8_SCHED; PG8_LDA(At, 0, 0); PG8_STAGE(PG8_SA(1, 1), a1 + hstepA, voffA);
            PG8_WAIT_L(8); PG8_BAR; PG8_WAIT_L(0); PG8_MMA(0, 0, At, B0); PG8_BAR; PG8_SCHED;
            PG8_LDB(B1, 0, 1); PG8_STAGE(PG8_SB(0, 0), b2, voffB);
            PG8_BAR; PG8_WAIT_L(0); PG8_MMA(0, 1, At, B1); PG8_BAR;
            PG8_LDA(At, 0, 1); PG8_STAGE(PG8_SA(0, 0), a2, voffA);
            PG8_BAR; PG8_WAIT_L(0); PG8_MMA(1, 0, At, B0); PG8_BAR; PG8_SCHED;
            PG8_STAGE(PG8_SB(0, 1), b2 + hstepB, voffB);
            PG8_WAIT_V(6); PG8_BAR; PG8_MMA(1, 1, At, B1); PG8_BAR;
            PG8_LDB(B0, 1, 0); PG8_SCHED; PG8_LDA(At, 1, 0); PG8_STAGE(PG8_SA(0, 1), a2 + hstepA, voffA);
            PG8_WAIT_L(8); PG8_BAR; PG8_WAIT_L(0); PG8_MMA(0, 0, At, B0); PG8_BAR; PG8_SCHED;
            PG8_LDB(B1, 1, 1); PG8_STAGE(PG8_SB(1, 0), b3, voffB);
            PG8_BAR; PG8_WAIT_L(0); PG8_MMA(0, 1, At, B1); PG8_BAR;
            PG8_LDA(At, 1, 1); PG8_STAGE(PG8_SA(1, 0), a3, voffA);
            PG8_BAR; PG8_WAIT_L(0); PG8_MMA(1, 0, At, B0); PG8_BAR; PG8_SCHED;
            PG8_STAGE(PG8_SB(1, 1), b3 + hstepB, voffB);
            PG8_WAIT_V(6); PG8_BAR; PG8_MMA(1, 1, At, B1); PG8_BAR;
            }
        }
        if constexpr (ALIGN_EPI) { if (wr == 0) PG8_BAR; }
        if constexpr (!Epi::AFTER_DRAIN) { E(acc, cur, wr, wc, fr, fq); S.done(cur); }
        if (!has_next) break;
#pragma unroll
        for (int a = 0; a < 2; ++a)
#pragma unroll
            for (int b = 0; b < 2; ++b)
#pragma unroll
                for (int m = 0; m < 4; ++m)
#pragma unroll
                    for (int n = 0; n < 2; ++n) acc[a][b][m][n] = (f32x4){0.f, 0.f, 0.f, 0.f};
        cur = nxt; cA = nA; cB = nB; ++ui;
        if constexpr (ALIGN_EPI) { if (wr == 1) PG8_BAR; }
    }
    PG8_WAIT_V(0);
    if constexpr (!ALIGN_EPI) { if (wr == 0) PG8_BAR; }
    PG8_BAR;
    if constexpr (Epi::AFTER_DRAIN) { E.fused(acc, cur, wr, wc, fr, fq, lds, wid, lane); S.done(cur); }
#undef PG8_SA
#undef PG8_SB
#undef PG8_STAGE
#undef PG8_LDA
#undef PG8_LDB
#undef PG8_MMA
#undef PG8_WAIT_V
#undef PG8_WAIT_L
#undef PG8_BAR
#undef PG8_SCHED
}
}

using pg8::bf16_t; using pg8::bf16x8; using pg8::f32x4; using pg8::u32x4; using pg8::u32x2; using pg8::cvt_pk_bf16;
using pg8::NB; using pg8::SEQ; using pg8::DMODEL; using pg8::MTOK; using pg8::NMEMTOK; using pg8::LDP; using pg8::EPSN;
#define LAS __attribute__((address_space(3)))
typedef short s16x4 __attribute__((ext_vector_type(4)));
typedef float f32x2 __attribute__((ext_vector_type(2)));

constexpr int NTHREADS = 512, NWAVES = 8;
constexpr int LDS_BYTES = 147456;
constexpr int LDS_MISC = 139264;

constexpr size_t al256(size_t x) { return (x + 255) & ~(size_t)255; }
constexpr size_t WS_CTL   = 0;
constexpr size_t WS_WIN0  = 1u << 20;
constexpr size_t WS_WIN1  = WS_WIN0 + (size_t)4608 * 2048 * 2;
constexpr size_t WS_WIN2  = WS_WIN1 + (size_t)7168 * 2048 * 2;
constexpr size_t WS_WIN3  = WS_WIN2 + (size_t)5632 * 2048 * 2;
constexpr size_t WS_WOUT  = WS_WIN3 + (size_t)4608 * 2048 * 2;
constexpr size_t WS_WMEM  = WS_WOUT + (size_t)4 * 2048 * 2048 * 2;
constexpr size_t WS_HB    = WS_WMEM + (size_t)1024 * 2048 * 2;
constexpr size_t WS_PROJ  = WS_HB + (size_t)MTOK * 2048 * 2;
constexpr size_t WS_MEMB  = WS_PROJ + (size_t)MTOK * LDP * 2;
constexpr size_t WS_MKV   = WS_MEMB + (size_t)1024 * 2048 * 2;
constexpr size_t WS_RSS   = WS_MKV + (size_t)1024 * 1024 * 2;
constexpr size_t WS_RSSM  = WS_RSS + (size_t)5 * MTOK * 4;
constexpr size_t WS_ROPEA = WS_RSSM + 4096;
constexpr size_t WS_ROPEB = WS_ROPEA + (size_t)MTOK * 16 * 4;
constexpr size_t WS_ROPEC = WS_ROPEB + (size_t)MTOK * 32 * 4;
constexpr size_t WS_KMEAN = WS_ROPEC + (size_t)MTOK * 128 * 4;
constexpr size_t WS_RPREV = WS_KMEAN + (size_t)4 * 12 * 16 * 128 * 4;
constexpr size_t WS_END   = WS_RPREV + (size_t)4 * 32 * 6 * 256 * 128 * 2;

__constant__ double INVF[88] = {
 1.0, 0.19392274474868576, 0.03760603093086393, 0.007292664737217109, 0.001414213562373095, 0.0002742481756762073, 5.318295896944988e-05, 1.031338537721246e-05,
 1.0, 0.44036660267178046, 0.19392274474868576, 0.08539710028576561, 0.03760603093086393, 0.016560440080994446, 0.007292664737217109, 0.003211445994752591, 0.001414213562373095, 0.000622772421914596, 0.0002742481756762073, 0.00012076973741146504, 5.318295896944988e-05, 2.341999896140934e-05, 1.031338537721246e-05, 4.5416704806078695e-06,
 1.0, 0.8659643233600653, 0.7498942093324559, 0.6493816315762113, 0.5623413251903491, 0.4869675251658631, 0.4216965034285822, 0.3651741272548377, 0.31622776601683794, 0.27384196342643613, 0.23713737056616552, 0.2053525026457146, 0.1778279410038923, 0.1539926526059492, 0.1333521432163324, 0.11547819846894582, 0.1, 0.08659643233600653, 0.07498942093324558, 0.06493816315762113, 0.05623413251903491, 0.04869675251658631, 0.042169650342858224, 0.03651741272548377, 0.03162277660168379, 0.027384196342643614, 0.023713737056616554, 0.02053525026457146, 0.01778279410038923, 0.01539926526059492, 0.01333521432163324, 0.011547819846894581, 0.01, 0.008659643233600654, 0.007498942093324558, 0.006493816315762113, 0.005623413251903491, 0.004869675251658631, 0.004216965034285823, 0.003651741272548377, 0.0031622776601683794, 0.0027384196342643613, 0.0023713737056616554, 0.002053525026457146, 0.0017782794100389228, 0.001539926526059492, 0.001333521432163324, 0.0011547819846894581, 0.001, 0.0008659643233600654, 0.0007498942093324559, 0.0006493816315762113, 0.0005623413251903491, 0.0004869675251658631, 0.00042169650342858224, 0.0003651741272548377, 0.00031622776601683794, 0.0002738419634264361, 0.00023713737056616554, 0.0002053525026457146, 0.00017782794100389227, 0.0001539926526059492, 0.0001333521432163324, 0.00011547819846894582 };
__device__ __forceinline__ float log2gamma(int h) {
    return h == 0 ? -0.04580368961312479f : h == 1 ? -0.02612928206836121f : h == 2 ? -0.014949433599796901f : h == 3 ? -0.008567249848519122f : h == 4 ? -0.004914372264518986f : -0.002820519062378663f;
}

#define LDS_WAIT() asm volatile("s_waitcnt lgkmcnt(0)" ::: "memory")
__device__ __forceinline__ unsigned f2bf(float f) { unsigned u = __builtin_bit_cast(unsigned, f); return (u + 0x7fffu + ((u >> 16) & 1u)) >> 16; }
__device__ __forceinline__ unsigned pk2(float lo, float hi) { return f2bf(lo) | (f2bf(hi) << 16); }
__device__ __forceinline__ float bflo(unsigned w) { return __builtin_bit_cast(float, w << 16); }
__device__ __forceinline__ float bfhi(unsigned w) { return __builtin_bit_cast(float, w & 0xffff0000u); }
__device__ __forceinline__ float wave_sum(float v) {
#pragma unroll
    for (int o = 1; o < 64; o <<= 1) v += __shfl_xor(v, o);
    return v;
}
__device__ __forceinline__ float fexp2(float x) { return __builtin_amdgcn_exp2f(x); }
__device__ __forceinline__ s16x4 vtr(const LAS unsigned char* p) { return __builtin_bit_cast(s16x4, __builtin_amdgcn_ds_read_tr16_b64_v4i16((LAS s16x4*)p)); }
__device__ __forceinline__ bf16x8 cat8(s16x4 a, s16x4 b) { bf16x8 r; r[0] = a[0]; r[1] = a[1]; r[2] = a[2]; r[3] = a[3]; r[4] = b[0]; r[5] = b[1]; r[6] = b[2]; r[7] = b[3]; return r; }
typedef float f32x2_t __attribute__((ext_vector_type(2)));
typedef __bf16 bf16x2_t __attribute__((ext_vector_type(2)));
__device__ __forceinline__ unsigned cvtpk(float lo, float hi) { f32x2_t v = {lo, hi}; bf16x2_t b = __builtin_convertvector(v, bf16x2_t); return __builtin_bit_cast(unsigned, b); }
__device__ __forceinline__ float xmax16(float x) { const auto r = __builtin_amdgcn_permlane16_swap(__builtin_bit_cast(unsigned, x), __builtin_bit_cast(unsigned, x), false, false); return fmaxf(__builtin_bit_cast(float, r[0]), __builtin_bit_cast(float, r[1])); }
__device__ __forceinline__ float xmax32(float x) { const auto r = __builtin_amdgcn_permlane32_swap(__builtin_bit_cast(unsigned, x), __builtin_bit_cast(unsigned, x), false, false); return fmaxf(__builtin_bit_cast(float, r[0]), __builtin_bit_cast(float, r[1])); }
__device__ __forceinline__ bf16x8 pack8s(f32x4 a, f32x4 b) { u32x4 w; w.x = cvtpk(a[0], a[1]); w.y = cvtpk(a[2], a[3]); w.z = cvtpk(b[0], b[1]); w.w = cvtpk(b[2], b[3]); return __builtin_bit_cast(bf16x8, w); }
__device__ __forceinline__ bf16x8 pack8(f32x4 a, f32x4 b) { u32x4 w; w.x = cvt_pk_bf16(a[0], a[1]); w.y = cvt_pk_bf16(a[2], a[3]); w.z = cvt_pk_bf16(b[0], b[1]); w.w = cvt_pk_bf16(b[2], b[3]); return __builtin_bit_cast(bf16x8, w); }
__device__ __forceinline__ float silu_mul(float o, float z) { return o * z * __builtin_amdgcn_rcpf(1.0f + fexp2(-1.4426950408889634f * z)); }

__device__ __forceinline__ void transpose_item(const float* W, int N, int mid, const float* gvec, bf16_t* WT, int nblk, int item, int lane, LAS float* scr) {
    const int kb = item / nblk, nb = item % nblk, k0 = 64 * kb, n0 = 64 * nb;
    const int c4 = lane & 15, r4 = lane >> 4, j = n0 + 4 * c4;
    const int sc = (mid < 0) ? j : pg8::src_col(mid, j);
    f32x4 v[16];
#pragma unroll
    for (int i = 0; i < 16; ++i) { v[i] = (f32x4){0.f, 0.f, 0.f, 0.f}; if (sc >= 0) v[i] = *(const GAS f32x4*)(W + (size_t)(k0 + 4 * i + r4) * N + sc); }
#pragma unroll
    for (int i = 0; i < 16; ++i) { const int kk = 4 * i + r4; const float gk = gvec ? gvec[k0 + kk] : 1.0f; LAS float* d = scr + kk * 65 + 4 * c4;
        d[0] = v[i][0] * gk; d[1] = v[i][1] * gk; d[2] = v[i][2] * gk; d[3] = v[i][3] * gk; }
    LDS_WAIT(); asm volatile("" ::: "memory");
    const int c = lane & 7;
#pragma unroll
    for (int jj = 0; jj < 8; ++jj) { const int n = (lane >> 3) + 8 * jj; const LAS float* sp = scr + (8 * c) * 65 + n;
        u32x4 o; o.x = pk2(sp[0 * 65], sp[1 * 65]); o.y = pk2(sp[2 * 65], sp[3 * 65]); o.z = pk2(sp[4 * 65], sp[5 * 65]); o.w = pk2(sp[6 * 65], sp[7 * 65]);
        *(GAS u32x4*)(WT + (size_t)(n0 + n) * 2048 + k0 + 8 * c) = o; }
    LDS_WAIT(); asm volatile("" ::: "memory");
}
__device__ __forceinline__ void row_to_bf16(const float* xrow, bf16_t* orow, float* rss, int lane) {
    const f32x4* xr = (const f32x4*)xrow + lane; float s = 0.f;
    GAS u32x2* o8 = (GAS u32x2*)orow + lane;
#pragma unroll
    for (int j = 0; j < 8; ++j) { const f32x4 v = xr[64 * j]; s += (v.x * v.x + v.y * v.y) + (v.z * v.z + v.w * v.w);
        u32x2 w; w.x = pk2(v.x, v.y); w.y = pk2(v.z, v.w); o8[64 * j] = w; }
    s = wave_sum(s);
    if (lane == 0) *(GAS float*)rss = s;
}

enum { MODE_SWA = 0, MODE_MOBA = 1, MODE_MEM = 2 };
template <int DH, int MODE>
__device__ __forceinline__ void attn_unit(LAS unsigned char* lds, int tid, int wid, int lane,
        const bf16_t* Q,
        int qrow0,
        const bf16_t* Kb, const bf16_t* Vb, int ldkv,
        int nt, int krow_a, int krow_b,
        float m_init, float l_init, unsigned sel0, unsigned sel1,
        bf16_t* Zy,
        bool dry = false)
{
    asm volatile("" : "+v"(tid), "+v"(lane)); asm volatile("" : "+s"(wid));
    constexpr int KSTR = DH * 2 + 16, VSTR = DH * 2 + 32, KBYTES = 64 * KSTR, VBYTES = 64 * VSTR, STG = KBYTES + VBYTES;
    constexpr int CPR = DH / 8  , CPT = (64 * CPR) / NTHREADS  ;
    constexpr int NK = DH / 32, NDB = DH / 16;
    const int g = lane >> 4, l15 = lane & 15, q4 = l15 >> 2, p4 = l15 & 3;
    bf16x8 Qf[2][NK];
#pragma unroll
    for (int j = 0; j < 2; ++j)
#pragma unroll
        for (int k = 0; k < NK; ++k) Qf[j][k] = *(const GAS bf16x8*)(Q + (size_t)(qrow0 + j * 16 + l15) * LDP + k * 32 + g * 8);
    f32x4 O[NDB][2];
#pragma unroll
    for (int db = 0; db < NDB; ++db) { O[db][0] = (f32x4){0.f, 0.f, 0.f, 0.f}; O[db][1] = (f32x4){0.f, 0.f, 0.f, 0.f}; }
    const float m0 = (MODE == MODE_SWA) ? m_init : 0.f;
    float mrow[2] = {m0, m0}, lrow[2] = {g == 0 ? l_init : 0.f, g == 0 ? l_init : 0.f};
    bool first = (MODE != MODE_SWA);
    const unsigned sel[2] = {sel0, sel1};

    u32x4 kreg[2][CPT], vreg[2][CPT];
#define ATT_KROW(it) ((MODE == MODE_MOBA && (it) >= 4) ? (krow_b + 64 * ((it) - 4)) : (krow_a + 64 * (it)))
#define ATT_ISSUE(hf_, it) do { const int kr_ = ATT_KROW(it); _Pragma("unroll") for (int i_ = 0; i_ < CPT; ++i_) { const int c_ = tid + NTHREADS * i_, r_ = c_ / CPR, cc_ = c_ % CPR; \
        kreg[hf_][i_] = *(const GAS u32x4*)(Kb + (size_t)(kr_ + r_) * ldkv + cc_ * 8); vreg[hf_][i_] = *(const GAS u32x4*)(Vb + (size_t)(kr_ + r_) * ldkv + cc_ * 8); } } while (0)
    constexpr bool PF2 = false;
    ATT_ISSUE(0, 0);
    if (PF2 && nt > 1) ATT_ISSUE(1, 1);
    for (int it0 = 0; it0 < nt; it0 += 2) {
#pragma unroll
      for (int hf = 0; hf < 2; ++hf) {
        const int it = it0 + hf;
        if (it >= nt) break;
        LAS unsigned char* Kt = lds + hf * STG; LAS unsigned char* Vt = Kt + KBYTES;
#pragma unroll
        for (int i = 0; i < CPT; ++i) { const int c = tid + NTHREADS * i, r = c / CPR, cc = c % CPR;
            *(LAS u32x4*)(Kt + r * KSTR + cc * 16) = kreg[PF2 ? hf : 0][i]; *(LAS u32x4*)(Vt + r * VSTR + cc * 16) = vreg[PF2 ? hf : 0][i]; }
        if (PF2) { if (it + 2 < nt) ATT_ISSUE(hf, it + 2); } else { if (it + 1 < nt) ATT_ISSUE(0, it + 1); }
        __syncthreads();
        const int kp = ATT_KROW(it);
        bool active = true;
        if (MODE == MODE_SWA) active = !(kp > qrow0 + 31 || kp + 63 <= qrow0 - 128);
        if (MODE == MODE_MOBA) active = !(kp > qrow0 + 31);
        if (active) {
            f32x4 S[4][2];
            float sinit[2] = {-mrow[0], -mrow[1]};
            if (MODE == MODE_MOBA && it >= 4) {
                const int pb = (it - 4) >> 2;
                sinit[0] = ((sel[0] >> pb) & 1u) ? sinit[0] : -INFINITY; sinit[1] = ((sel[1] >> pb) & 1u) ? sinit[1] : -INFINITY;
            }
#pragma unroll
            for (int kb = 0; kb < 4; ++kb) { S[kb][0] = (f32x4){sinit[0], sinit[0], sinit[0], sinit[0]}; S[kb][1] = (f32x4){sinit[1], sinit[1], sinit[1], sinit[1]}; }
#pragma unroll
            for (int kb = 0; kb < 4; ++kb) {
#pragma unroll
                for (int k = 0; k < NK; ++k) {
                    const bf16x8 a = *(const LAS bf16x8*)(Kt + (kb * 16 + l15) * KSTR + (k * 32 + g * 8) * 2);
                    S[kb][0] = __builtin_amdgcn_mfma_f32_16x16x32_bf16(a, Qf[0][k], S[kb][0], 0, 0, 0);
                    S[kb][1] = __builtin_amdgcn_mfma_f32_16x16x32_bf16(a, Qf[1][k], S[kb][1], 0, 0, 0);
                }
                if (kb & 1) __builtin_amdgcn_sched_barrier(0);
            }
            bf16x8 Pb[2][2];
#pragma unroll
            for (int j = 0; j < 2; ++j) {
                const int qi = qrow0 + j * 16 + l15;
                if (MODE == MODE_SWA) {
                    if (!(kp + 63 <= qrow0 && kp > qrow0 + 31 - 128)) {
                        const unsigned dbase = (unsigned)(qi - kp - 4 * g);
#pragma unroll
                        for (int kb = 0; kb < 4; ++kb)
#pragma unroll
                            for (int i = 0; i < 4; ++i) S[kb][j][i] = ((dbase - (unsigned)(kb * 16 + i)) < 128u) ? S[kb][j][i] : -INFINITY;
                    }
                } else if (MODE == MODE_MOBA) {
                    if (kp + 63 > qrow0) {
#pragma unroll
                        for (int kb = 0; kb < 4; ++kb)
#pragma unroll
                            for (int i = 0; i < 4; ++i) S[kb][j][i] = ((qi - kp - 4 * g) >= (kb * 16 + i)) ? S[kb][j][i] : -INFINITY;
                    }
                }
                float mx = -INFINITY;
#pragma unroll
                for (int kb = 0; kb < 4; ++kb) mx = fmaxf(mx, fmaxf(fmaxf(S[kb][j][0], S[kb][j][1]), fmaxf(S[kb][j][2], S[kb][j][3])));
                mx = xmax16(mx); mx = xmax32(mx);
                const bool need = (first && mx > -INFINITY) || (mx > 8.0f);
                if (__builtin_amdgcn_ballot_w64(need) != 0ull) {
                    const float dlt = need ? mx : 0.f, alpha = fexp2(-dlt);
#pragma unroll
                    for (int kb = 0; kb < 4; ++kb) S[kb][j] = S[kb][j] - dlt;
                    mrow[j] += dlt; lrow[j] *= alpha;
#pragma unroll
                    for (int db = 0; db < NDB; ++db) O[db][j] = O[db][j] * alpha;
                }
                float ps = 0.f;
#pragma unroll
                for (int kb = 0; kb < 4; ++kb)
#pragma unroll
                    for (int i = 0; i < 4; ++i) { const float p = fexp2(S[kb][j][i]); S[kb][j][i] = p; ps += p; }
                lrow[j] += ps;
                Pb[j][0] = pack8s(S[0][j], S[1][j]); Pb[j][1] = pack8s(S[2][j], S[3][j]);
            }
#pragma unroll
            for (int s = 0; s < 2; ++s)
#pragma unroll
                for (int db = 0; db < NDB; ++db) {
                    const s16x4 lo = vtr(Vt + (32 * s + 4 * g + q4) * VSTR + (16 * db + 4 * p4) * 2);
                    const s16x4 hi = vtr(Vt + (32 * s + 16 + 4 * g + q4) * VSTR + (16 * db + 4 * p4) * 2);
                    const bf16x8 a = cat8(lo, hi);
                    O[db][0] = __builtin_amdgcn_mfma_f32_16x16x32_bf16(a, Pb[0][s], O[db][0], 0, 0, 0);
                    O[db][1] = __builtin_amdgcn_mfma_f32_16x16x32_bf16(a, Pb[1][s], O[db][1], 0, 0, 0);
                    if ((db & 3) == 3) __builtin_amdgcn_sched_barrier(0);
                }
            first = false;
        }
      }
    }
#undef ATT_ISSUE
#undef ATT_KROW
#pragma unroll
    for (int j = 0; j < 2; ++j) {
        float l = lrow[j]; l += __shfl_xor(l, 16); l += __shfl_xor(l, 32);
        const float inv = 1.0f / l;
        bf16_t* zp = Zy + (size_t)(qrow0 + j * 16 + l15) * LDP + 4 * g;
#pragma unroll
        for (int db = 0; db < NDB; ++db) {
            const u32x2 z = *(const GAS u32x2*)(zp + 16 * db);
            const f32x4 o = O[db][j] * inv;
            u32x2 w; w.x = cvt_pk_bf16(silu_mul(o[0], bflo(z.x)), silu_mul(o[1], bfhi(z.x))); w.y = cvt_pk_bf16(silu_mul(o[2], bflo(z.y)), silu_mul(o[3], bfhi(z.y)));
            if (!dry) *(GAS u32x2*)(zp + 16 * db) = w;
        }
    }
    __syncthreads();
}

__device__ __forceinline__ void moba_gate(LAS unsigned char* lds, int tid, const bf16_t* proj, const float* kmean, int b, int h, int qb) {
    asm volatile("" : "+v"(tid));
    LAS float* km = (LAS float*)lds;
    LAS unsigned* selm = (LAS unsigned*)(lds + LDS_MISC - 2048);
    for (int i = tid; i < 16 * 128; i += NTHREADS) km[i] = *((const GAS float*)kmean + (size_t)((b * 12 + h) * 16) * 128 + i);
    __syncthreads();
    const int q = tid >> 1, half = tid & 1;
    const bf16_t* qp = proj + (size_t)(b * SEQ + qb * 256 + q) * LDP + h * 128 + half * 64;
    float gsc[15];
#pragma unroll
    for (int n = 0; n < 15; ++n) gsc[n] = 0.f;
#pragma unroll 1
    for (int c = 0; c < 8; ++c) {
        const u32x4 w = *(const GAS u32x4*)(qp + c * 8);
        float qv[8] = {bflo(w.x), bfhi(w.x), bflo(w.y), bfhi(w.y), bflo(w.z), bfhi(w.z), bflo(w.w), bfhi(w.w)};
#pragma unroll
        for (int n = 0; n < 15; ++n) if (n < qb) {
            const LAS float* kr = km + n * 128 + half * 64 + c * 8;
#pragma unroll
            for (int e = 0; e < 8; ++e) gsc[n] += qv[e] * kr[e];
        }
    }
    unsigned mask = 0u;
#pragma unroll
    for (int n = 0; n < 15; ++n) { gsc[n] += __shfl_xor(gsc[n], 1); if (n >= qb) gsc[n] = -INFINITY; }
#pragma unroll
    for (int r = 0; r < 3; ++r) {
        float best = -INFINITY; int bi = -1;
#pragma unroll
        for (int n = 0; n < 15; ++n) { const bool taken = (mask >> n) & 1u; if (!taken && gsc[n] > best) { best = gsc[n]; bi = n; } }
        if (bi >= 0) mask |= 1u << bi;
    }
    if (half == 0) selm[q] = mask;
    __syncthreads();
}

__device__ __forceinline__ void kmean_unit(LAS unsigned char* lds, int tid, const bf16_t* proj, float* kmean, int u) {
    asm volatile("" : "+v"(tid));
    const int blk = u & 15, bh = u >> 4, b = bh / 12, h = bh % 12;
    const int cc = tid & 15, kg = tid >> 4;
    float s[8] = {0.f, 0.f, 0.f, 0.f, 0.f, 0.f, 0.f, 0.f};
    const bf16_t* kp = proj + (size_t)(b * SEQ + blk * 256 + kg * 8) * LDP + 1536 + h * 128 + cc * 8;
#pragma unroll
    for (int r = 0; r < 8; ++r) { const u32x4 w = *(const GAS u32x4*)(kp + (size_t)r * LDP);
        s[0] += bflo(w.x); s[1] += bfhi(w.x); s[2] += bflo(w.y); s[3] += bfhi(w.y); s[4] += bflo(w.z); s[5] += bfhi(w.z); s[6] += bflo(w.w); s[7] += bfhi(w.w); }
    LAS float* red = (LAS float*)lds;
#pragma unroll
    for (int e = 0; e < 8; ++e) red[kg * 128 + cc * 8 + e] = s[e];
    __syncthreads();
    if (tid < 128) { float a = 0.f;
#pragma unroll 8
        for (int k = 0; k < 32; ++k) a += red[k * 128 + tid];
        *((GAS float*)kmean + (size_t)u * 128 + tid) = a * (1.0f / 256.0f); }
    __syncthreads();
}

__device__ __forceinline__ void ret_scan_item(LAS unsigned char* lds, int tid, int wid, int lane, const bf16_t* proj, bf16_t* rprev, int item) {
    asm volatile("" : "+v"(tid), "+v"(lane)); asm volatile("" : "+s"(wid));
    constexpr int KS = 288, VS = 96, KB = 128 * KS, STG = KB + 128 * VS;
    const int es = item & 7, bh = item >> 3, b = bh / 6, h = bh % 6;
    const float lg = log2gamma(h), gchunk = fexp2(128.f * lg);
    const int g = lane >> 4, l15 = lane & 15, q4 = l15 >> 2, p4 = l15 & 3;
    const bf16_t* kbase = proj + (size_t)(b * SEQ) * LDP + 768 + h * 128;
    const bf16_t* vbase = proj + (size_t)(b * SEQ) * LDP + 1536 + h * 256 + es * 32;
    f32x4 R[2] = {(f32x4){0.f, 0.f, 0.f, 0.f}, (f32x4){0.f, 0.f, 0.f, 0.f}};
    u32x4 kreg[4], vreg;
#define RS_ISSUE(n) do { _Pragma("unroll") for (int i_ = 0; i_ < 4; ++i_) { const int c_ = tid + NTHREADS * i_; kreg[i_] = *(const GAS u32x4*)(kbase + (size_t)((n) * 128 + (c_ >> 4)) * LDP + (c_ & 15) * 8); } \
        vreg = *(const GAS u32x4*)(vbase + (size_t)((n) * 128 + (tid >> 2)) * LDP + (tid & 3) * 8); } while (0)
    RS_ISSUE(0);
    for (int n = 0; n < 32; ++n) {
        bf16_t* rp = rprev + ((size_t)((b * 32 + n) * 6 + h) * 256 + es * 32 + l15) * 128 + wid * 16 + 4 * g;
#pragma unroll
        for (int eb = 0; eb < 2; ++eb) { u32x2 w; w.x = cvt_pk_bf16(R[eb][0], R[eb][1]); w.y = cvt_pk_bf16(R[eb][2], R[eb][3]); *(GAS u32x2*)(rp + (size_t)eb * 16 * 128) = w; }
        if (n == 31) break;
        LAS unsigned char* Kt = lds + (n & 1) * STG; LAS unsigned char* Vt = Kt + KB;
#pragma unroll
        for (int i = 0; i < 4; ++i) { const int c = tid + NTHREADS * i, t = c >> 4, cc = c & 15;
            const float zt = fexp2((float)(127 - t) * lg);
            const u32x4 w = kreg[i]; u32x4 o;
            o.x = cvt_pk_bf16(bflo(w.x) * zt, bfhi(w.x) * zt); o.y = cvt_pk_bf16(bflo(w.y) * zt, bfhi(w.y) * zt); o.z = cvt_pk_bf16(bflo(w.z) * zt, bfhi(w.z) * zt); o.w = cvt_pk_bf16(bflo(w.w) * zt, bfhi(w.w) * zt);
            *(LAS u32x4*)(Kt + t * KS + cc * 16) = o; }
        *(LAS u32x4*)(Vt + (tid >> 2) * VS + (tid & 3) * 16) = vreg;
        __syncthreads();
        if (n + 1 < 31) RS_ISSUE(n + 1);
        R[0] = R[0] * gchunk; R[1] = R[1] * gchunk;
#pragma unroll
        for (int s = 0; s < 4; ++s) {
            const bf16x8 a = cat8(vtr(Kt + (32 * s + 8 * g + q4) * KS + (16 * wid + 4 * p4) * 2), vtr(Kt + (32 * s + 8 * g + 4 + q4) * KS + (16 * wid + 4 * p4) * 2));
#pragma unroll
            for (int eb = 0; eb < 2; ++eb) {
                const bf16x8 bb = cat8(vtr(Vt + (32 * s + 8 * g + q4) * VS + (16 * eb + 4 * p4) * 2), vtr(Vt + (32 * s + 8 * g + 4 + q4) * VS + (16 * eb + 4 * p4) * 2));
                R[eb] = __builtin_amdgcn_mfma_f32_16x16x32_bf16(a, bb, R[eb], 0, 0, 0);
            }
        }
    }
#undef RS_ISSUE
    __syncthreads();
}

__device__ __forceinline__ void ret_out_unit(LAS unsigned char* lds, int tid, int wid, int lane, bf16_t* proj, const bf16_t* rprev, int u, bool dry = false) {
    asm volatile("" : "+v"(tid), "+v"(lane)); asm volatile("" : "+s"(wid));
    constexpr int KS = 272, VS = 544, KB = 128 * KS;
    const int h = u % 6, bn = u / 6, n = bn & 31, b = bn >> 5;
    const float lg = log2gamma(h);
    const int g = lane >> 4, l15 = lane & 15, q4 = l15 >> 2, p4 = l15 & 3;
    const int row0 = b * SEQ + n * 128;
    LAS unsigned char* Kt = lds; LAS unsigned char* Vt = lds + KB;
    const bf16_t* kbase = proj + (size_t)row0 * LDP + 768 + h * 128;
    const bf16_t* vbase = proj + (size_t)row0 * LDP + 1536 + h * 256;
#pragma unroll
    for (int i = 0; i < 4; ++i) { const int c = tid + NTHREADS * i, t = c >> 4, cc = c & 15; *(LAS u32x4*)(Kt + t * KS + cc * 16) = *(const GAS u32x4*)(kbase + (size_t)t * LDP + cc * 8); }
#pragma unroll
    for (int i = 0; i < 8; ++i) { const int c = tid + NTHREADS * i, t = c >> 5, cc = c & 31; *(LAS u32x4*)(Vt + t * VS + cc * 16) = *(const GAS u32x4*)(vbase + (size_t)t * LDP + cc * 8); }
    const int qrow = row0 + wid * 16 + l15;
    bf16x8 Qf[4];
#pragma unroll
    for (int k = 0; k < 4; ++k) Qf[k] = *(const GAS bf16x8*)(proj + (size_t)qrow * LDP + h * 128 + k * 32 + g * 8);
    u32x4 rreg[8];
    const bf16_t* rbase = rprev + (size_t)((b * 32 + n) * 6 + h) * 256 * 128;
#pragma unroll
    for (int i = 0; i < 8; ++i) { const int c = tid + NTHREADS * i; rreg[i] = *(const GAS u32x4*)(rbase + (size_t)c * 8); }
    __syncthreads();
    f32x4 S[8];
#pragma unroll
    for (int kb = 0; kb < 8; ++kb) S[kb] = (f32x4){0.f, 0.f, 0.f, 0.f};
#pragma unroll
    for (int kb = 0; kb < 8; ++kb) if (kb <= wid) {
#pragma unroll
        for (int k = 0; k < 4; ++k) {
            const bf16x8 a = *(const LAS bf16x8*)(Kt + (kb * 16 + l15) * KS + (k * 32 + g * 8) * 2);
            S[kb] = __builtin_amdgcn_mfma_f32_16x16x32_bf16(a, Qf[k], S[kb], 0, 0, 0);
        }
    }
    const int tq = wid * 16 + l15;
    bf16x8 Pb[4];
#pragma unroll
    for (int kb = 0; kb < 8; ++kb)
#pragma unroll
        for (int i = 0; i < 4; ++i) { const int tk = kb * 16 + 4 * g + i; S[kb][i] = (tk <= tq) ? S[kb][i] * fexp2(-(float)(tk + 1) * lg) : 0.f; }
#pragma unroll
    for (int s = 0; s < 4; ++s) Pb[s] = pack8(S[2 * s], S[2 * s + 1]);
    f32x4 O[16];
#pragma unroll
    for (int eb = 0; eb < 16; ++eb) O[eb] = (f32x4){0.f, 0.f, 0.f, 0.f};
#pragma unroll
    for (int s = 0; s < 4; ++s) if (2 * s <= wid) {
#pragma unroll
        for (int eb = 0; eb < 16; ++eb) {
            const bf16x8 a = cat8(vtr(Vt + (32 * s + 4 * g + q4) * VS + (16 * eb + 4 * p4) * 2), vtr(Vt + (32 * s + 16 + 4 * g + q4) * VS + (16 * eb + 4 * p4) * 2));
            O[eb] = __builtin_amdgcn_mfma_f32_16x16x32_bf16(a, Pb[s], O[eb], 0, 0, 0);
        }
    }
    __syncthreads();
#pragma unroll
    for (int i = 0; i < 8; ++i) { const int c = tid + NTHREADS * i; *(LAS u32x4*)(Vt + (c >> 4) * KS + (c & 15) * 16) = rreg[i]; }
    __syncthreads();
#pragma unroll
    for (int eb = 0; eb < 16; ++eb)
#pragma unroll
        for (int k = 0; k < 4; ++k) {
            const bf16x8 a = *(const LAS bf16x8*)(Vt + (eb * 16 + l15) * KS + (k * 32 + g * 8) * 2);
            O[eb] = __builtin_amdgcn_mfma_f32_16x16x32_bf16(a, Qf[k], O[eb], 0, 0, 0);
        }
    const float xi = fexp2((float)(tq + 1) * lg);
    float ss = 0.f;
#pragma unroll
    for (int eb = 0; eb < 16; ++eb) { O[eb] = O[eb] * xi; ss += (O[eb][0] * O[eb][0] + O[eb][1] * O[eb][1]) + (O[eb][2] * O[eb][2] + O[eb][3] * O[eb][3]); }
    ss += __shfl_xor(ss, 16); ss += __shfl_xor(ss, 32);
    const float rstd = __builtin_amdgcn_rsqf(ss * (1.0f / 256.0f) + EPSN);
    bf16_t* zp = proj + (size_t)qrow * LDP + 3584 + h * 256 + 4 * g;
#pragma unroll
    for (int eb = 0; eb < 16; ++eb) {
        const u32x2 z = *(const GAS u32x2*)(zp + 16 * eb);
        const f32x4 o = O[eb] * rstd;
        u32x2 w; w.x = cvt_pk_bf16(silu_mul(o[0], bflo(z.x)), silu_mul(o[1], bfhi(z.x))); w.y = cvt_pk_bf16(silu_mul(o[2], bflo(z.y)), silu_mul(o[3], bfhi(z.y)));
        if (!dry) *(GAS u32x2*)(zp + 16 * eb) = w;
    }
    __syncthreads();
}

#define XB_TMO      128
#define XB_XCNT(j)  (256  + 64 * (j))
#define XB_XSUB(j)  (1280 + 64 * (j))
#define XB_XGEN(j)  (2304 + 64 * (j))
#define XB_TOP      3328
#define XB_TOPGEN   3392
#define XCD_BAR_WORDS 3456
#define XB_SPIN_CAP (1u << 18)

__device__ __forceinline__ unsigned xb_ld(unsigned* p)              { return __hip_atomic_load(p, __ATOMIC_RELAXED, __HIP_MEMORY_SCOPE_AGENT); }
__device__ __forceinline__ unsigned xb_add(unsigned* p, unsigned v) { return __hip_atomic_fetch_add(p, v, __ATOMIC_RELAXED, __HIP_MEMORY_SCOPE_AGENT); }
__device__ __forceinline__ unsigned xb_xcc_id() { return (unsigned)__builtin_amdgcn_s_getreg((3 << 11) | 20) & 0xFu; }
#define XB_SPIN(cond, bar) do { unsigned _sp = 0; while (cond) { __builtin_amdgcn_s_sleep(1); \
    if ((++_sp & 255u) == 0u) { if (xb_ld(&(bar)[XB_TMO])) break; if (_sp > XB_SPIN_CAP) { atomicAdd(&(bar)[XB_TMO], 1u); break; } } } } while (0)

struct XcdBarrier {
    unsigned* bar; unsigned x;
    volatile LAS unsigned* st;
};

__device__ __forceinline__ XcdBarrier xcd_barrier_post(unsigned* bar, volatile LAS unsigned* st) {
    XcdBarrier b; b.bar = bar; b.x = xb_xcc_id(); b.st = st;
    if (threadIdx.x == 0) (void)xb_add(&bar[XB_XCNT(b.x)], 1u);
    return b;
}
__device__ __forceinline__ void xcd_barrier_complete(unsigned* bar, unsigned x, unsigned& nloc, unsigned& nx) {
    const unsigned G = gridDim.x * gridDim.y * gridDim.z;
    unsigned sum, cnt, mine, sp = 0u;
    for (;;) {
        sum = 0u; cnt = 0u; mine = 0u;
#pragma unroll
        for (unsigned j = 0; j < 16; ++j) { const unsigned c = xb_ld(&bar[XB_XCNT(j)]); sum += c; cnt += (c > 0u) ? 1u : 0u; mine = (j == x) ? c : mine; }
        if (sum == G) break;
        __builtin_amdgcn_s_sleep(1);
        if ((++sp & 255u) == 0u) { if (xb_ld(&bar[XB_TMO])) break; if (sp > XB_SPIN_CAP) { atomicAdd(&bar[XB_TMO], 1u); break; } }
    }
    nloc = mine > 0u ? mine : 1u; nx = cnt > 0u ? cnt : 1u;
}

__device__ __forceinline__ void xcd_barrier(const XcdBarrier& b) {
    asm volatile("s_waitcnt vmcnt(0)" ::: "memory");
    __syncthreads();
    if (threadIdx.x == 0) {
        unsigned* bar = b.bar;
        __builtin_amdgcn_s_waitcnt(0);
        unsigned nloc = b.st[0], nx = b.st[1];
        if (nloc == 0u) { xcd_barrier_complete(bar, b.x, nloc, nx); b.st[0] = nloc; b.st[1] = nx; }
        const unsigned old = xb_add(&bar[XB_XSUB(b.x)], 1u);
        const unsigned gen = old / nloc;
        if (old + 1u == (gen + 1u) * nloc) {
            __builtin_amdgcn_fence(__ATOMIC_RELEASE, "agent");
            asm volatile("s_waitcnt vmcnt(0)" ::: "memory");
            const unsigned og = xb_add(&bar[XB_TOP], 1u);
            const unsigned tg = og / nx;
            if (og + 1u == (tg + 1u) * nx) xb_add(&bar[XB_TOPGEN], 1u);
            else XB_SPIN(xb_ld(&bar[XB_TOPGEN]) == tg, bar);
            __builtin_amdgcn_fence(__ATOMIC_ACQUIRE, "agent");
            xb_add(&bar[XB_XGEN(b.x)], 1u);
            asm volatile("s_waitcnt vmcnt(0)" ::: "memory");
        } else {
            XB_SPIN(xb_ld(&bar[XB_XGEN(b.x)]) == gen, bar);
            __builtin_amdgcn_fence(__ATOMIC_ACQUIRE, "agent");
            asm volatile("s_waitcnt vmcnt(0)" ::: "memory");
        }
    }
    __syncthreads();
}


#define CONV_WEIGHTS(MASK, worker, nworkers) do { \
        int lane_ = lane, wid_ = wid; asm volatile("" : "+v"(lane_)); asm volatile("" : "+s"(wid_)); LAS float* scr_ = (LAS float*)(lds + wid_ * 16640); \
        int total_ = 0; \
        _Pragma("unroll 1") for (int mi_ = 0; mi_ < 9; ++mi_) if (((MASK) >> mi_) & 1u) total_ += 32 * (mi_ < 4 ? pg8::npad_of(mi_ == 3 ? 0 : mi_) / 64 : (mi_ < 8 ? 32 : 16)); \
        for (int it_ = (worker); it_ < total_; it_ += (nworkers)) { \
            int r_ = it_; \
            _Pragma("unroll 1") for (int mi = 0; mi < 9; ++mi) { \
                if (!(((MASK) >> mi) & 1u)) continue; \
                const float* W; int N, mid_, nblk; const float* gv; bf16_t* WT; \
                if (mi < 4) { const int l_ = mi; mid_ = l_ == 3 ? 0 : l_; N = pg8::nc_of(mid_); nblk = pg8::npad_of(mid_) / 64; \
                    W = args.in[l_ == 0 ? 6 : l_ == 1 ? 10 : l_ == 2 ? 13 : 16]; gv = args.in[l_ == 0 ? 5 : l_ == 1 ? 9 : l_ == 2 ? 12 : 15]; \
                    WT = (bf16_t*)(ws + (l_ == 0 ? WS_WIN0 : l_ == 1 ? WS_WIN1 : l_ == 2 ? WS_WIN2 : WS_WIN3)); } \
                else if (mi < 8) { const int l_ = mi - 4; mid_ = -1; N = 2048; nblk = 32; W = args.in[l_ == 0 ? 8 : l_ == 1 ? 11 : l_ == 2 ? 14 : 18]; gv = nullptr; WT = woutT + (size_t)l_ * 2048 * 2048; } \
                else { mid_ = -1; N = 1024; nblk = 16; W = args.in[4]; gv = args.in[3]; WT = wmemT; } \
                const int cnt_ = 32 * nblk; \
                if (r_ < cnt_) { transpose_item(W, N, mid_, gv, WT, nblk, r_, lane_, scr_); break; } \
                r_ -= cnt_; \
            } \
        } } while (0)

struct Args { const float* in[20]; float* out; unsigned char* ws; };

__device__ __forceinline__ int fetch_unit(unsigned* ctr, volatile LAS unsigned* slot, int tid) {
    if (tid == 0) *slot = atomicAdd(ctr, 1u);
    __syncthreads();
    const unsigned v = *slot;
    __syncthreads();
    return __builtin_amdgcn_readfirstlane((int)v);
}

__global__ void __launch_bounds__(NTHREADS, 2) trunk_fwd(Args args) {
    extern __shared__ __attribute__((aligned(16))) unsigned char lds_raw[];
    cg::grid_group grid = cg::this_grid();
    LAS unsigned char* lds = (LAS unsigned char*)lds_raw;
    volatile LAS unsigned* misc = (volatile LAS unsigned*)(lds + LDS_MISC);
    const int tid = threadIdx.x, lane = tid & 63, wid = __builtin_amdgcn_readfirstlane(tid >> 6);
    const int G = gridDim.x, bx = blockIdx.x;
#define WS_PTRS() unsigned char* ws = args.ws; asm volatile("" : "+s"(ws)); \
    unsigned* ctl = (unsigned*)(ws + WS_CTL); bf16_t* hb = (bf16_t*)(ws + WS_HB); bf16_t* proj = (bf16_t*)(ws + WS_PROJ); \
    bf16_t* memb = (bf16_t*)(ws + WS_MEMB); bf16_t* mkv = (bf16_t*)(ws + WS_MKV); float* rss = (float*)(ws + WS_RSS); float* rssm = (float*)(ws + WS_RSSM); \
    float* ropeA = (float*)(ws + WS_ROPEA); float* ropeB = (float*)(ws + WS_ROPEB); float* ropeC = (float*)(ws + WS_ROPEC); \
    float* kmean = (float*)(ws + WS_KMEAN); bf16_t* rprev = (bf16_t*)(ws + WS_RPREV); bf16_t* woutT = (bf16_t*)(ws + WS_WOUT); bf16_t* wmemT = (bf16_t*)(ws + WS_WMEM); \
    (void)ctl; (void)hb; (void)proj; (void)memb; (void)mkv; (void)rss; (void)rssm; (void)ropeA; (void)ropeB; (void)ropeC; (void)kmean; (void)rprev; (void)woutT; (void)wmemT
#ifndef REP_P0
#define REP_P0 1
#endif
    for (int rep0 = 0; rep0 < REP_P0; ++rep0) {
        if (rep0) grid.sync();
        WS_PTRS(); const float* x = args.in[0];
        const int gw = bx * NWAVES + wid, NGW = G * NWAVES;
        LAS float* scr = (LAS float*)(lds + wid * 16640);
        if (G == 256) CONV_WEIGHTS(0x111u, gw, NGW); else CONV_WEIGHTS(0x1FFu, gw, NGW);
        for (int m = gw; m < MTOK; m += NGW) row_to_bf16(x + (size_t)m * DMODEL, hb + (size_t)m * DMODEL, rss + m, lane);
        for (int m = gw; m < NB * NMEMTOK; m += NGW) row_to_bf16(args.in[1] + (size_t)m * DMODEL, memb + (size_t)m * DMODEL, rssm + m, lane);
        const int* positions = (const int*)args.in[2];
        const int gt = bx * NTHREADS + tid, NGT = G * NTHREADS;
        for (int i = gt; i < MTOK * 88; i += NGT) {
            const int tok = i / 88, f = i % 88;
            float* tb; int F, fl;
            if (f < 8) { tb = ropeA; F = 8; fl = f; } else if (f < 24) { tb = ropeB; F = 16; fl = f - 8; } else { tb = ropeC; F = 64; fl = f - 24; }
            const double rev = (double)positions[tok] * INVF[f] * 0.15915494309189535;
            const float fr = (float)(rev - __builtin_rint(rev));
            *((GAS float*)tb + (size_t)tok * 2 * F + fl) = __builtin_amdgcn_cosf(fr); *((GAS float*)tb + (size_t)tok * 2 * F + F + fl) = __builtin_amdgcn_sinf(fr);
        }
        for (int i = gt; i < 4 * MTOK; i += NGT) *((GAS float*)rss + MTOK + i) = 0.f;
        for (int i = gt; i < 4 * 12 * 16 * 128; i += NGT) *((GAS float*)kmean + i) = 0.f;
        if (bx == 0) for (int i = tid; i < 1024 + XCD_BAR_WORDS; i += NTHREADS) ctl[i] = 0u;
    }
    grid.sync();
    if (tid < 2) misc[8 + tid] = 0u;
    __syncthreads();
    XcdBarrier xbar;
    { unsigned char* ws0 = args.ws; xbar = xcd_barrier_post((unsigned*)(ws0 + WS_CTL) + 1024, misc + 8); }
#define GRID_SYNC() xcd_barrier(xbar)

    const float L2E = 1.4426950408889634f;
#pragma unroll 1
    for (int l = 0; l < 4; ++l) {
        const int mid = (l == 3) ? 0 : l;
        const int nmix = pg8::nmix_of(mid), zoff = nmix + 512;
#pragma unroll 1
#ifndef REP_P1
#define REP_P1 1
#endif
        for (int rep1 = 0; rep1 < REP_P1; ++rep1)
        for (int pass = 0; pass < (l == 0 ? 2 : 1); ++pass) {
            WS_PTRS();
            pg8::Gemm g; pg8::StaticOrder S; pg8::EpiIn E;
            if (pass == 0) {
                g.A = hb; g.Bt = (const bf16_t*)(ws + (l == 0 ? WS_WIN0 : l == 1 ? WS_WIN1 : l == 2 ? WS_WIN2 : WS_WIN3)); g.lda = DMODEL; g.K = DMODEL;
                S.init(MTOK, pg8::npad_of(mid), G, bx);
                E.O = proj; E.ldc = LDP; E.mid = mid; E.rss = rss + (size_t)l * MTOK; E.kmean = kmean;
            } else {
                g.A = memb; g.Bt = wmemT; g.lda = DMODEL; g.K = DMODEL;
                S.init(NB * NMEMTOK, 1024, 1 << 20, bx - (G == 256 ? 240 : 0));
                E.O = mkv; E.ldc = 1024; E.mid = 3; E.rss = rssm; E.kmean = kmean;
            }
            E.rope0 = ropeA;

#ifndef SK_P1
pg8::gemm_phase<pg8::EpiIn, pg8::StaticOrder, true, true>(lds, g, S, E);
#endif

            __syncthreads();
        }
        if (l == 0 && G == 256 && bx >= 128 && bx < 240) {
            WS_PTRS();
            CONV_WEIGHTS(0x066u, (bx - 128) * NWAVES + wid, 112 * NWAVES);
        } else if (l == 2 && G == 256 && bx >= 128) {
            WS_PTRS();
            CONV_WEIGHTS(0x088u, (bx - 128) * NWAVES + wid, 128 * NWAVES);
        }
        GRID_SYNC();

        const int nsub = (mid == 2) ? 2 : 1;
#pragma unroll 1
        for (int sub = 0; sub < nsub; ++sub) {
            int nA, nMem;
            if (mid == 0) { nA = 1536; nMem = 256; } else if (mid == 1) { nA = 96; nMem = 32; } else if (sub == 0) { nA = 192; nMem = 256; } else { nA = 768; nMem = 0; }
#ifndef REP_P2
#define REP_P2 1
#endif
#ifndef REP_MID
#define REP_MID mid
#endif
            const int nrep = (mid == (REP_MID)) ? REP_P2 : 1;
            for (int rep = 0; rep < nrep; ++rep) {
            const bool dry = rep < nrep - 1;
            WS_PTRS();
            unsigned* ctr = ctl + (l * 2 + sub) + 16 * rep;
            if (mid == 1) ctr = ctl + 128 + 64 * (bx & 7) + 16 * rep;
            int u = fetch_unit(ctr, misc, tid);
            if (mid == 0) {
                while (u < nA) {
                    const int hp = u & 3, n = (u >> 2) & 31, r = u >> 7, kvh = r % 3, b = r / 3;
                    const int head = kvh * 8 + hp * 2 + (wid >> 2);
                    const float sink = args.in[l == 0 ? 7 : 17][head] * L2E;
#ifndef SK_SWA
                    attn_unit<64, MODE_SWA>(lds, tid, wid, lane, proj + head * 64, b * SEQ + n * 128 + (wid & 3) * 32, proj + 1536 + kvh * 64, proj + 1728 + kvh * 64, LDP,
                                            n == 0 ? 2 : 4, b * SEQ + n * 128 - (n ? 128 : 0), 0, sink, 1.f, 0u, 0u, proj + zoff + head * 64, dry);
#endif
                    u = fetch_unit(ctr, misc, tid);
                }
            } else if (mid == 1) {
                while (u < nA) {
                    const int qb = 15 - u / 6, bh = (bx & 7) + 8 * (u % 6), b = bh / 12, h = bh % 12;
#ifndef SK_MOBA
                    moba_gate(lds, tid, proj, kmean, b, h, qb);
                    volatile LAS unsigned* selm = (volatile LAS unsigned*)(lds + LDS_MISC - 2048);
                    const unsigned s0 = selm[wid * 32 + (lane & 15)], s1 = selm[wid * 32 + 16 + (lane & 15)];
                    __syncthreads();
                    attn_unit<128, MODE_MOBA>(lds, tid, wid, lane, proj + h * 128, b * SEQ + qb * 256 + wid * 32, proj + 1536 + h * 128, proj + 3072 + h * 128, LDP,
                                              4 + 4 * qb, b * SEQ + qb * 256, b * SEQ, -1e30f, 0.f, s0, s1, proj + zoff + h * 128, dry);
#endif
                    u = fetch_unit(ctr, misc, tid);
                }
            } else if (sub == 0) {
                while (u < nA) {
#ifndef SK_SCAN
                    ret_scan_item(lds, tid, wid, lane, proj, rprev, u);
#endif
                    u = fetch_unit(ctr, misc, tid);
                }
            } else {
                while (u < nA) {
#ifndef SK_ROUT
                    ret_out_unit(lds, tid, wid, lane, proj, rprev, u, dry);
#endif
                    u = fetch_unit(ctr, misc, tid);
                }
            }
            while (u < nA + nMem) {
                const int v = (mid == 1) ? (bx & 7) + 8 * (u - nA) : (u - nA), hm = v & 3, qt = (v >> 2) & 15, b = v >> 6;
#ifndef SK_MEM
                attn_unit<128, MODE_MEM>(lds, tid, wid, lane, proj + nmix + hm * 128, b * SEQ + qt * 256 + wid * 32, mkv + hm * 128, mkv + 512 + hm * 128, 1024,
                                         4, b * NMEMTOK, 0, -1e30f, 0.f, 0u, 0u, proj + zoff + 1536 + hm * 128, dry);
#endif
                u = fetch_unit(ctr, misc, tid);
            }
            GRID_SYNC();
            }
        }

        {
            WS_PTRS(); const float* x = args.in[0]; float* out = args.out;
            pg8::Gemm g; g.A = proj + zoff; g.Bt = woutT + (size_t)l * 2048 * 2048; g.lda = LDP; g.K = DMODEL;
            pg8::StaticOrder S; S.init(MTOK, DMODEL, G, bx);
            pg8::EpiOut E; E.basef = x; E.out = out; E.hb = hb; E.rssn = rss + (size_t)(l + 1) * MTOK; E.mode = (l == 0) ? 0 : (l == 3 ? 2 : 1);

#ifndef SK_P3
pg8::gemm_phase<pg8::EpiOut, pg8::StaticOrder, true, true>(lds, g, S, E);
#endif

            __syncthreads();
        }
        GRID_SYNC();
    }

#ifdef EXTRA_SYNCS
    for (int i = 0; i < EXTRA_SYNCS; ++i) GRID_SYNC();
#endif
    {
        const int gw = bx * NWAVES + wid, NGW = G * NWAVES;
        WS_PTRS(); float* out = args.out;
        int lane_f = lane; asm volatile("" : "+v"(lane_f));
        const float* gf = args.in[19];
        for (int m = gw; m < MTOK; m += NGW) {
            const float s = __builtin_amdgcn_rsqf(*((const GAS float*)rss + 4 * MTOK + m) * (1.0f / DMODEL) + EPSN);
            f32x4* xr = (f32x4*)(out + (size_t)m * DMODEL) + lane_f; const f32x4* gr = (const f32x4*)gf + lane_f;
#pragma unroll
            for (int j = 0; j < 8; ++j) { const f32x4 v = xr[64 * j]; xr[64 * j] = v * s * gr[64 * j]; }
        }
    }
}

extern "C" void kernel_launch(void* const* d_in, const int* in_sizes, int n_in, void* d_out, int out_size, void* d_ws, size_t ws_size, hipStream_t stream) {
    static int grid = 0;
    if (grid == 0) {
        if (n_in != 20 || out_size != MTOK * DMODEL || ws_size < WS_END) { fprintf(stderr, "kernel_launch: unexpected shapes (n_in %d, out %d, ws %zu, need %zu)\n", n_in, out_size, ws_size, (size_t)WS_END); grid = -1; return; }
        int dev = 0, cus = 0, per_cu = 0;
        hipGetDevice(&dev); hipDeviceGetAttribute(&cus, hipDeviceAttributeMultiprocessorCount, dev);
        hipFuncSetAttribute((const void*)trunk_fwd, hipFuncAttributeMaxDynamicSharedMemorySize, LDS_BYTES);
        if (hipOccupancyMaxActiveBlocksPerMultiprocessor(&per_cu, (const void*)trunk_fwd, NTHREADS, LDS_BYTES) != hipSuccess || per_cu < 1) { fprintf(stderr, "kernel_launch: occupancy query gave %d\n", per_cu); per_cu = 1; }
        (void)hipGetLastError();
        grid = cus;
        if (grid != 256) fprintf(stderr, "kernel_launch: note: %d CUs\n", grid);
    }
    if (grid < 0) return;
    Args a{};
    for (int i = 0; i < 20; ++i) a.in[i] = (const float*)d_in[i];
    a.out = (float*)d_out; a.ws = (unsigned char*)d_ws;
    void* kargs[] = {&a};
    hipError_t e = hipLaunchCooperativeKernel((const void*)trunk_fwd, dim3(grid), dim3(NTHREADS), kargs, LDS_BYTES, stream);
    if (e != hipSuccess) fprintf(stderr, "cooperative launch failed: %s (grid %d)\n", hipGetErrorString(e), grid);
}
```

```cpp
#include <hip/hip_runtime.h>
#include <hip/hip_cooperative_groups.h>
#include <cstdio>
#include <cstdint>
namespace cg = cooperative_groups;
#define GAS __attribute__((address_space(1)))
namespace pg8 {
#define PG8_LAS __attribute__((address_space(3)))
typedef unsigned short bf16_t;
typedef short bf16x8 __attribute__((ext_vector_type(8)));
typedef float f32x4 __attribute__((ext_vector_type(4)));
typedef unsigned u32x4 __attribute__((ext_vector_type(4)));
constexpr int BM = 256, BK = 64, HALF = 128, HTB = HALF * BK * 2  , STAGE_BYTES = 8 * HTB, NXCD = 8, WGM = 4;

__host__ __device__ __forceinline__ int lds_byte(int r, int c) { const int st = (r >> 4) * 2 + (c >> 5), rr = r & 15, cc = c & 31, ob = rr * 64 + cc * 2; return st * 1024 + (ob ^ (((ob >> 9) & 1) << 5)); }
__host__ __device__ __forceinline__ void stage_rc(int b, int& R, int& C) { const int st = b / 1024, sb = b % 1024, swz = sb ^ (((sb >> 9) & 1) << 5); R = (st >> 1) * 16 + swz / 64; C = (st & 1) * 32 + (swz % 64) / 2; }
__host__ __device__ __forceinline__ int perm32(int rho) { const int n = rho >> 4, i = rho & 15; return 8 * (i >> 2) + 4 * n + (i & 3); }

struct Unit { int pm, pn; };
struct Gemm { const bf16_t* A; const bf16_t* Bt; int lda, K, ldb; };

struct StaticOrder {
    int nM, nN, nwg, G, c;
    __host__ __device__ void init(int M, int N, int G_, int c_) { nM = M / BM; nN = N / BM; nwg = nM * nN; G = G_; c = c_; }
    __host__ __device__ bool next(int i, Unit& u) const {
        const long L = (long)i * G + c; if (L >= nwg || c < 0) return false;
        int wgid = (int)L; const int xcd0 = wgid % NXCD; { const int q = nwg / NXCD, r = nwg % NXCD, xcd = wgid % NXCD, off = wgid / NXCD; wgid = (xcd < r ? xcd * (q + 1) : r * (q + 1) + (xcd - r) * q) + off; }
        const int nig = WGM * nN, gid = wgid / nig, fm = gid * WGM, gsz = (nM - fm) < WGM ? (nM - fm) : WGM;
        u.pm = fm + ((wgid % nig) % gsz); u.pn = (wgid % nig) / gsz;
        if (nwg % NXCD == 0 && (nwg / NXCD) % (WGM * nN) == 0) u.pn = (u.pn + xcd0 * nN / NXCD) % nN;
        return true;
    }
    __device__ __forceinline__ void a_ready(const Unit&) const {}
    __device__ __forceinline__ void done(const Unit&) const {}
};

__device__ __forceinline__ unsigned cvt_pk_bf16(float lo, float hi) { unsigned r; asm volatile("v_cvt_pk_bf16_f32 %0, %1, %2" : "=v"(r) : "v"(lo), "v"(hi)); return r; }
constexpr int NB = 4, SEQ = 4096, DMODEL = 2048, MTOK = NB * SEQ, NMEMTOK = 256, LDP = 7168 + 64;
constexpr int LDH = DMODEL + 64, LDW = DMODEL + 64;
constexpr float EPSN = 1e-6f;
__host__ __device__ constexpr int nc_of(int mid)   { return mid == 0 ? 4480 : (mid == 1 ? 7168 : 5632); }
__host__ __device__ constexpr int npad_of(int mid) { return mid == 0 ? 4608 : (mid == 1 ? 7168 : 5632); }
__host__ __device__ constexpr int nmix_of(int mid) { return mid == 0 ? 1920 : (mid == 1 ? 4608 : 3072); }

struct GDesc { int dst0, dst1, rope, rstr; float scale; };
__device__ __forceinline__ GDesc gdesc(int mid, int j0) {
    GDesc d; d.dst0 = j0; d.dst1 = j0 + 4; d.rope = -1; d.rstr = 0; d.scale = 1.f;
    const float L2E = 1.4426950408889634f, R128 = 0.08838834764831845f;
    if (mid == 0) {
        if (j0 >= 4480) { d.dst0 = -1; return d; }
        if (j0 < 1728) { const int hb = j0 & ~63, lg = (j0 & 63) >> 3;
            if (lg < 2) { d.dst0 = hb + 4 * lg; d.dst1 = hb + 8 + 4 * lg; d.rope = 4 * lg; d.rstr = 16; }
            if (j0 < 1536) d.scale = 0.125f * L2E; }
        else if (j0 >= 1920 && j0 < 2432) d.scale = R128 * L2E;
    } else if (mid == 1) {
        if (j0 < 3072) { const int hb = j0 & ~127, lg = (j0 & 127) >> 3;
            if (lg < 4) { d.dst0 = hb + 4 * lg; d.dst1 = hb + 16 + 4 * lg; d.rope = MTOK * 16 + 4 * lg; d.rstr = 32; }
            if (j0 < 1536) d.scale = R128 * L2E; }
        else if (j0 >= 4608 && j0 < 5120) d.scale = R128 * L2E;
    } else if (mid == 2) {
        if (j0 < 1536) { const int hb = j0 & ~127, lg = (j0 & 127) >> 3;
            d.dst0 = hb + 4 * lg; d.dst1 = hb + 64 + 4 * lg; d.rope = MTOK * 48 + 4 * lg; d.rstr = 128;
            if (j0 >= 768) d.scale = R128; }
        else if (j0 >= 3072 && j0 < 3584) d.scale = R128 * L2E;
    }
    return d;
}
__device__ __forceinline__ int src_col(int mid, int j) { const GDesc d = gdesc(mid, j & ~7); if (d.dst0 < 0) return -1; return (j & 4) ? d.dst1 + (j & 3) : d.dst0 + (j & 3); }

typedef unsigned u32x2 __attribute__((ext_vector_type(2)));
struct EpiIn {
    static constexpr bool PERM = true, AFTER_DRAIN = false;
    bf16_t* O; int ldc, mid; const float* rss; const float* rope0; float* kmean;
    __device__ __forceinline__ void operator()(const f32x4 (&acc)[2][2][4][2], const Unit& u, int wr, int wc, int fr, int fq) const {
        const int row0 = u.pm * BM + wr * 64 + fr;
        const bool ksum = (mid == 1) && (u.pn >= 6) && (u.pn < 12);
        float cs[2][8];
#pragma unroll
        for (int bj = 0; bj < 2; ++bj)
#pragma unroll
            for (int e = 0; e < 8; ++e) cs[bj][e] = 0.f;
        GDesc d[2];
#pragma unroll
        for (int bj = 0; bj < 2; ++bj) d[bj] = gdesc(mid, u.pn * BM + bj * HALF + wc * 32 + 8 * fq);
#pragma unroll
        for (int ai = 0; ai < 2; ++ai)
#pragma unroll
            for (int m = 0; m < 4; ++m) {
                const int r = row0 + ai * HALF + m * 16;
                const float s = __builtin_amdgcn_rsqf(*((const GAS float*)rss + r) * (1.0f / DMODEL) + EPSN);
                bf16_t* rowp = O + (size_t)r * ldc;
#pragma unroll
                for (int bj = 0; bj < 2; ++bj) {
                    if (d[bj].dst0 < 0) continue;
                    const float sc = s * d[bj].scale;
                    f32x4 v0 = acc[ai][bj][m][0] * sc, v1 = acc[ai][bj][m][1] * sc;
                    if (d[bj].rope >= 0) {
                        const float* t = rope0 + d[bj].rope + (size_t)r * d[bj].rstr; const int F = d[bj].rstr >> 1;
                        const f32x4 c = *(const GAS f32x4*)t, sn = *(const GAS f32x4*)(t + F);
                        const f32x4 n0 = v0 * c - v1 * sn, n1 = v1 * c + v0 * sn; v0 = n0; v1 = n1;
                    }
                    if (ksum) {
#pragma unroll
                        for (int e = 0; e < 4; ++e) { cs[bj][e] += v0[e]; cs[bj][4 + e] += v1[e]; }
                    }
                    u32x2 w0, w1; w0.x = cvt_pk_bf16(v0[0], v0[1]); w0.y = cvt_pk_bf16(v0[2], v0[3]); w1.x = cvt_pk_bf16(v1[0], v1[1]); w1.y = cvt_pk_bf16(v1[2], v1[3]);
                    if (d[bj].dst1 == d[bj].dst0 + 4) { u32x4 w; w.x = w0.x; w.y = w0.y; w.z = w1.x; w.w = w1.y; *(GAS u32x4*)(rowp + d[bj].dst0) = w; }
                    else { *(GAS u32x2*)(rowp + d[bj].dst0) = w0; *(GAS u32x2*)(rowp + d[bj].dst1) = w1; }
                }
            }
        if (ksum) {
            float* kb = kmean + (size_t)((u.pm >> 4) * 12 * 16 + (u.pm & 15)) * 128;
#pragma unroll
            for (int bj = 0; bj < 2; ++bj)
#pragma unroll
                for (int e = 0; e < 8; ++e) {
                    float v = cs[bj][e];
                    v += __shfl_xor(v, 1); v += __shfl_xor(v, 2); v += __shfl_xor(v, 4); v += __shfl_xor(v, 8);
                    const int col = ((e < 4) ? d[bj].dst0 + e : d[bj].dst1 + e - 4) - 1536, h = col >> 7, dd = col & 127;
                    if (fr == 0) (void)__hip_atomic_fetch_add((GAS float*)(kb + (size_t)h * 16 * 128 + dd), v * (1.0f / 256.0f), __ATOMIC_RELAXED, __HIP_MEMORY_SCOPE_AGENT);
                }
        }
    }
};
struct EpiOut {
    static constexpr bool PERM = true, AFTER_DRAIN = false;
    const float* basef; float* out; bf16_t* hb; float* rssn; int mode;
    __device__ __forceinline__ void operator()(const f32x4 (&acc)[2][2][4][2], const Unit& u, int wr, int wc, int fr, int fq) const {
        const int row0 = u.pm * BM + wr * 64 + fr, col0 = u.pn * BM + wc * 32 + 8 * fq;
#pragma unroll
        for (int ai = 0; ai < 2; ++ai)
#pragma unroll
            for (int m = 0; m < 4; ++m) {
                const int r = row0 + ai * HALF + m * 16; float ss = 0.f;
#pragma unroll
                for (int bj = 0; bj < 2; ++bj) {
                    const size_t off = (size_t)r * DMODEL + col0 + bj * HALF, offh = (size_t)r * LDH + col0 + bj * HALF;
                    f32x4 b0, b1;
                    if (mode == 0) { b0 = *(const GAS f32x4*)(basef + off); b1 = *(const GAS f32x4*)(basef + off + 4); }
                    else { const u32x4 hw = *(const GAS u32x4*)(hb + offh);
                        b0 = (f32x4){__builtin_bit_cast(float, hw.x << 16), __builtin_bit_cast(float, hw.x & 0xffff0000u), __builtin_bit_cast(float, hw.y << 16), __builtin_bit_cast(float, hw.y & 0xffff0000u)};
                        b1 = (f32x4){__builtin_bit_cast(float, hw.z << 16), __builtin_bit_cast(float, hw.z & 0xffff0000u), __builtin_bit_cast(float, hw.w << 16), __builtin_bit_cast(float, hw.w & 0xffff0000u)}; }
                    const f32x4 v0 = acc[ai][bj][m][0] + b0, v1 = acc[ai][bj][m][1] + b1;
                    if (mode == 2) { *(GAS f32x4*)(out + off) = v0; *(GAS f32x4*)(out + off + 4) = v1; }
                    else { u32x4 w; w.x = cvt_pk_bf16(v0[0], v0[1]); w.y = cvt_pk_bf16(v0[2], v0[3]); w.z = cvt_pk_bf16(v1[0], v1[1]); w.w = cvt_pk_bf16(v1[2], v1[3]);
                        *(GAS u32x4*)(hb + offh) = w; }
                    ss += (v0[0] * v0[0] + v0[1] * v0[1]) + (v0[2] * v0[2] + v0[3] * v0[3]) + (v1[0] * v1[0] + v1[1] * v1[1]) + (v1[2] * v1[2] + v1[3] * v1[3]);
                }
                ss += __shfl_xor(ss, 16); ss += __shfl_xor(ss, 32);
                if (fq == 0) (void)__hip_atomic_fetch_add((GAS float*)(rssn + r), ss, __ATOMIC_RELAXED, __HIP_MEMORY_SCOPE_AGENT);
                if (m & 1) asm volatile("" ::: "memory");
            }
    }
};

template <class Epi, class Sched, bool ALIGN_EPI = false, bool SP2 = false>
__device__ __forceinline__ void gemm_phase(PG8_LAS unsigned char* lds, const Gemm g, const Sched& S, const Epi& E) {
    int tid_ = threadIdx.x; asm volatile("" : "+v"(tid_));
    const int tid = tid_, wid = __builtin_amdgcn_readfirstlane(tid >> 6), lane = tid & 63, wr = wid >> 2, wc = wid & 3, fr = lane & 15, fq = lane >> 4;
    const int K = g.K, nt = K / BK;
    unsigned voffA[2], voffB[2];
#pragma unroll
    for (int i = 0; i < 2; ++i) { int R, C; stage_rc(tid * 16 + i * 8192, R, C); const int Rb = Epi::PERM ? ((R & ~31) + perm32(R & 31)) : R;
        voffA[i] = (unsigned)(R * g.lda + C) * 2u; voffB[i] = (unsigned)(Rb * g.ldb + C) * 2u; }
    const size_t kstep = (size_t)(BK * 2);
    const size_t hstepA = (size_t)HALF * g.lda * 2, hstepB = (size_t)HALF * g.ldb * 2;
    const size_t tstepA = 2 * hstepA, tstepB = 2 * hstepB;
    const unsigned ldsw = (unsigned)wid * 1024u;
    const int aoff = lds_byte(wr * 64 + fr, fq * 8), boff = lds_byte(wc * 32 + fr, fq * 8);
#define PG8_SA(b, h) (((b) * 2 + (h)) * HTB)
#define PG8_SB(b, h) ((4 + (b) * 2 + (h)) * HTB)
#define PG8_STAGE(bufoff, gbase, voff) do { _Pragma("unroll") for (int _i = 0; _i < 2; ++_i) \
        __builtin_amdgcn_global_load_lds((const unsigned*)((const char*)(gbase) + (voff)[_i]), (PG8_LAS unsigned*)(lds + (bufoff) + ldsw + _i * 8192), 16, 0, 0); } while (0)
#define PG8_LDA(dst, b, h) do { _Pragma("unroll") for (int m = 0; m < 4; ++m) _Pragma("unroll") for (int k = 0; k < 2; ++k) dst[m][k] = *(const PG8_LAS bf16x8*)(lds + PG8_SA(b, h) + aoff + m * 2048 + k * 1024); } while (0)
#define PG8_LDB(dst, b, h) do { _Pragma("unroll") for (int n = 0; n < 2; ++n) _Pragma("unroll") for (int k = 0; k < 2; ++k) dst[n][k] = *(const PG8_LAS bf16x8*)(lds + PG8_SB(b, h) + boff + n * 2048 + k * 1024); } while (0)
#define PG8_MMA(ai, bj, At, Bt) do { __builtin_amdgcn_s_setprio(1); _Pragma("unroll") for (int m = 0; m < 4; ++m) _Pragma("unroll") for (int n = 0; n < 2; ++n) _Pragma("unroll") for (int k = 0; k < 2; ++k) \
        acc[ai][bj][m][n] = __builtin_amdgcn_mfma_f32_16x16x32_bf16(Bt[n][k], At[m][k], acc[ai][bj][m][n], 0, 0, 0); __builtin_amdgcn_s_setprio(0); } while (0)
#define PG8_WAIT_V(n) asm volatile("s_waitcnt vmcnt(" #n ")" ::: "memory")
#define PG8_WAIT_L(n) asm volatile("s_waitcnt lgkmcnt(" #n ")" ::: "memory")
#define PG8_BAR __builtin_amdgcn_s_barrier()
#define PG8_SCHED __builtin_amdgcn_sched_barrier(0)
    Unit cur, nxt; int ui = 0;
    if (!S.next(0, cur)) return;
    f32x4 acc[2][2][4][2];
#pragma unroll
    for (int a = 0; a < 2; ++a)
#pragma unroll
        for (int b = 0; b < 2; ++b)
#pragma unroll
            for (int m = 0; m < 4; ++m)
#pragma unroll
                for (int n = 0; n < 2; ++n) acc[a][b][m][n] = (f32x4){0.f, 0.f, 0.f, 0.f};
    bf16x8 At[4][2], B0[2][2], B1[2][2];
    const char* cA = (const char*)g.A + (size_t)cur.pm * tstepA; const char* cB = (const char*)g.Bt + (size_t)cur.pn * tstepB;
    S.a_ready(cur);
    if constexpr (SP2) {
        PG8_STAGE(PG8_SB(0, 0), cB, voffB); PG8_STAGE(PG8_SB(0, 1), cB + hstepB, voffB); PG8_STAGE(PG8_SA(0, 0), cA, voffA); PG8_STAGE(PG8_SA(0, 1), cA + hstepA, voffA);
        if (wr == 1) PG8_BAR;
        PG8_WAIT_V(2); PG8_BAR;
        PG8_STAGE(PG8_SB(1, 0), cB + kstep, voffB); PG8_STAGE(PG8_SA(1, 0), cA + kstep, voffA); PG8_STAGE(PG8_SB(1, 1), cB + hstepB + kstep, voffB);
        PG8_WAIT_V(6); PG8_BAR;
    } else {
        PG8_STAGE(PG8_SB(0, 0), cB, voffB); PG8_STAGE(PG8_SA(0, 0), cA, voffA); PG8_STAGE(PG8_SB(0, 1), cB + hstepB, voffB); PG8_STAGE(PG8_SA(0, 1), cA + hstepA, voffA);
        if (wr == 1) PG8_BAR;
        PG8_WAIT_V(4); PG8_BAR;
        PG8_STAGE(PG8_SB(1, 0), cB + kstep, voffB); PG8_STAGE(PG8_SA(1, 0), cA + kstep, voffA); PG8_STAGE(PG8_SB(1, 1), cB + hstepB + kstep, voffB);
        PG8_WAIT_V(6); PG8_BAR;
    }
    for (;;) {
        const bool has_next = S.next(ui + 1, nxt);
        const char* nA = has_next ? (const char*)g.A + (size_t)nxt.pm * tstepA : cA; const char* nB = has_next ? (const char*)g.Bt + (size_t)nxt.pn * tstepB : cB;
        for (int t = 0; t < nt; t += 2) {
            const bool last = (t == nt - 2);
            const char* a1 = cA + (size_t)(t + 1) * kstep;
            const char* a2 = last ? nA : cA + (size_t)(t + 2) * kstep; const char* b2 = last ? nB : cB + (size_t)(t + 2) * kstep;
            const char* a3 = a2 + kstep; const char* b3 = b2 + kstep;
            if (last && has_next) S.a_ready(nxt);
            if constexpr (SP2) {
            PG8_LDB(B0, 0, 0); PG8_LDB(B1, 0, 1); PG8_SCHED; PG8_LDA(At, 0, 0); PG8_STAGE(PG8_SA(1, 1), a1 + hstepA, voffA);
            PG8_WAIT_V(8); PG8_WAIT_L(0); PG8_BAR; PG8_MMA(0, 0, At, B0); PG8_MMA(0, 1, At, B1); PG8_BAR; PG8_SCHED;
            PG8_LDA(At, 0, 1); PG8_STAGE(PG8_SB(0, 0), b2, voffB); PG8_STAGE(PG8_SB(0, 1), b2 + hstepB, voffB); PG8_STAGE(PG8_SA(0, 0), a2, voffA);
            PG8_WAIT_V(8); PG8_WAIT_L(0); PG8_BAR; PG8_MMA(1, 0, At, B0); PG8_MMA(1, 1, At, B1); PG8_BAR; PG8_SCHED;
            PG8_LDB(B0, 1, 0); PG8_LDB(B1, 1, 1); PG8_SCHED; PG8_LDA(At, 1, 0); PG8_STAGE(PG8_SA(0, 1), a2 + hstepA, voffA);
            PG8_WAIT_V(8); PG8_WAIT_L(0); PG8_BAR; PG8_MMA(0, 0, At, B0); PG8_MMA(0, 1, At, B1); PG8_BAR; PG8_SCHED;
            PG8_LDA(At, 1, 1); PG8_STAGE(PG8_SB(1, 0), b3, voffB); PG8_STAGE(PG8_SB(1, 1), b3 + hstepB, voffB); PG8_STAGE(PG8_SA(1, 0), a3, voffA);
            PG8_WAIT_V(8); PG8_WAIT_L(0); PG8_BAR; PG8_MMA(1, 0, At, B0); PG8_MMA(1, 1, At, B1); PG8_BAR; PG8_SCHED;
            } else {
            PG8_LDB(B0, 0, 0); PG8_SCHED; PG8_LDA(At, 0, 0); PG8_STAGE(PG8_SA(1, 1), a1 + hstepA, voffA);
            PG8_WAIT_L(8); PG8_BAR; PG8_WAIT_L(0); PG8_MMA(0, 0, At, B0); PG8_BAR; PG8_SCHED;
            PG8_LDB(B1, 0, 1); PG8_STAGE(PG8_SB(0, 0), b2, voffB);
            PG8_BAR; PG8_WAIT_L(0); PG8_MMA(0, 1, At, B1); PG8_BAR;
            PG8_LDA(At, 0, 1); PG8_STAGE(PG8_SA(0, 0), a2, voffA);
            PG8_BAR; PG8_WAIT_L(0); PG8_MMA(1, 0, At, B0); PG8_BAR; PG8_SCHED;
            PG8_STAGE(PG8_SB(0, 1), b2 + hstepB, voffB);
            PG8_WAIT_V(6); PG8_BAR; PG8_MMA(1, 1, At, B1); PG8_BAR;
            PG8_LDB(B0, 1, 0); PG8_SCHED; PG8_LDA(At, 1, 0); PG8_STAGE(PG8_SA(0, 1), a2 + hstepA, voffA);
            PG8_WAIT_L(8); PG8_BAR; PG8_WAIT_L(0); PG8_MMA(0, 0, At, B0); PG8_BAR; PG8_SCHED;
            PG8_LDB(B1, 1, 1); PG8_STAGE(PG8_SB(1, 0), b3, voffB);
            PG8_BAR; PG8_WAIT_L(0); PG8_MMA(0, 1, At, B1); PG8_BAR;
            PG8_LDA(At, 1, 1); PG8_STAGE(PG8_SA(1, 0), a3, voffA);
            PG8_BAR; PG8_WAIT_L(0); PG8_MMA(1, 0, At, B0); PG8_BAR; PG8_SCHED;
            PG8_STAGE(PG8_SB(1, 1), b3 + hstepB, voffB);
            PG8_WAIT_V(6); PG8_BAR; PG8_MMA(1, 1, At, B1); PG8_BAR;
            }
        }
        if constexpr (ALIGN_EPI) { if (wr == 0) PG8_BAR; }
        if constexpr (!Epi::AFTER_DRAIN) { E(acc, cur, wr, wc, fr, fq); S.done(cur); }
        if (!has_next) break;
#pragma unroll
        for (int a = 0; a < 2; ++a)
#pragma unroll
            for (int b = 0; b < 2; ++b)
#pragma unroll
                for (int m = 0; m < 4; ++m)
#pragma unroll
                    for (int n = 0; n < 2; ++n) acc[a][b][m][n] = (f32x4){0.f, 0.f, 0.f, 0.f};
        cur = nxt; cA = nA; cB = nB; ++ui;
        if constexpr (ALIGN_EPI) { if (wr == 1) PG8_BAR; }
    }
    PG8_WAIT_V(0);
    if constexpr (!ALIGN_EPI) { if (wr == 0) PG8_BAR; }
    PG8_BAR;
    if constexpr (Epi::AFTER_DRAIN) { E.fused(acc, cur, wr, wc, fr, fq, lds, wid, lane); S.done(cur); }
#undef PG8_SA
#undef PG8_SB
#undef PG8_STAGE
#undef PG8_LDA
#undef PG8_LDB
#undef PG8_MMA
#undef PG8_WAIT_V
#undef PG8_WAIT_L
#undef PG8_BAR
#undef PG8_SCHED
}
}

using pg8::bf16_t; using pg8::bf16x8; using pg8::f32x4; using pg8::u32x4; using pg8::u32x2; using pg8::cvt_pk_bf16;
using pg8::NB; using pg8::SEQ; using pg8::DMODEL; using pg8::MTOK; using pg8::NMEMTOK; using pg8::LDP; using pg8::LDH; using pg8::LDW; using pg8::EPSN;
#define LAS __attribute__((address_space(3)))
typedef short s16x4 __attribute__((ext_vector_type(4)));
typedef float f32x2 __attribute__((ext_vector_type(2)));

constexpr int NTHREADS = 512, NWAVES = 8;
constexpr int LDS_BYTES = 147456;
constexpr int LDS_MISC = 139264;

constexpr size_t al256(size_t x) { return (x + 255) & ~(size_t)255; }
constexpr size_t WS_CTL   = 0;
constexpr size_t WS_WIN0  = 1u << 20;
constexpr size_t WS_WIN1  = WS_WIN0 + (size_t)4608 * LDW * 2;
constexpr size_t WS_WIN2  = WS_WIN1 + (size_t)7168 * LDW * 2;
constexpr size_t WS_WIN3  = WS_WIN2 + (size_t)5632 * LDW * 2;
constexpr size_t WS_WOUT  = WS_WIN3 + (size_t)4608 * LDW * 2;
constexpr size_t WS_WMEM  = WS_WOUT + (size_t)4 * 2048 * LDW * 2;
constexpr size_t WS_HB    = WS_WMEM + (size_t)1024 * LDW * 2;
constexpr size_t WS_PROJ  = WS_HB + (size_t)MTOK * LDH * 2;
constexpr size_t WS_MEMB  = WS_PROJ + (size_t)MTOK * LDP * 2;
constexpr size_t WS_MKV   = WS_MEMB + (size_t)1024 * LDH * 2;
constexpr size_t WS_RSS   = WS_MKV + (size_t)1024 * 1024 * 2;
constexpr size_t WS_RSSM  = WS_RSS + (size_t)5 * MTOK * 4;
constexpr size_t WS_ROPEA = WS_RSSM + 4096;
constexpr size_t WS_ROPEB = WS_ROPEA + (size_t)MTOK * 16 * 4;
constexpr size_t WS_ROPEC = WS_ROPEB + (size_t)MTOK * 32 * 4;
constexpr size_t WS_KMEAN = WS_ROPEC + (size_t)MTOK * 128 * 4;
constexpr size_t WS_RPREV = WS_KMEAN + (size_t)4 * 12 * 16 * 128 * 4;
constexpr size_t WS_END   = WS_RPREV + (size_t)4 * 32 * 6 * 256 * 128 * 2;

__constant__ double INVF[88] = {
 1.0, 0.19392274474868576, 0.03760603093086393, 0.007292664737217109, 0.001414213562373095, 0.0002742481756762073, 5.318295896944988e-05, 1.031338537721246e-05,
 1.0, 0.44036660267178046, 0.19392274474868576, 0.08539710028576561, 0.03760603093086393, 0.016560440080994446, 0.007292664737217109, 0.003211445994752591, 0.001414213562373095, 0.000622772421914596, 0.0002742481756762073, 0.00012076973741146504, 5.318295896944988e-05, 2.341999896140934e-05, 1.031338537721246e-05, 4.5416704806078695e-06,
 1.0, 0.8659643233600653, 0.7498942093324559, 0.6493816315762113, 0.5623413251903491, 0.4869675251658631, 0.4216965034285822, 0.3651741272548377, 0.31622776601683794, 0.27384196342643613, 0.23713737056616552, 0.2053525026457146, 0.1778279410038923, 0.1539926526059492, 0.1333521432163324, 0.11547819846894582, 0.1, 0.08659643233600653, 0.07498942093324558, 0.06493816315762113, 0.05623413251903491, 0.04869675251658631, 0.042169650342858224, 0.03651741272548377, 0.03162277660168379, 0.027384196342643614, 0.023713737056616554, 0.02053525026457146, 0.01778279410038923, 0.01539926526059492, 0.01333521432163324, 0.011547819846894581, 0.01, 0.008659643233600654, 0.007498942093324558, 0.006493816315762113, 0.005623413251903491, 0.004869675251658631, 0.004216965034285823, 0.003651741272548377, 0.0031622776601683794, 0.0027384196342643613, 0.0023713737056616554, 0.002053525026457146, 0.0017782794100389228, 0.001539926526059492, 0.001333521432163324, 0.0011547819846894581, 0.001, 0.0008659643233600654, 0.0007498942093324559, 0.0006493816315762113, 0.0005623413251903491, 0.0004869675251658631, 0.00042169650342858224, 0.0003651741272548377, 0.00031622776601683794, 0.0002738419634264361, 0.00023713737056616554, 0.0002053525026457146, 0.00017782794100389227, 0.0001539926526059492, 0.0001333521432163324, 0.00011547819846894582 };
__device__ __forceinline__ float log2gamma(int h) {
    return h == 0 ? -0.04580368961312479f : h == 1 ? -0.02612928206836121f : h == 2 ? -0.014949433599796901f : h == 3 ? -0.008567249848519122f : h == 4 ? -0.004914372264518986f : -0.002820519062378663f;
}

#define LDS_WAIT() asm volatile("s_waitcnt lgkmcnt(0)" ::: "memory")
__device__ __forceinline__ unsigned f2bf(float f) { unsigned u = __builtin_bit_cast(unsigned, f); return (u + 0x7fffu + ((u >> 16) & 1u)) >> 16; }
__device__ __forceinline__ unsigned pk2(float lo, float hi) { return f2bf(lo) | (f2bf(hi) << 16); }
__device__ __forceinline__ float bflo(unsigned w) { return __builtin_bit_cast(float, w << 16); }
__device__ __forceinline__ float bfhi(unsigned w) { return __builtin_bit_cast(float, w & 0xffff0000u); }
__device__ __forceinline__ float wave_sum(float v) {
#pragma unroll
    for (int o = 1; o < 64; o <<= 1) v += __shfl_xor(v, o);
    return v;
}
__device__ __forceinline__ float fexp2(float x) { return __builtin_amdgcn_exp2f(x); }
__device__ __forceinline__ s16x4 vtr(const LAS unsigned char* p) { return __builtin_bit_cast(s16x4, __builtin_amdgcn_ds_read_tr16_b64_v4i16((LAS s16x4*)p)); }
__device__ __forceinline__ bf16x8 cat8(s16x4 a, s16x4 b) { bf16x8 r; r[0] = a[0]; r[1] = a[1]; r[2] = a[2]; r[3] = a[3]; r[4] = b[0]; r[5] = b[1]; r[6] = b[2]; r[7] = b[3]; return r; }
typedef float f32x2_t __attribute__((ext_vector_type(2)));
typedef __bf16 bf16x2_t __attribute__((ext_vector_type(2)));
__device__ __forceinline__ unsigned cvtpk(float lo, float hi) { f32x2_t v = {lo, hi}; bf16x2_t b = __builtin_convertvector(v, bf16x2_t); return __builtin_bit_cast(unsigned, b); }
__device__ __forceinline__ float xmax16(float x) { const auto r = __builtin_amdgcn_permlane16_swap(__builtin_bit_cast(unsigned, x), __builtin_bit_cast(unsigned, x), false, false); return fmaxf(__builtin_bit_cast(float, r[0]), __builtin_bit_cast(float, r[1])); }
__device__ __forceinline__ float xmax32(float x) { const auto r = __builtin_amdgcn_permlane32_swap(__builtin_bit_cast(unsigned, x), __builtin_bit_cast(unsigned, x), false, false); return fmaxf(__builtin_bit_cast(float, r[0]), __builtin_bit_cast(float, r[1])); }
__device__ __forceinline__ bf16x8 pack8s(f32x4 a, f32x4 b) { u32x4 w; w.x = cvtpk(a[0], a[1]); w.y = cvtpk(a[2], a[3]); w.z = cvtpk(b[0], b[1]); w.w = cvtpk(b[2], b[3]); return __builtin_bit_cast(bf16x8, w); }
__device__ __forceinline__ bf16x8 pack8(f32x4 a, f32x4 b) { u32x4 w; w.x = cvt_pk_bf16(a[0], a[1]); w.y = cvt_pk_bf16(a[2], a[3]); w.z = cvt_pk_bf16(b[0], b[1]); w.w = cvt_pk_bf16(b[2], b[3]); return __builtin_bit_cast(bf16x8, w); }
__device__ __forceinline__ float silu_mul(float o, float z) { return o * z * __builtin_amdgcn_rcpf(1.0f + fexp2(-1.4426950408889634f * z)); }

__device__ __forceinline__ void transpose_item(const float* W, int N, int mid, const float* gvec, bf16_t* WT, int nblk, int item, int lane, LAS float* scr) {
    const int kb = item / nblk, nb = item % nblk, k0 = 64 * kb, n0 = 64 * nb;
    const int c4 = lane & 15, r4 = lane >> 4, j = n0 + 4 * c4;
    const int sc = (mid < 0) ? j : pg8::src_col(mid, j);
    f32x4 v[16];
#pragma unroll
    for (int i = 0; i < 16; ++i) { v[i] = (f32x4){0.f, 0.f, 0.f, 0.f}; if (sc >= 0) v[i] = *(const GAS f32x4*)(W + (size_t)(k0 + 4 * i + r4) * N + sc); }
#pragma unroll
    for (int i = 0; i < 16; ++i) { const int kk = 4 * i + r4; const float gk = gvec ? gvec[k0 + kk] : 1.0f; LAS float* d = scr + kk * 65 + 4 * c4;
        d[0] = v[i][0] * gk; d[1] = v[i][1] * gk; d[2] = v[i][2] * gk; d[3] = v[i][3] * gk; }
    LDS_WAIT(); asm volatile("" ::: "memory");
    const int c = lane & 7;
#pragma unroll
    for (int jj = 0; jj < 8; ++jj) { const int n = (lane >> 3) + 8 * jj; const LAS float* sp = scr + (8 * c) * 65 + n;
        u32x4 o; o.x = pk2(sp[0 * 65], sp[1 * 65]); o.y = pk2(sp[2 * 65], sp[3 * 65]); o.z = pk2(sp[4 * 65], sp[5 * 65]); o.w = pk2(sp[6 * 65], sp[7 * 65]);
        *(GAS u32x4*)(WT + (size_t)(n0 + n) * LDW + k0 + 8 * c) = o; }
    LDS_WAIT(); asm volatile("" ::: "memory");
}
__device__ __forceinline__ void row_to_bf16(const float* xrow, bf16_t* orow, float* rss, int lane) {
    const f32x4* xr = (const f32x4*)xrow + lane; float s = 0.f;
    GAS u32x2* o8 = (GAS u32x2*)orow + lane;
#pragma unroll
    for (int j = 0; j < 8; ++j) { const f32x4 v = xr[64 * j]; s += (v.x * v.x + v.y * v.y) + (v.z * v.z + v.w * v.w);
        u32x2 w; w.x = pk2(v.x, v.y); w.y = pk2(v.z, v.w); o8[64 * j] = w; }
    s = wave_sum(s);
    if (lane == 0) *(GAS float*)rss = s;
}

enum { MODE_SWA = 0, MODE_MOBA = 1, MODE_MEM = 2 };
template <int DH, int MODE>
__device__ __forceinline__ void attn_unit(LAS unsigned char* lds, int tid, int wid, int lane,
        const bf16_t* Q,
        int qrow0,
        const bf16_t* Kb, const bf16_t* Vb, int ldkv,
        int nt, int krow_a, int krow_b,
        float m_init, float l_init, unsigned sel0, unsigned sel1,
        bf16_t* Zy,
        bool dry = false)
{
    asm volatile("" : "+v"(tid), "+v"(lane)); asm volatile("" : "+s"(wid));
    constexpr int KSTR = DH * 2 + 16, VSTR = DH * 2 + 32, KBYTES = 64 * KSTR, VBYTES = 64 * VSTR, STG = KBYTES + VBYTES;
    constexpr int CPR = DH / 8  , CPT = (64 * CPR) / NTHREADS  ;
    constexpr int NK = DH / 32, NDB = DH / 16;
    const int g = lane >> 4, l15 = lane & 15, q4 = l15 >> 2, p4 = l15 & 3;
    bf16x8 Qf[2][NK];
#pragma unroll
    for (int j = 0; j < 2; ++j)
#pragma unroll
        for (int k = 0; k < NK; ++k) Qf[j][k] = *(const GAS bf16x8*)(Q + (size_t)(qrow0 + j * 16 + l15) * LDP + k * 32 + g * 8);
    f32x4 O[NDB][2];
#pragma unroll
    for (int db = 0; db < NDB; ++db) { O[db][0] = (f32x4){0.f, 0.f, 0.f, 0.f}; O[db][1] = (f32x4){0.f, 0.f, 0.f, 0.f}; }
    const float m0 = (MODE == MODE_SWA) ? m_init : 0.f;
    float mrow[2] = {m0, m0}, lrow[2] = {g == 0 ? l_init : 0.f, g == 0 ? l_init : 0.f};
    bool first = (MODE != MODE_SWA);
    const unsigned sel[2] = {sel0, sel1};

    u32x4 kreg[2][CPT], vreg[2][CPT];
#define ATT_KROW(it) ((MODE == MODE_MOBA && (it) >= 4) ? (krow_b + 64 * ((it) - 4)) : (krow_a + 64 * (it)))
#define ATT_ISSUE(hf_, it) do { const int kr_ = ATT_KROW(it); _Pragma("unroll") for (int i_ = 0; i_ < CPT; ++i_) { const int c_ = tid + NTHREADS * i_, r_ = c_ / CPR, cc_ = c_ % CPR; \
        kreg[hf_][i_] = *(const GAS u32x4*)(Kb + (size_t)(kr_ + r_) * ldkv + cc_ * 8); vreg[hf_][i_] = *(const GAS u32x4*)(Vb + (size_t)(kr_ + r_) * ldkv + cc_ * 8); } } while (0)
    constexpr bool PF2 = false;
    ATT_ISSUE(0, 0);
    if (PF2 && nt > 1) ATT_ISSUE(1, 1);
    for (int it0 = 0; it0 < nt; it0 += 2) {
#pragma unroll
      for (int hf = 0; hf < 2; ++hf) {
        const int it = it0 + hf;
        if (it >= nt) break;
        LAS unsigned char* Kt = lds + hf * STG; LAS unsigned char* Vt = Kt + KBYTES;
#pragma unroll
        for (int i = 0; i < CPT; ++i) { const int c = tid + NTHREADS * i, r = c / CPR, cc = c % CPR;
            *(LAS u32x4*)(Kt + r * KSTR + cc * 16) = kreg[PF2 ? hf : 0][i]; *(LAS u32x4*)(Vt + r * VSTR + cc * 16) = vreg[PF2 ? hf : 0][i]; }
        if (PF2) { if (it + 2 < nt) ATT_ISSUE(hf, it + 2); } else { if (it + 1 < nt) ATT_ISSUE(0, it + 1); }
        __syncthreads();
        const int kp = ATT_KROW(it);
        bool active = true;
        if (MODE == MODE_SWA) active = !(kp > qrow0 + 31 || kp + 63 <= qrow0 - 128);
        if (MODE == MODE_MOBA) active = !(kp > qrow0 + 31);
        if (active) {
            f32x4 S[4][2];
            float sinit[2] = {-mrow[0], -mrow[1]};
            if (MODE == MODE_MOBA && it >= 4) {
                const int pb = (it - 4) >> 2;
                sinit[0] = ((sel[0] >> pb) & 1u) ? sinit[0] : -INFINITY; sinit[1] = ((sel[1] >> pb) & 1u) ? sinit[1] : -INFINITY;
            }
#pragma unroll
            for (int kb = 0; kb < 4; ++kb) { S[kb][0] = (f32x4){sinit[0], sinit[0], sinit[0], sinit[0]}; S[kb][1] = (f32x4){sinit[1], sinit[1], sinit[1], sinit[1]}; }
#pragma unroll
            for (int kb = 0; kb < 4; ++kb) {
#pragma unroll
                for (int k = 0; k < NK; ++k) {
                    const bf16x8 a = *(const LAS bf16x8*)(Kt + (kb * 16 + l15) * KSTR + (k * 32 + g * 8) * 2);
                    S[kb][0] = __builtin_amdgcn_mfma_f32_16x16x32_bf16(a, Qf[0][k], S[kb][0], 0, 0, 0);
                    S[kb][1] = __builtin_amdgcn_mfma_f32_16x16x32_bf16(a, Qf[1][k], S[kb][1], 0, 0, 0);
                }
                if (kb & 1) __builtin_amdgcn_sched_barrier(0);
            }
            bf16x8 Pb[2][2];
#pragma unroll
            for (int j = 0; j < 2; ++j) {
                const int qi = qrow0 + j * 16 + l15;
                if (MODE == MODE_SWA) {
                    if (!(kp + 63 <= qrow0 && kp > qrow0 + 31 - 128)) {
                        const unsigned dbase = (unsigned)(qi - kp - 4 * g);
#pragma unroll
                        for (int kb = 0; kb < 4; ++kb)
#pragma unroll
                            for (int i = 0; i < 4; ++i) S[kb][j][i] = ((dbase - (unsigned)(kb * 16 + i)) < 128u) ? S[kb][j][i] : -INFINITY;
                    }
                } else if (MODE == MODE_MOBA) {
                    if (kp + 63 > qrow0) {
#pragma unroll
                        for (int kb = 0; kb < 4; ++kb)
#pragma unroll
                            for (int i = 0; i < 4; ++i) S[kb][j][i] = ((qi - kp - 4 * g) >= (kb * 16 + i)) ? S[kb][j][i] : -INFINITY;
                    }
                }
                float mx = -INFINITY;
#pragma unroll
                for (int kb = 0; kb < 4; ++kb) mx = fmaxf(mx, fmaxf(fmaxf(S[kb][j][0], S[kb][j][1]), fmaxf(S[kb][j][2], S[kb][j][3])));
                mx = xmax16(mx); mx = xmax32(mx);
                const bool need = (first && mx > -INFINITY) || (mx > 8.0f);
                if (__builtin_amdgcn_ballot_w64(need) != 0ull) {
                    const float dlt = need ? mx : 0.f, alpha = fexp2(-dlt);
#pragma unroll
                    for (int kb = 0; kb < 4; ++kb) S[kb][j] = S[kb][j] - dlt;
                    mrow[j] += dlt; lrow[j] *= alpha;
#pragma unroll
                    for (int db = 0; db < NDB; ++db) O[db][j] = O[db][j] * alpha;
                }
                float ps = 0.f;
#pragma unroll
                for (int kb = 0; kb < 4; ++kb)
#pragma unroll
                    for (int i = 0; i < 4; ++i) { const float p = fexp2(S[kb][j][i]); S[kb][j][i] = p; ps += p; }
                lrow[j] += ps;
                Pb[j][0] = pack8s(S[0][j], S[1][j]); Pb[j][1] = pack8s(S[2][j], S[3][j]);
            }
#pragma unroll
            for (int s = 0; s < 2; ++s)
#pragma unroll
                for (int db = 0; db < NDB; ++db) {
                    const s16x4 lo = vtr(Vt + (32 * s + 4 * g + q4) * VSTR + (16 * db + 4 * p4) * 2);
                    const s16x4 hi = vtr(Vt + (32 * s + 16 + 4 * g + q4) * VSTR + (16 * db + 4 * p4) * 2);
                    const bf16x8 a = cat8(lo, hi);
                    O[db][0] = __builtin_amdgcn_mfma_f32_16x16x32_bf16(a, Pb[0][s], O[db][0], 0, 0, 0);
                    O[db][1] = __builtin_amdgcn_mfma_f32_16x16x32_bf16(a, Pb[1][s], O[db][1], 0, 0, 0);
                    if ((db & 3) == 3) __builtin_amdgcn_sched_barrier(0);
                }
            first = false;
        }
      }
    }
#undef ATT_ISSUE
#undef ATT_KROW
#pragma unroll
    for (int j = 0; j < 2; ++j) {
        float l = lrow[j]; l += __shfl_xor(l, 16); l += __shfl_xor(l, 32);
        const float inv = 1.0f / l;
        bf16_t* zp = Zy + (size_t)(qrow0 + j * 16 + l15) * LDP + 4 * g;
#pragma unroll
        for (int db = 0; db < NDB; ++db) {
            const u32x2 z = *(const GAS u32x2*)(zp + 16 * db);
            const f32x4 o = O[db][j] * inv;
            u32x2 w; w.x = cvt_pk_bf16(silu_mul(o[0], bflo(z.x)), silu_mul(o[1], bfhi(z.x))); w.y = cvt_pk_bf16(silu_mul(o[2], bflo(z.y)), silu_mul(o[3], bfhi(z.y)));
            if (!dry) *(GAS u32x2*)(zp + 16 * db) = w;
        }
    }
    __syncthreads();
}

__device__ __forceinline__ void moba_gate(LAS unsigned char* lds, int tid, const bf16_t* proj, const float* kmean, int b, int h, int qb) {
    asm volatile("" : "+v"(tid));
    LAS float* km = (LAS float*)lds;
    LAS unsigned* selm = (LAS unsigned*)(lds + LDS_MISC - 2048);
    for (int i = tid; i < 16 * 128; i += NTHREADS) km[i] = *((const GAS float*)kmean + (size_t)((b * 12 + h) * 16) * 128 + i);
    __syncthreads();
    const int q = tid >> 1, half = tid & 1;
    const bf16_t* qp = proj + (size_t)(b * SEQ + qb * 256 + q) * LDP + h * 128 + half * 64;
    float gsc[15];
#pragma unroll
    for (int n = 0; n < 15; ++n) gsc[n] = 0.f;
#pragma unroll 1
    for (int c = 0; c < 8; ++c) {
        const u32x4 w = *(const GAS u32x4*)(qp + c * 8);
        float qv[8] = {bflo(w.x), bfhi(w.x), bflo(w.y), bfhi(w.y), bflo(w.z), bfhi(w.z), bflo(w.w), bfhi(w.w)};
#pragma unroll
        for (int n = 0; n < 15; ++n) if (n < qb) {
            const LAS float* kr = km + n * 128 + half * 64 + c * 8;
#pragma unroll
            for (int e = 0; e < 8; ++e) gsc[n] += qv[e] * kr[e];
        }
    }
    unsigned mask = 0u;
#pragma unroll
    for (int n = 0; n < 15; ++n) { gsc[n] += __shfl_xor(gsc[n], 1); if (n >= qb) gsc[n] = -INFINITY; }
#pragma unroll
    for (int r = 0; r < 3; ++r) {
        float best = -INFINITY; int bi = -1;
#pragma unroll
        for (int n = 0; n < 15; ++n) { const bool taken = (mask >> n) & 1u; if (!taken && gsc[n] > best) { best = gsc[n]; bi = n; } }
        if (bi >= 0) mask |= 1u << bi;
    }
    if (half == 0) selm[q] = mask;
    __syncthreads();
}

__device__ __forceinline__ void kmean_unit(LAS unsigned char* lds, int tid, const bf16_t* proj, float* kmean, int u) {
    asm volatile("" : "+v"(tid));
    const int blk = u & 15, bh = u >> 4, b = bh / 12, h = bh % 12;
    const int cc = tid & 15, kg = tid >> 4;
    float s[8] = {0.f, 0.f, 0.f, 0.f, 0.f, 0.f, 0.f, 0.f};
    const bf16_t* kp = proj + (size_t)(b * SEQ + blk * 256 + kg * 8) * LDP + 1536 + h * 128 + cc * 8;
#pragma unroll
    for (int r = 0; r < 8; ++r) { const u32x4 w = *(const GAS u32x4*)(kp + (size_t)r * LDP);
        s[0] += bflo(w.x); s[1] += bfhi(w.x); s[2] += bflo(w.y); s[3] += bfhi(w.y); s[4] += bflo(w.z); s[5] += bfhi(w.z); s[6] += bflo(w.w); s[7] += bfhi(w.w); }
    LAS float* red = (LAS float*)lds;
#pragma unroll
    for (int e = 0; e < 8; ++e) red[kg * 128 + cc * 8 + e] = s[e];
    __syncthreads();
    if (tid < 128) { float a = 0.f;
#pragma unroll 8
        for (int k = 0; k < 32; ++k) a += red[k * 128 + tid];
        *((GAS float*)kmean + (size_t)u * 128 + tid) = a * (1.0f / 256.0f); }
    __syncthreads();
}

__device__ __forceinline__ void ret_scan_item(LAS unsigned char* lds, int tid, int wid, int lane, const bf16_t* proj, bf16_t* rprev, int item) {
    asm volatile("" : "+v"(tid), "+v"(lane)); asm volatile("" : "+s"(wid));
    constexpr int KS = 288, VS = 96, KB = 128 * KS, STG = KB + 128 * VS;
    const int es = item & 7, bh = item >> 3, b = bh / 6, h = bh % 6;
    const float lg = log2gamma(h), gchunk = fexp2(128.f * lg);
    const int g = lane >> 4, l15 = lane & 15, q4 = l15 >> 2, p4 = l15 & 3;
    const bf16_t* kbase = proj + (size_t)(b * SEQ) * LDP + 768 + h * 128;
    const bf16_t* vbase = proj + (size_t)(b * SEQ) * LDP + 1536 + h * 256 + es * 32;
    f32x4 R[2] = {(f32x4){0.f, 0.f, 0.f, 0.f}, (f32x4){0.f, 0.f, 0.f, 0.f}};
    u32x4 kreg[4], vreg;
#define RS_ISSUE(n) do { _Pragma("unroll") for (int i_ = 0; i_ < 4; ++i_) { const int c_ = tid + NTHREADS * i_; kreg[i_] = *(const GAS u32x4*)(kbase + (size_t)((n) * 128 + (c_ >> 4)) * LDP + (c_ & 15) * 8); } \
        vreg = *(const GAS u32x4*)(vbase + (size_t)((n) * 128 + (tid >> 2)) * LDP + (tid & 3) * 8); } while (0)
    RS_ISSUE(0);
    for (int n = 0; n < 32; ++n) {
        bf16_t* rp = rprev + ((size_t)((b * 32 + n) * 6 + h) * 256 + es * 32 + l15) * 128 + wid * 16 + 4 * g;
#pragma unroll
        for (int eb = 0; eb < 2; ++eb) { u32x2 w; w.x = cvt_pk_bf16(R[eb][0], R[eb][1]); w.y = cvt_pk_bf16(R[eb][2], R[eb][3]); *(GAS u32x2*)(rp + (size_t)eb * 16 * 128) = w; }
        if (n == 31) break;
        LAS unsigned char* Kt = lds + (n & 1) * STG; LAS unsigned char* Vt = Kt + KB;
#pragma unroll
        for (int i = 0; i < 4; ++i) { const int c = tid + NTHREADS * i, t = c >> 4, cc = c & 15;
            const float zt = fexp2((float)(127 - t) * lg);
            const u32x4 w = kreg[i]; u32x4 o;
            o.x = cvt_pk_bf16(bflo(w.x) * zt, bfhi(w.x) * zt); o.y = cvt_pk_bf16(bflo(w.y) * zt, bfhi(w.y) * zt); o.z = cvt_pk_bf16(bflo(w.z) * zt, bfhi(w.z) * zt); o.w = cvt_pk_bf16(bflo(w.w) * zt, bfhi(w.w) * zt);
            *(LAS u32x4*)(Kt + t * KS + cc * 16) = o; }
        *(LAS u32x4*)(Vt + (tid >> 2) * VS + (tid & 3) * 16) = vreg;
        __syncthreads();
        if (n + 1 < 31) RS_ISSUE(n + 1);
        R[0] = R[0] * gchunk; R[1] = R[1] * gchunk;
#pragma unroll
        for (int s = 0; s < 4; ++s) {
            const bf16x8 a = cat8(vtr(Kt + (32 * s + 8 * g + q4) * KS + (16 * wid + 4 * p4) * 2), vtr(Kt + (32 * s + 8 * g + 4 + q4) * KS + (16 * wid + 4 * p4) * 2));
#pragma unroll
            for (int eb = 0; eb < 2; ++eb) {
                const bf16x8 bb = cat8(vtr(Vt + (32 * s + 8 * g + q4) * VS + (16 * eb + 4 * p4) * 2), vtr(Vt + (32 * s + 8 * g + 4 + q4) * VS + (16 * eb + 4 * p4) * 2));
                R[eb] = __builtin_amdgcn_mfma_f32_16x16x32_bf16(a, bb, R[eb], 0, 0, 0);
            }
        }
    }
#undef RS_ISSUE
    __syncthreads();
}

__device__ __forceinline__ void ret_out_unit(LAS unsigned char* lds, int tid, int wid, int lane, bf16_t* proj, const bf16_t* rprev, int u, bool dry = false) {
    asm volatile("" : "+v"(tid), "+v"(lane)); asm volatile("" : "+s"(wid));
    constexpr int KS = 272, VS = 544, KB = 128 * KS;
    const int h = u % 6, bn = u / 6, n = bn & 31, b = bn >> 5;
    const float lg = log2gamma(h);
    const int g = lane >> 4, l15 = lane & 15, q4 = l15 >> 2, p4 = l15 & 3;
    const int row0 = b * SEQ + n * 128;
    LAS unsigned char* Kt = lds; LAS unsigned char* Vt = lds + KB;
    const bf16_t* kbase = proj + (size_t)row0 * LDP + 768 + h * 128;
    const bf16_t* vbase = proj + (size_t)row0 * LDP + 1536 + h * 256;
#pragma unroll
    for (int i = 0; i < 4; ++i) { const int c = tid + NTHREADS * i, t = c >> 4, cc = c & 15; *(LAS u32x4*)(Kt + t * KS + cc * 16) = *(const GAS u32x4*)(kbase + (size_t)t * LDP + cc * 8); }
#pragma unroll
    for (int i = 0; i < 8; ++i) { const int c = tid + NTHREADS * i, t = c >> 5, cc = c & 31; *(LAS u32x4*)(Vt + t * VS + cc * 16) = *(const GAS u32x4*)(vbase + (size_t)t * LDP + cc * 8); }
    const int qrow = row0 + wid * 16 + l15;
    bf16x8 Qf[4];
#pragma unroll
    for (int k = 0; k < 4; ++k) Qf[k] = *(const GAS bf16x8*)(proj + (size_t)qrow * LDP + h * 128 + k * 32 + g * 8);
    u32x4 rreg[8];
    const bf16_t* rbase = rprev + (size_t)((b * 32 + n) * 6 + h) * 256 * 128;
#pragma unroll
    for (int i = 0; i < 8; ++i) { const int c = tid + NTHREADS * i; rreg[i] = *(const GAS u32x4*)(rbase + (size_t)c * 8); }
    __syncthreads();
    f32x4 S[8];
#pragma unroll
    for (int kb = 0; kb < 8; ++kb) S[kb] = (f32x4){0.f, 0.f, 0.f, 0.f};
#pragma unroll
    for (int kb = 0; kb < 8; ++kb) if (kb <= wid) {
#pragma unroll
        for (int k = 0; k < 4; ++k) {
            const bf16x8 a = *(const LAS bf16x8*)(Kt + (kb * 16 + l15) * KS + (k * 32 + g * 8) * 2);
            S[kb] = __builtin_amdgcn_mfma_f32_16x16x32_bf16(a, Qf[k], S[kb], 0, 0, 0);
        }
    }
    const int tq = wid * 16 + l15;
    bf16x8 Pb[4];
#pragma unroll
    for (int kb = 0; kb < 8; ++kb)
#pragma unroll
        for (int i = 0; i < 4; ++i) { const int tk = kb * 16 + 4 * g + i; S[kb][i] = (tk <= tq) ? S[kb][i] * fexp2(-(float)(tk + 1) * lg) : 0.f; }
#pragma unroll
    for (int s = 0; s < 4; ++s) Pb[s] = pack8(S[2 * s], S[2 * s + 1]);
    f32x4 O[16];
#pragma unroll
    for (int eb = 0; eb < 16; ++eb) O[eb] = (f32x4){0.f, 0.f, 0.f, 0.f};
#pragma unroll
    for (int s = 0; s < 4; ++s) if (2 * s <= wid) {
#pragma unroll
        for (int eb = 0; eb < 16; ++eb) {
            const bf16x8 a = cat8(vtr(Vt + (32 * s + 4 * g + q4) * VS + (16 * eb + 4 * p4) * 2), vtr(Vt + (32 * s + 16 + 4 * g + q4) * VS + (16 * eb + 4 * p4) * 2));
            O[eb] = __builtin_amdgcn_mfma_f32_16x16x32_bf16(a, Pb[s], O[eb], 0, 0, 0);
        }
    }
    __syncthreads();
#pragma unroll
    for (int i = 0; i < 8; ++i) { const int c = tid + NTHREADS * i; *(LAS u32x4*)(Vt + (c >> 4) * KS + (c & 15) * 16) = rreg[i]; }
    __syncthreads();
#pragma unroll
    for (int eb = 0; eb < 16; ++eb)
#pragma unroll
        for (int k = 0; k < 4; ++k) {
            const bf16x8 a = *(const LAS bf16x8*)(Vt + (eb * 16 + l15) * KS + (k * 32 + g * 8) * 2);
            O[eb] = __builtin_amdgcn_mfma_f32_16x16x32_bf16(a, Qf[k], O[eb], 0, 0, 0);
        }
    const float xi = fexp2((float)(tq + 1) * lg);
    float ss = 0.f;
#pragma unroll
    for (int eb = 0; eb < 16; ++eb) { O[eb] = O[eb] * xi; ss += (O[eb][0] * O[eb][0] + O[eb][1] * O[eb][1]) + (O[eb][2] * O[eb][2] + O[eb][3] * O[eb][3]); }
    ss += __shfl_xor(ss, 16); ss += __shfl_xor(ss, 32);
    const float rstd = __builtin_amdgcn_rsqf(ss * (1.0f / 256.0f) + EPSN);
    bf16_t* zp = proj + (size_t)qrow * LDP + 3584 + h * 256 + 4 * g;
#pragma unroll
    for (int eb = 0; eb < 16; ++eb) {
        const u32x2 z = *(const GAS u32x2*)(zp + 16 * eb);
        const f32x4 o = O[eb] * rstd;
        u32x2 w; w.x = cvt_pk_bf16(silu_mul(o[0], bflo(z.x)), silu_mul(o[1], bfhi(z.x))); w.y = cvt_pk_bf16(silu_mul(o[2], bflo(z.y)), silu_mul(o[3], bfhi(z.y)));
        if (!dry) *(GAS u32x2*)(zp + 16 * eb) = w;
    }
    __syncthreads();
}

#define XB_TMO      128
#define XB_XCNT(j)  (256  + 64 * (j))
#define XB_XSUB(j)  (1280 + 64 * (j))
#define XB_XGEN(j)  (2304 + 64 * (j))
#define XB_TOP      3328
#define XB_TOPGEN   3392
#define XCD_BAR_WORDS 3456
#define XB_SPIN_CAP (1u << 18)

__device__ __forceinline__ unsigned xb_ld(unsigned* p)              { return __hip_atomic_load(p, __ATOMIC_RELAXED, __HIP_MEMORY_SCOPE_AGENT); }
__device__ __forceinline__ unsigned xb_add(unsigned* p, unsigned v) { return __hip_atomic_fetch_add(p, v, __ATOMIC_RELAXED, __HIP_MEMORY_SCOPE_AGENT); }
__device__ __forceinline__ unsigned xb_xcc_id() { return (unsigned)__builtin_amdgcn_s_getreg((3 << 11) | 20) & 0xFu; }
#define XB_SPIN(cond, bar) do { unsigned _sp = 0; while (cond) { __builtin_amdgcn_s_sleep(1); \
    if ((++_sp & 255u) == 0u) { if (xb_ld(&(bar)[XB_TMO])) break; if (_sp > XB_SPIN_CAP) { atomicAdd(&(bar)[XB_TMO], 1u); break; } } } } while (0)

struct XcdBarrier {
    unsigned* bar; unsigned x;
    volatile LAS unsigned* st;
};

__device__ __forceinline__ XcdBarrier xcd_barrier_post(unsigned* bar, volatile LAS unsigned* st) {
    XcdBarrier b; b.bar = bar; b.x = xb_xcc_id(); b.st = st;
    if (threadIdx.x == 0) (void)xb_add(&bar[XB_XCNT(b.x)], 1u);
    return b;
}
__device__ __forceinline__ void xcd_barrier_complete(unsigned* bar, unsigned x, unsigned& nloc, unsigned& nx) {
    const unsigned G = gridDim.x * gridDim.y * gridDim.z;
    unsigned sum, cnt, mine, sp = 0u;
    for (;;) {
        sum = 0u; cnt = 0u; mine = 0u;
#pragma unroll
        for (unsigned j = 0; j < 16; ++j) { const unsigned c = xb_ld(&bar[XB_XCNT(j)]); sum += c; cnt += (c > 0u) ? 1u : 0u; mine = (j == x) ? c : mine; }
        if (sum == G) break;
        __builtin_amdgcn_s_sleep(1);
        if ((++sp & 255u) == 0u) { if (xb_ld(&bar[XB_TMO])) break; if (sp > XB_SPIN_CAP) { atomicAdd(&bar[XB_TMO], 1u); break; } }
    }
    nloc = mine > 0u ? mine : 1u; nx = cnt > 0u ? cnt : 1u;
}

__device__ __forceinline__ void xcd_barrier(const XcdBarrier& b) {
    asm volatile("s_waitcnt vmcnt(0)" ::: "memory");
    __syncthreads();
    if (threadIdx.x == 0) {
        unsigned* bar = b.bar;
        __builtin_amdgcn_s_waitcnt(0);
        unsigned nloc = b.st[0], nx = b.st[1];
        if (nloc == 0u) { xcd_barrier_complete(bar, b.x, nloc, nx); b.st[0] = nloc; b.st[1] = nx; }
        const unsigned old = xb_add(&bar[XB_XSUB(b.x)], 1u);
        const unsigned gen = old / nloc;
        if (old + 1u == (gen + 1u) * nloc) {
            __builtin_amdgcn_fence(__ATOMIC_RELEASE, "agent");
            asm volatile("s_waitcnt vmcnt(0)" ::: "memory");
            const unsigned og = xb_add(&bar[XB_TOP], 1u);
            const unsigned tg = og / nx;
            if (og + 1u == (tg + 1u) * nx) xb_add(&bar[XB_TOPGEN], 1u);
            else XB_SPIN(xb_ld(&bar[XB_TOPGEN]) == tg, bar);
            __builtin_amdgcn_fence(__ATOMIC_ACQUIRE, "agent");
            xb_add(&bar[XB_XGEN(b.x)], 1u);
            asm volatile("s_waitcnt vmcnt(0)" ::: "memory");
        } else {
            XB_SPIN(xb_ld(&bar[XB_XGEN(b.x)]) == gen, bar);
            __builtin_amdgcn_fence(__ATOMIC_ACQUIRE, "agent");
            asm volatile("s_waitcnt vmcnt(0)" ::: "memory");
        }
    }
    __syncthreads();
}


#define CONV_WEIGHTS(MASK, worker, nworkers) do { \
        int lane_ = lane, wid_ = wid; asm volatile("" : "+v"(lane_)); asm volatile("" : "+s"(wid_)); LAS float* scr_ = (LAS float*)(lds + wid_ * 16640); \
        int total_ = 0; \
        _Pragma("unroll 1") for (int mi_ = 0; mi_ < 9; ++mi_) if (((MASK) >> mi_) & 1u) total_ += 32 * (mi_ < 4 ? pg8::npad_of(mi_ == 3 ? 0 : mi_) / 64 : (mi_ < 8 ? 32 : 16)); \
        for (int it_ = (worker); it_ < total_; it_ += (nworkers)) { \
            int r_ = it_; \
            _Pragma("unroll 1") for (int mi = 0; mi < 9; ++mi) { \
                if (!(((MASK) >> mi) & 1u)) continue; \
                const float* W; int N, mid_, nblk; const float* gv; bf16_t* WT; \
                if (mi < 4) { const int l_ = mi; mid_ = l_ == 3 ? 0 : l_; N = pg8::nc_of(mid_); nblk = pg8::npad_of(mid_) / 64; \
                    W = args.in[l_ == 0 ? 6 : l_ == 1 ? 10 : l_ == 2 ? 13 : 16]; gv = args.in[l_ == 0 ? 5 : l_ == 1 ? 9 : l_ == 2 ? 12 : 15]; \
                    WT = (bf16_t*)(ws + (l_ == 0 ? WS_WIN0 : l_ == 1 ? WS_WIN1 : l_ == 2 ? WS_WIN2 : WS_WIN3)); } \
                else if (mi < 8) { const int l_ = mi - 4; mid_ = -1; N = 2048; nblk = 32; W = args.in[l_ == 0 ? 8 : l_ == 1 ? 11 : l_ == 2 ? 14 : 18]; gv = nullptr; WT = woutT + (size_t)l_ * 2048 * LDW; } \
                else { mid_ = -1; N = 1024; nblk = 16; W = args.in[4]; gv = args.in[3]; WT = wmemT; } \
                const int cnt_ = 32 * nblk; \
                if (r_ < cnt_) { transpose_item(W, N, mid_, gv, WT, nblk, r_, lane_, scr_); break; } \
                r_ -= cnt_; \
            } \
        } } while (0)

struct Args { const float* in[20]; float* out; unsigned char* ws; };

__device__ __forceinline__ int fetch_unit(unsigned* ctr, volatile LAS unsigned* slot, int tid) {
    if (tid == 0) *slot = atomicAdd(ctr, 1u);
    __syncthreads();
    const unsigned v = *slot;
    __syncthreads();
    return __builtin_amdgcn_readfirstlane((int)v);
}

__global__ void __launch_bounds__(NTHREADS, 2) trunk_fwd(Args args) {
    extern __shared__ __attribute__((aligned(16))) unsigned char lds_raw[];
    cg::grid_group grid = cg::this_grid();
    LAS unsigned char* lds = (LAS unsigned char*)lds_raw;
    volatile LAS unsigned* misc = (volatile LAS unsigned*)(lds + LDS_MISC);
    const int tid = threadIdx.x, lane = tid & 63, wid = __builtin_amdgcn_readfirstlane(tid >> 6);
    const int G = gridDim.x, bx = blockIdx.x;
#define WS_PTRS() unsigned char* ws = args.ws; asm volatile("" : "+s"(ws)); \
    unsigned* ctl = (unsigned*)(ws + WS_CTL); bf16_t* hb = (bf16_t*)(ws + WS_HB); bf16_t* proj = (bf16_t*)(ws + WS_PROJ); \
    bf16_t* memb = (bf16_t*)(ws + WS_MEMB); bf16_t* mkv = (bf16_t*)(ws + WS_MKV); float* rss = (float*)(ws + WS_RSS); float* rssm = (float*)(ws + WS_RSSM); \
    float* ropeA = (float*)(ws + WS_ROPEA); float* ropeB = (float*)(ws + WS_ROPEB); float* ropeC = (float*)(ws + WS_ROPEC); \
    float* kmean = (float*)(ws + WS_KMEAN); bf16_t* rprev = (bf16_t*)(ws + WS_RPREV); bf16_t* woutT = (bf16_t*)(ws + WS_WOUT); bf16_t* wmemT = (bf16_t*)(ws + WS_WMEM); \
    (void)ctl; (void)hb; (void)proj; (void)memb; (void)mkv; (void)rss; (void)rssm; (void)ropeA; (void)ropeB; (void)ropeC; (void)kmean; (void)rprev; (void)woutT; (void)wmemT
#ifndef REP_P0
#define REP_P0 1
#endif
    for (int rep0 = 0; rep0 < REP_P0; ++rep0) {
        if (rep0) grid.sync();
        WS_PTRS(); const float* x = args.in[0];
        const int gw = bx * NWAVES + wid, NGW = G * NWAVES;
        LAS float* scr = (LAS float*)(lds + wid * 16640);
        if (G == 256) CONV_WEIGHTS(0x111u, gw, NGW); else CONV_WEIGHTS(0x1FFu, gw, NGW);
        for (int m = gw; m < MTOK; m += NGW) row_to_bf16(x + (size_t)m * DMODEL, hb + (size_t)m * LDH, rss + m, lane);
        for (int m = gw; m < NB * NMEMTOK; m += NGW) row_to_bf16(args.in[1] + (size_t)m * DMODEL, memb + (size_t)m * LDH, rssm + m, lane);
        const int* positions = (const int*)args.in[2];
        const int gt = bx * NTHREADS + tid, NGT = G * NTHREADS;
        for (int i = gt; i < MTOK * 88; i += NGT) {
            const int tok = i / 88, f = i % 88;
            float* tb; int F, fl;
            if (f < 8) { tb = ropeA; F = 8; fl = f; } else if (f < 24) { tb = ropeB; F = 16; fl = f - 8; } else { tb = ropeC; F = 64; fl = f - 24; }
            const double rev = (double)positions[tok] * INVF[f] * 0.15915494309189535;
            const float fr = (float)(rev - __builtin_rint(rev));
            *((GAS float*)tb + (size_t)tok * 2 * F + fl) = __builtin_amdgcn_cosf(fr); *((GAS float*)tb + (size_t)tok * 2 * F + F + fl) = __builtin_amdgcn_sinf(fr);
        }
        for (int i = gt; i < 4 * MTOK; i += NGT) *((GAS float*)rss + MTOK + i) = 0.f;
        for (int i = gt; i < 4 * 12 * 16 * 128; i += NGT) *((GAS float*)kmean + i) = 0.f;
        if (bx == 0) for (int i = tid; i < 1024 + XCD_BAR_WORDS; i += NTHREADS) ctl[i] = 0u;
    }
    grid.sync();
    if (tid < 2) misc[8 + tid] = 0u;
    __syncthreads();
    XcdBarrier xbar;
    { unsigned char* ws0 = args.ws; xbar = xcd_barrier_post((unsigned*)(ws0 + WS_CTL) + 1024, misc + 8); }
#define GRID_SYNC() xcd_barrier(xbar)

    const float L2E = 1.4426950408889634f;
#pragma unroll 1
    for (int l = 0; l < 4; ++l) {
        const int mid = (l == 3) ? 0 : l;
        const int nmix = pg8::nmix_of(mid), zoff = nmix + 512;
#pragma unroll 1
#ifndef REP_P1
#define REP_P1 1
#endif
        for (int rep1 = 0; rep1 < REP_P1; ++rep1)
        for (int pass = 0; pass < (l == 0 ? 2 : 1); ++pass) {
            WS_PTRS();
            pg8::Gemm g; pg8::StaticOrder S; pg8::EpiIn E;
            if (pass == 0) {
                g.A = hb; g.Bt = (const bf16_t*)(ws + (l == 0 ? WS_WIN0 : l == 1 ? WS_WIN1 : l == 2 ? WS_WIN2 : WS_WIN3)); g.lda = LDH; g.K = DMODEL; g.ldb = LDW;
                S.init(MTOK, pg8::npad_of(mid), G, bx);
                E.O = proj; E.ldc = LDP; E.mid = mid; E.rss = rss + (size_t)l * MTOK; E.kmean = kmean;
            } else {
                g.A = memb; g.Bt = wmemT; g.lda = LDH; g.K = DMODEL; g.ldb = LDW;
                S.init(NB * NMEMTOK, 1024, 1 << 20, bx - (G == 256 ? 240 : 0));
                E.O = mkv; E.ldc = 1024; E.mid = 3; E.rss = rssm; E.kmean = kmean;
            }
            E.rope0 = ropeA;

#ifndef SK_P1
pg8::gemm_phase<pg8::EpiIn, pg8::StaticOrder, true, true>(lds, g, S, E);
#endif

            __syncthreads();
        }
        if (l == 0 && G == 256 && bx >= 128 && bx < 240) {
            WS_PTRS();
            CONV_WEIGHTS(0x066u, (bx - 128) * NWAVES + wid, 112 * NWAVES);
        } else if (l == 2 && G == 256 && bx >= 128) {
            WS_PTRS();
            CONV_WEIGHTS(0x088u, (bx - 128) * NWAVES + wid, 128 * NWAVES);
        }
        GRID_SYNC();

        const int nsub = (mid == 2) ? 2 : 1;
#pragma unroll 1
        for (int sub = 0; sub < nsub; ++sub) {
            int nA, nMem;
            if (mid == 0) { nA = 1536; nMem = 256; } else if (mid == 1) { nA = 96; nMem = 32; } else if (sub == 0) { nA = 192; nMem = 256; } else { nA = 768; nMem = 0; }
#ifndef REP_P2
#define REP_P2 1
#endif
#ifndef REP_MID
#define REP_MID mid
#endif
            const int nrep = (mid == (REP_MID)) ? REP_P2 : 1;
            for (int rep = 0; rep < nrep; ++rep) {
            const bool dry = rep < nrep - 1;
            WS_PTRS();
            unsigned* ctr = ctl + (l * 2 + sub) + 16 * rep;
            if (mid == 1) ctr = ctl + 128 + 64 * (bx & 7) + 16 * rep;
            int u = fetch_unit(ctr, misc, tid);
            if (mid == 0) {
                while (u < nA) {
                    const int hp = u & 3, n = (u >> 2) & 31, r = u >> 7, kvh = r % 3, b = r / 3;
                    const int head = kvh * 8 + hp * 2 + (wid >> 2);
                    const float sink = args.in[l == 0 ? 7 : 17][head] * L2E;
#ifndef SK_SWA
                    attn_unit<64, MODE_SWA>(lds, tid, wid, lane, proj + head * 64, b * SEQ + n * 128 + (wid & 3) * 32, proj + 1536 + kvh * 64, proj + 1728 + kvh * 64, LDP,
                                            n == 0 ? 2 : 4, b * SEQ + n * 128 - (n ? 128 : 0), 0, sink, 1.f, 0u, 0u, proj + zoff + head * 64, dry);
#endif
                    u = fetch_unit(ctr, misc, tid);
                }
            } else if (mid == 1) {
                while (u < nA) {
                    const int qb = 15 - u / 6, bh = (bx & 7) + 8 * (u % 6), b = bh / 12, h = bh % 12;
#ifndef SK_MOBA
                    moba_gate(lds, tid, proj, kmean, b, h, qb);
                    volatile LAS unsigned* selm = (volatile LAS unsigned*)(lds + LDS_MISC - 2048);
                    const unsigned s0 = selm[wid * 32 + (lane & 15)], s1 = selm[wid * 32 + 16 + (lane & 15)];
                    __syncthreads();
                    attn_unit<128, MODE_MOBA>(lds, tid, wid, lane, proj + h * 128, b * SEQ + qb * 256 + wid * 32, proj + 1536 + h * 128, proj + 3072 + h * 128, LDP,
                                              4 + 4 * qb, b * SEQ + qb * 256, b * SEQ, -1e30f, 0.f, s0, s1, proj + zoff + h * 128, dry);
#endif
                    u = fetch_unit(ctr, misc, tid);
                }
            } else if (sub == 0) {
                while (u < nA) {
#ifndef SK_SCAN
                    ret_scan_item(lds, tid, wid, lane, proj, rprev, u);
#endif
                    u = fetch_unit(ctr, misc, tid);
                }
            } else {
                while (u < nA) {
#ifndef SK_ROUT
                    ret_out_unit(lds, tid, wid, lane, proj, rprev, u, dry);
#endif
                    u = fetch_unit(ctr, misc, tid);
                }
            }
            while (u < nA + nMem) {
                const int v = (mid == 1) ? (bx & 7) + 8 * (u - nA) : (u - nA), hm = v & 3, qt = (v >> 2) & 15, b = v >> 6;
#ifndef SK_MEM
                attn_unit<128, MODE_MEM>(lds, tid, wid, lane, proj + nmix + hm * 128, b * SEQ + qt * 256 + wid * 32, mkv + hm * 128, mkv + 512 + hm * 128, 1024,
                                         4, b * NMEMTOK, 0, -1e30f, 0.f, 0u, 0u, proj + zoff + 1536 + hm * 128, dry);
#endif
                u = fetch_unit(ctr, misc, tid);
            }
            GRID_SYNC();
            }
        }

        {
            WS_PTRS(); const float* x = args.in[0]; float* out = args.out;
            pg8::Gemm g; g.A = proj + zoff; g.Bt = woutT + (size_t)l * 2048 * LDW; g.lda = LDP; g.K = DMODEL; g.ldb = LDW;
            pg8::StaticOrder S; S.init(MTOK, DMODEL, G, bx);
            pg8::EpiOut E; E.basef = x; E.out = out; E.hb = hb; E.rssn = rss + (size_t)(l + 1) * MTOK; E.mode = (l == 0) ? 0 : (l == 3 ? 2 : 1);

#ifndef SK_P3
pg8::gemm_phase<pg8::EpiOut, pg8::StaticOrder, true, true>(lds, g, S, E);
#endif

            __syncthreads();
        }
        GRID_SYNC();
    }

#ifdef EXTRA_SYNCS
    for (int i = 0; i < EXTRA_SYNCS; ++i) GRID_SYNC();
#endif
    {
        const int gw = bx * NWAVES + wid, NGW = G * NWAVES;
        WS_PTRS(); float* out = args.out;
        int lane_f = lane; asm volatile("" : "+v"(lane_f));
        const float* gf = args.in[19];
        for (int m = gw; m < MTOK; m += NGW) {
            const float s = __builtin_amdgcn_rsqf(*((const GAS float*)rss + 4 * MTOK + m) * (1.0f / DMODEL) + EPSN);
            f32x4* xr = (f32x4*)(out + (size_t)m * DMODEL) + lane_f; const f32x4* gr = (const f32x4*)gf + lane_f;
#pragma unroll
            for (int j = 0; j < 8; ++j) { const f32x4 v = xr[64 * j]; xr[64 * j] = v * s * gr[64 * j]; }
        }
    }
}

extern "C" void kernel_launch(void* const* d_in, const int* in_sizes, int n_in, void* d_out, int out_size, void* d_ws, size_t ws_size, hipStream_t stream) {
    static int grid = 0;
    if (grid == 0) {
        if (n_in != 20 || out_size != MTOK * DMODEL || ws_size < WS_END) { fprintf(stderr, "kernel_launch: unexpected shapes (n_in %d, out %d, ws %zu, need %zu)\n", n_in, out_size, ws_size, (size_t)WS_END); grid = -1; return; }
        int dev = 0, cus = 0, per_cu = 0;
        hipGetDevice(&dev); hipDeviceGetAttribute(&cus, hipDeviceAttributeMultiprocessorCount, dev);
        hipFuncSetAttribute((const void*)trunk_fwd, hipFuncAttributeMaxDynamicSharedMemorySize, LDS_BYTES);
        if (hipOccupancyMaxActiveBlocksPerMultiprocessor(&per_cu, (const void*)trunk_fwd, NTHREADS, LDS_BYTES) != hipSuccess || per_cu < 1) { fprintf(stderr, "kernel_launch: occupancy query gave %d\n", per_cu); per_cu = 1; }
        (void)hipGetLastError();
        grid = cus;
        if (grid != 256) fprintf(stderr, "kernel_launch: note: %d CUs\n", grid);
    }
    if (grid < 0) return;
    Args a{};
    for (int i = 0; i < 20; ++i) a.in[i] = (const float*)d_in[i];
    a.out = (float*)d_out; a.ws = (unsigned char*)d_ws;
    void* kargs[] = {&a};
    hipError_t e = hipLaunchCooperativeKernel((const void*)trunk_fwd, dim3(grid), dim3(NTHREADS), kargs, LDS_BYTES, stream);
    if (e != hipSuccess) fprintf(stderr, "cooperative launch failed: %s (grid %d)\n", hipGetErrorString(e), grid);
}
```
